# Optimizing an MI355X kernel written in HIP

```python
import math
import jax, jax.numpy as jnp
from jax import lax
import numpy as np

D_MODEL = 1024
BATCH = 8
SEQ = 2048
DEPTH = 2
DEC_BATCH = 128
DEC_SEQ = 4
PAST_LEN = 16384
PAGE_SIZE = 128

GDN_HEADS = 4
GDN_DK = 128
GDN_DV = 128
GDN_K = GDN_HEADS * GDN_DK
GDN_V = GDN_HEADS * GDN_DV
CONV_W = 4
GDN_CONV_DIM = 2 * GDN_K + GDN_V
ML_HEADS = 4
ML_DK = 64
ML_DV = 128
ML_K = ML_HEADS * ML_DK
ML_V = ML_HEADS * ML_DV
D_FF = 4 * D_MODEL
CHUNK = 64
EPS = 1e-6
IN_SPLITS = (GDN_K, GDN_K, GDN_V, GDN_V, GDN_HEADS, GDN_HEADS,
             ML_K, ML_K, ML_V, ML_V, ML_HEADS, ML_HEADS, D_MODEL, D_MODEL)
IN_DIM = sum(IN_SPLITS)

kernel_name = 'hybrid_gdn_mlstm_gated_merge_step'


def _split_cols(a, sizes):
    offs = [int(o) for o in np.cumsum(sizes)[:-1]]
    return jnp.split(a, offs, axis=-1)


def _rmsnorm(x, w):
    xf = x.astype(jnp.float32)
    y = xf * lax.rsqrt(jnp.mean(xf * xf, axis=-1, keepdims=True) + EPS) * w.astype(jnp.float32)
    return y.astype(x.dtype)


def _head_rmsnorm(x, w):
    D = x.shape[-1]
    y = x * lax.rsqrt(jnp.mean(x * x, axis=-1, keepdims=True) + EPS)
    return y * w.astype(jnp.float32).reshape(-1, D)


def _l2norm(x):
    return x * lax.rsqrt(jnp.sum(x * x, axis=-1, keepdims=True) + EPS)


def _chunk_len(T):
    return CHUNK if T % CHUNK == 0 else T


def _to_chunks(a, L):
    B, T, H = a.shape[:3]
    a = a.reshape((B, T // L, L, H) + a.shape[3:])
    return jnp.moveaxis(a, (1, 3), (0, 2))


def _from_chunks(o):
    o = jnp.moveaxis(o, (0, 2), (1, 3))
    B, N, L, H, D = o.shape
    return o.reshape(B, N * L, H, D)


def _causal_conv_silu(x, buf, w):
    T = x.shape[1]
    xp = jnp.concatenate([buf.astype(x.dtype), x], axis=1)
    y = xp[:, 0:T] * w[0]
    for j in range(1, CONV_W):
        y = y + xp[:, j:j + T] * w[j]
    return jax.nn.silu(y), xp[:, -(CONV_W - 1):]


def _gated_delta_chunked(q, k, v, g, beta, S0):
    L = _chunk_len(q.shape[1])
    q, k, v, g, beta = (_to_chunks(a, L) for a in (q, k, v, g, beta))
    incl = jnp.tril(jnp.ones((L, L), bool))
    strict = jnp.tril(jnp.ones((L, L), bool), -1)
    gc = jnp.cumsum(g, axis=-1)
    decay = jnp.exp(jnp.where(incl, gc[..., :, None] - gc[..., None, :], -jnp.inf))
    kb = k * beta[..., None]
    A = jnp.where(strict, jnp.einsum('nbhid,nbhjd->nbhij', kb, k) * decay, 0.0)
    eye = jnp.broadcast_to(jnp.eye(L, dtype=A.dtype), A.shape)
    Tinv = lax.linalg.triangular_solve(A, eye, left_side=True, lower=True, unit_diagonal=True)
    w = jnp.einsum('nbhij,nbhjd->nbhid', Tinv, kb * jnp.exp(gc)[..., None])
    u = jnp.einsum('nbhij,nbhje->nbhie', Tinv, v * beta[..., None])
    qk = jnp.where(incl, jnp.einsum('nbhid,nbhjd->nbhij', q, k) * decay, 0.0)
    qd = q * jnp.exp(gc)[..., None]
    kd = k * jnp.exp(gc[..., -1:] - gc)[..., None]
    dl = jnp.exp(gc[..., -1])

    def step(S, xs):
        qd_c, qk_c, u_c, w_c, kd_c, dl_c = xs
        v_new = u_c - jnp.einsum('bhld,bhde->bhle', w_c, S)
        o = jnp.einsum('bhld,bhde->bhle', qd_c, S) + jnp.einsum('bhij,bhje->bhie', qk_c, v_new)
        S = S * dl_c[..., None, None] + jnp.einsum('bhld,bhle->bhde', kd_c, v_new)
        return S, o

    S, o = lax.scan(step, S0, (qd, qk, u, w, kd, dl))
    return _from_chunks(o), S


def _mlstm_chunked(q, k, v, log_i, log_f, C0, n0, m0):
    L = _chunk_len(q.shape[1])
    q, k, v, log_i, log_f = (_to_chunks(a, L) for a in (q, k, v, log_i, log_f))
    incl = jnp.tril(jnp.ones((L, L), bool))
    F = jnp.cumsum(log_f, axis=-1)
    D = jnp.where(incl, F[..., :, None] - F[..., None, :] + log_i[..., None, :], -jnp.inf)
    D_max = jnp.max(D, axis=-1)
    qk = jnp.einsum('nbhid,nbhjd->nbhij', q, k)
    G = log_i + F[..., -1:] - F
    G_max = jnp.max(G, axis=-1)

    def step(carry, xs):
        C, n, m = carry
        q_c, k_c, v_c, F_c, D_c, Dm_c, qk_c, G_c, Gm_c = xs
        inter = m[..., None] + F_c
        m_row = jnp.maximum(Dm_c, inter)
        Sm = jnp.exp(D_c - m_row[..., None]) * qk_c
        a = jnp.exp(inter - m_row)
        num = a[..., None] * jnp.einsum('bhld,bhde->bhle', q_c, C) + jnp.einsum('bhij,bhje->bhie', Sm, v_c)
        den = a * jnp.einsum('bhld,bhd->bhl', q_c, n) + jnp.sum(Sm, axis=-1)
        h = num / jnp.maximum(jnp.abs(den), jnp.exp(-m_row))[..., None]
        Fl = F_c[..., -1]
        m_new = jnp.maximum(m + Fl, Gm_c)
        dec = jnp.exp(m + Fl - m_new)
        wC = jnp.exp(G_c - m_new[..., None])
        C = dec[..., None, None] * C + jnp.einsum('bhl,bhld,bhle->bhde', wC, k_c, v_c)
        n = dec[..., None] * n + jnp.einsum('bhl,bhld->bhd', wC, k_c)
        return (C, n, m_new), h

    (C, n, m), h = lax.scan(step, (C0, n0, m0), (q, k, v, F, D, D_max, qk, G, G_max))
    return _from_chunks(h), C, n, m


def _mixer(h, conv_buf, S0, C0, n0, m0, w_in, gdn_conv_w, gdn_A_log, gdn_dt_bias, gdn_norm,
           ml_i_bias, ml_f_bias, ml_norm, w_branch_gdn, w_branch_ml, w_out):
    B, T, _ = h.shape
    f32 = jnp.float32
    (qg, kg, vg, zg, bg, ag, qm, km, vm, om, im, fm, gate_g, gate_m) = _split_cols(h @ w_in, IN_SPLITS)
    qkv, new_buf = _causal_conv_silu(jnp.concatenate([qg, kg, vg], axis=-1), conv_buf, gdn_conv_w)
    qg, kg, vg = _split_cols(qkv.astype(f32), (GDN_K, GDN_K, GDN_V))
    qg = _l2norm(qg.reshape(B, T, GDN_HEADS, GDN_DK)) * GDN_DK ** -0.5
    kg = _l2norm(kg.reshape(B, T, GDN_HEADS, GDN_DK))
    vg = vg.reshape(B, T, GDN_HEADS, GDN_DV)
    beta = jax.nn.sigmoid(bg.astype(f32))
    g = -jnp.exp(gdn_A_log.astype(f32)) * jax.nn.softplus(ag.astype(f32) + gdn_dt_bias.astype(f32))
    og, S_new = _gated_delta_chunked(qg, kg, vg, g, beta, S0.astype(f32))
    og = _head_rmsnorm(og, gdn_norm) * jax.nn.silu(zg.astype(f32)).reshape(B, T, GDN_HEADS, GDN_DV)
    br_g = og.reshape(B, T, GDN_V).astype(h.dtype) @ w_branch_gdn
    qm = qm.astype(f32).reshape(B, T, ML_HEADS, ML_DK) * ML_DK ** -0.5
    km = km.astype(f32).reshape(B, T, ML_HEADS, ML_DK)
    vm = vm.astype(f32).reshape(B, T, ML_HEADS, ML_DV)
    log_i = im.astype(f32) + ml_i_bias.astype(f32)
    log_f = jax.nn.log_sigmoid(fm.astype(f32) + ml_f_bias.astype(f32))
    hm, C_new, n_new, m_new = _mlstm_chunked(qm, km, vm, log_i, log_f,
                                            C0.astype(f32), n0.astype(f32), m0.astype(f32))
    hm = _head_rmsnorm(hm, ml_norm) * jax.nn.sigmoid(om.astype(f32)).reshape(B, T, ML_HEADS, ML_DV)
    br_m = hm.reshape(B, T, ML_V).astype(h.dtype) @ w_branch_ml
    merged = jax.nn.sigmoid(gate_g) * br_g + jax.nn.sigmoid(gate_m) * br_m
    dt = h.dtype
    return merged @ w_out, (new_buf.astype(dt), S_new.astype(dt), C_new.astype(dt), n_new.astype(dt), m_new.astype(dt))


def _trunk(x, conv_buf, gdn_S, ml_C, ml_n, ml_m, norm_mix, w_in, gdn_conv_w, gdn_A_log, gdn_dt_bias,
           gdn_norm, ml_i_bias, ml_f_bias, ml_norm, w_branch_gdn, w_branch_ml, w_out, norm_mlp,
           w_up, w_down, norm_final):
    new = ([], [], [], [], [])
    for l in range(DEPTH):
        mix, st = _mixer(_rmsnorm(x, norm_mix[l]), conv_buf[l], gdn_S[l], ml_C[l], ml_n[l], ml_m[l],
                         w_in[l], gdn_conv_w[l], gdn_A_log[l], gdn_dt_bias[l], gdn_norm[l],
                         ml_i_bias[l], ml_f_bias[l], ml_norm[l], w_branch_gdn[l], w_branch_ml[l], w_out[l])
        x = x + mix
        hmlp = _rmsnorm(x, norm_mlp[l])
        x = x + jnp.square(jax.nn.relu(hmlp @ w_up[l])) @ w_down[l]
        for lst, s in zip(new, st):
            lst.append(s)
    y = _rmsnorm(x, norm_final)
    conv_n, S_n, C_n, n_n, m_n = (jnp.stack(lst) for lst in new)
    return y, conv_n, S_n, C_n, n_n, m_n


def setup_inputs(seed: int = 0) -> dict:
    key = jax.random.key(seed)
    ks = jax.random.split(key, 24)
    f32 = jnp.float32

    def nrm(k, shape, scale):
        return jax.random.normal(k, shape, f32) * scale

    x_prompt = nrm(ks[0], (BATCH, SEQ, D_MODEL), 1.0)
    x_sample = nrm(ks[1], (DEC_BATCH, DEC_SEQ, D_MODEL), 1.0)
    state_gdn_conv = nrm(ks[2], (DEPTH, DEC_BATCH, CONV_W - 1, GDN_CONV_DIM), 1.0)
    state_gdn_S = nrm(ks[3], (DEPTH, DEC_BATCH, GDN_HEADS, GDN_DK, GDN_DV), GDN_DK ** -0.5)
    state_mlstm_C = nrm(ks[4], (DEPTH, DEC_BATCH, ML_HEADS, ML_DK, ML_DV), 0.1)
    state_mlstm_n = nrm(ks[5], (DEPTH, DEC_BATCH, ML_HEADS, ML_DK), 0.1)
    state_mlstm_m = jax.random.uniform(ks[6], (DEPTH, DEC_BATCH, ML_HEADS), f32, 0.0, 3.0)
    norm_mix = 1.0 + nrm(ks[7], (DEPTH, D_MODEL), 0.02)
    w_in = nrm(ks[8], (DEPTH, D_MODEL, IN_DIM), D_MODEL ** -0.5)
    gdn_conv_w = nrm(ks[9], (DEPTH, CONV_W, GDN_CONV_DIM), CONV_W ** -0.5)
    gdn_A_log = jnp.log(jax.random.uniform(ks[10], (DEPTH, GDN_HEADS), f32, 0.5, 4.0))
    dt0 = jnp.exp(jax.random.uniform(ks[11], (DEPTH, GDN_HEADS), f32, math.log(1e-3), math.log(1e-1)))
    gdn_dt_bias = dt0 + jnp.log(-jnp.expm1(-dt0))
    gdn_norm = 1.0 + nrm(ks[12], (DEPTH, GDN_DV), 0.02)
    ml_i_bias = nrm(ks[13], (DEPTH, ML_HEADS), 0.1) - 1.0
    ml_f_bias = jax.random.uniform(ks[14], (DEPTH, ML_HEADS), f32, 3.0, 6.0)
    ml_norm = 1.0 + nrm(ks[15], (DEPTH, ML_V), 0.02)
    w_branch_gdn = nrm(ks[16], (DEPTH, GDN_V, D_MODEL), GDN_V ** -0.5)
    w_branch_ml = nrm(ks[17], (DEPTH, ML_V, D_MODEL), ML_V ** -0.5)
    w_out = nrm(ks[18], (DEPTH, D_MODEL, D_MODEL), D_MODEL ** -0.5)
    norm_mlp = 1.0 + nrm(ks[19], (DEPTH, D_MODEL), 0.02)
    w_up = nrm(ks[20], (DEPTH, D_MODEL, D_FF), D_MODEL ** -0.5)
    w_down = nrm(ks[21], (DEPTH, D_FF, D_MODEL), D_FF ** -0.5)
    norm_final = 1.0 + nrm(ks[22], (D_MODEL,), 0.02)
    return {'x_prompt': x_prompt, 'x_sample': x_sample,
            'state_gdn_conv': state_gdn_conv, 'state_gdn_S': state_gdn_S,
            'state_mlstm_C': state_mlstm_C, 'state_mlstm_n': state_mlstm_n, 'state_mlstm_m': state_mlstm_m,
            'norm_mix': norm_mix, 'w_in': w_in, 'gdn_conv_w': gdn_conv_w, 'gdn_A_log': gdn_A_log,
            'gdn_dt_bias': gdn_dt_bias, 'gdn_norm': gdn_norm, 'ml_i_bias': ml_i_bias, 'ml_f_bias': ml_f_bias,
            'ml_norm': ml_norm, 'w_branch_gdn': w_branch_gdn, 'w_branch_ml': w_branch_ml, 'w_out': w_out,
            'norm_mlp': norm_mlp, 'w_up': w_up, 'w_down': w_down, 'norm_final': norm_final}


def reference(x_prompt, x_sample, state_gdn_conv, state_gdn_S, state_mlstm_C, state_mlstm_n, state_mlstm_m,
              norm_mix, w_in, gdn_conv_w, gdn_A_log, gdn_dt_bias, gdn_norm, ml_i_bias, ml_f_bias, ml_norm,
              w_branch_gdn, w_branch_ml, w_out, norm_mlp, w_up, w_down, norm_final):
    B = x_prompt.shape[0]
    dt = x_prompt.dtype
    z_conv = jnp.zeros((DEPTH, B, CONV_W - 1, GDN_CONV_DIM), dt)
    z_S = jnp.zeros((DEPTH, B, GDN_HEADS, GDN_DK, GDN_DV), dt)
    z_C = jnp.zeros((DEPTH, B, ML_HEADS, ML_DK, ML_DV), dt)
    z_n = jnp.zeros((DEPTH, B, ML_HEADS, ML_DK), dt)
    z_m = jnp.zeros((DEPTH, B, ML_HEADS), dt)
    y_prompt, conv_p, S_p, C_p, n_p, m_p = _trunk(
        x_prompt, z_conv, z_S, z_C, z_n, z_m, norm_mix, w_in, gdn_conv_w, gdn_A_log, gdn_dt_bias,
        gdn_norm, ml_i_bias, ml_f_bias, ml_norm, w_branch_gdn, w_branch_ml, w_out, norm_mlp,
        w_up, w_down, norm_final)
    y_sample, conv_s, S_s, C_s, n_s, m_s = _trunk(
        x_sample, state_gdn_conv, state_gdn_S, state_mlstm_C, state_mlstm_n, state_mlstm_m,
        norm_mix, w_in, gdn_conv_w, gdn_A_log, gdn_dt_bias, gdn_norm, ml_i_bias, ml_f_bias, ml_norm,
        w_branch_gdn, w_branch_ml, w_out, norm_mlp, w_up, w_down, norm_final)
    return (y_prompt, y_sample, conv_p, S_p, C_p, n_p, m_p, conv_s, S_s, C_s, n_s, m_s)
```

```cpp
#include <hip/hip_runtime.h>
#include <cstdio>
#include <cstdint>

#ifndef MK_ONE_LAUNCH
#define MK_ONE_LAUNCH 1
#endif

namespace pg8 {
#define PG8_LAS __attribute__((address_space(3)))
typedef unsigned short bf16_t;
typedef short bf16x8 __attribute__((ext_vector_type(8)));
typedef float f32x4 __attribute__((ext_vector_type(4)));
typedef unsigned u32x4 __attribute__((ext_vector_type(4)));
constexpr int BM = 256, BK = 64, HALF = 128, HTB = HALF * BK * 2  , STAGE_BYTES = 8 * HTB, NXCD = 8, WGM = 2;

__host__ __device__ __forceinline__ int lds_byte(int r, int c) { const int st = (r >> 4) * 2 + (c >> 5), rr = r & 15, cc = c & 31, ob = rr * 64 + cc * 2; return st * 1024 + (ob ^ (((ob >> 9) & 1) << 5)); }
__host__ __device__ __forceinline__ void stage_rc(int b, int& R, int& C) { const int st = b / 1024, sb = b % 1024, swz = sb ^ (((sb >> 9) & 1) << 5); R = (st >> 1) * 16 + swz / 64; C = (st & 1) * 32 + (swz % 64) / 2; }
__host__ __device__ __forceinline__ int perm32(int rho) { const int n = rho >> 4, i = rho & 15; return 8 * (i >> 2) + 4 * n + (i & 3); }

struct Unit { int pm, pn, k0, nt, part; };
template <int LDA_, int LDB_, int K_> struct Gemm { static constexpr int lda = LDA_, ldb = LDB_, K = K_; const bf16_t* A; const bf16_t* Bt; };

template <int M_, int N_, int K_> struct StaticOrder {
    static constexpr int nM = M_ / BM, nN = N_ / BM, nwg = nM * nN;
    int G, c; unsigned* cnt; unsigned need;
    __host__ __device__ void init(int G_, int c_) { G = G_; c = c_; cnt = nullptr; need = 0u; }
    __host__ __device__ static void tile_of(int wgid, Unit& u) {
        { const int q = nwg / NXCD, r = nwg % NXCD, xcd = wgid % NXCD, off = wgid / NXCD; wgid = (xcd < r ? xcd * (q + 1) : r * (q + 1) + (xcd - r) * q) + off; }
        const int nig = WGM * nN, gid = wgid / nig, fm = gid * WGM, gsz = (nM - fm) < WGM ? (nM - fm) : WGM;
        u.pm = fm + ((wgid % nig) % gsz); u.pn = (wgid % nig) / gsz;
    }
    __host__ __device__ bool next(int i, Unit& u) const {
        const long L = (long)i * G + c; if (L >= nwg) return false;
        tile_of((int)L, u); u.k0 = 0; u.nt = K_ / BK; u.part = -1; return true;
    }
    __device__ __forceinline__ void a_ready(const Unit& u) const {
        if (cnt == nullptr || u.pm < 64) return;
        if (threadIdx.x < 64) { unsigned sp = 0;
            while ((unsigned)__builtin_amdgcn_readfirstlane(__hip_atomic_load(cnt, __ATOMIC_RELAXED, __HIP_MEMORY_SCOPE_AGENT)) < need) { __builtin_amdgcn_s_sleep(2); if (++sp > (1u << 22)) break; }
            __builtin_amdgcn_fence(__ATOMIC_ACQUIRE, "agent");
            asm volatile("s_waitcnt vmcnt(0)" ::: "memory"); }
        asm volatile("" ::: "memory"); __builtin_amdgcn_s_barrier(); asm volatile("" ::: "memory");
    }
    __device__ __forceinline__ void done(const Unit&) const {}
};
__device__ __forceinline__ void soft_arrive(unsigned* cnt) {
    asm volatile("s_waitcnt vmcnt(0)" ::: "memory");
    __syncthreads();
    if (threadIdx.x == 0) { __builtin_amdgcn_fence(__ATOMIC_RELEASE, "agent"); asm volatile("s_waitcnt vmcnt(0)" ::: "memory");
        (void)__hip_atomic_fetch_add(cnt, 1u, __ATOMIC_RELAXED, __HIP_MEMORY_SCOPE_AGENT); }
}
template <int K_, int NP_, int N_ = 1024> struct SplitOrder {
    typedef StaticOrder<16384, N_, K_> Base;
    static constexpr int NTS = N_ / BM, NSUB = 2 * NTS * NP_;
    int G, c; unsigned* cnt; unsigned need;
    __host__ __device__ void init(int G_, int c_) { G = G_; c = c_; cnt = nullptr; need = 0u; }
    __host__ __device__ bool next(int i, Unit& u) const {
        const long L = (long)i * G + c; if (L >= Base::nwg + NSUB) return false;
        if (L < Base::nwg) { Base::tile_of((int)L, u); u.k0 = 0; u.nt = K_ / BK; u.part = -1; return true; }
        const int s = (int)L - Base::nwg, t = s / NP_, p = s % NP_;
        u.pm = 64 + t / NTS; u.pn = t % NTS; u.k0 = p * (K_ / NP_); u.nt = K_ / NP_ / BK; u.part = s; return true;
    }
    __device__ __forceinline__ void a_ready(const Unit& u) const {
        if (cnt == nullptr || u.part < 0) return;
        if (threadIdx.x < 64) { unsigned sp = 0;
            while ((unsigned)__builtin_amdgcn_readfirstlane(__hip_atomic_load(cnt, __ATOMIC_RELAXED, __HIP_MEMORY_SCOPE_AGENT)) < need) { __builtin_amdgcn_s_sleep(2); if (++sp > (1u << 22)) break; }
            __builtin_amdgcn_fence(__ATOMIC_ACQUIRE, "agent");
            asm volatile("s_waitcnt vmcnt(0)" ::: "memory"); }
        asm volatile("" ::: "memory"); __builtin_amdgcn_s_barrier(); asm volatile("" ::: "memory");
    }
    __device__ __forceinline__ void done(const Unit&) const {}
};
struct SplitSrcOrder {
    typedef StaticOrder<16384, 1024, 1024> Base;
    int G, c;
    __host__ __device__ void init(int G_, int c_) { G = G_; c = c_; }
    __host__ __device__ bool next(int i, Unit& u) const {
        const long L = (long)i * G + c; if (L >= Base::nwg + 16) return false;
        if (L < Base::nwg) { Base::tile_of((int)L, u); u.k0 = 0; u.nt = 16; u.part = -1; return true; }
        const int s = (int)L - Base::nwg, t = s >> 1;
        u.pm = 64 + (t >> 2); u.pn = t & 3; u.k0 = 512 * (s & 1); u.nt = 8; u.part = s; return true;
    }
    __device__ __forceinline__ void a_ready(const Unit&) const {}
    __device__ __forceinline__ void done(const Unit&) const {}
};

typedef __bf16 bf16x2_hw __attribute__((ext_vector_type(2)));
__device__ __forceinline__ unsigned cvt_pk_bf16(float lo, float hi) { const bf16x2_hw v = {(__bf16)lo, (__bf16)hi}; return __builtin_bit_cast(unsigned, v); }
__device__ __forceinline__ void st16_wt(void* p, u32x4 v) { asm volatile("global_store_dwordx4 %0, %1, off sc1\n\ts_nop 1" :: "v"(p), "v"(v) : "memory"); }
__device__ __forceinline__ void st16_wt(void* p, f32x4 v) { st16_wt(p, __builtin_bit_cast(u32x4, v)); }
__device__ __forceinline__ float bf_lo(unsigned w) { return __builtin_bit_cast(float, w << 16); }
__device__ __forceinline__ float bf_hi(unsigned w) { return __builtin_bit_cast(float, w & 0xffff0000u); }
__device__ __forceinline__ float sigmoidf_(float x) { return __builtin_amdgcn_rcpf(1.0f + __expf(-x)); }

constexpr int MP_ROWS = 16384;
constexpr int LDP = 5648;

struct EpiProj {
    static constexpr bool PERM = true, AFTER_DRAIN = false, HAS_INIT = false; static constexpr int MIDT = 0;
    bf16_t* P; float* gates; bf16_t* halo;
    __device__ __forceinline__ void operator()(const f32x4 (&acc)[2][2][4][2], const Unit& u, int wr, int wc, int fr, int fq) const {
        const int row0 = u.pm * BM + wr * 64 + fr;
        if (u.pn < 22) {
            const int col0 = u.pn * BM + wc * 32 + 8 * fq;
#pragma unroll
            for (int ai = 0; ai < 2; ++ai)
#pragma unroll
                for (int m = 0; m < 4; ++m) { const int r = row0 + ai * HALF + m * 16; bf16_t* rowp = P + (size_t)r * LDP + col0;
#pragma unroll
                    for (int bj = 0; bj < 2; ++bj) { f32x4 v0 = acc[ai][bj][m][0], v1 = acc[ai][bj][m][1];
                        if (u.pn >= 14) {
#pragma unroll
                            for (int e = 0; e < 4; ++e) { v0[e] = sigmoidf_(v0[e]); v1[e] = sigmoidf_(v1[e]); } }
                        u32x4 w; w.x = cvt_pk_bf16(v0[0], v0[1]); w.y = cvt_pk_bf16(v0[2], v0[3]); w.z = cvt_pk_bf16(v1[0], v1[1]); w.w = cvt_pk_bf16(v1[2], v1[3]);
                        *(u32x4*)(rowp + bj * HALF) = w;
                        if (m == 3 && u.pn < 6 && fr >= 13 && r < MP_ROWS) *(u32x4*)(halo + ((size_t)(r >> 6) * 3 + (fr - 13)) * 1536 + col0 + bj * HALF) = w; } }
        } else if (wc == 0 && fq < 2) {
#pragma unroll
            for (int ai = 0; ai < 2; ++ai)
#pragma unroll
                for (int m = 0; m < 4; ++m) { const int r = row0 + ai * HALF + m * 16; float* gp = gates + (size_t)r * 16 + 8 * fq;
                    *(f32x4*)gp = acc[ai][0][m][0]; *(f32x4*)(gp + 4) = acc[ai][0][m][1]; }
        }
    }
};
struct EpiRelu2 {
    static constexpr bool PERM = true, AFTER_DRAIN = false, HAS_INIT = false; static constexpr int MIDT = 0;
    bf16_t* H; float* slab;
    __device__ __forceinline__ void operator()(const f32x4 (&acc)[2][2][4][2], const Unit& u, int wr, int wc, int fr, int fq) const {
        if (u.part >= 0) {
            float* sb = slab + (size_t)u.part * 65536 + (size_t)(wr * 64 + fr) * 256 + wc * 32 + 8 * fq;
#pragma unroll
            for (int ai = 0; ai < 2; ++ai)
#pragma unroll
                for (int m = 0; m < 4; ++m)
#pragma unroll
                    for (int bj = 0; bj < 2; ++bj)
#pragma unroll
                        for (int n = 0; n < 2; ++n) *(f32x4*)(sb + (ai * HALF + m * 16) * 256 + bj * HALF + 4 * n) = acc[ai][bj][m][n];
            return;
        }
        const int row0 = u.pm * BM + wr * 64 + fr, col0 = u.pn * BM + wc * 32 + 8 * fq;
#pragma unroll
        for (int ai = 0; ai < 2; ++ai)
#pragma unroll
            for (int m = 0; m < 4; ++m) { bf16_t* rowp = H + (size_t)(row0 + ai * HALF + m * 16) * 4096 + col0;
#pragma unroll
                for (int bj = 0; bj < 2; ++bj) { f32x4 v0 = acc[ai][bj][m][0], v1 = acc[ai][bj][m][1];
#pragma unroll
                    for (int e = 0; e < 4; ++e) { const float a = fmaxf(v0[e], 0.f), b = fmaxf(v1[e], 0.f); v0[e] = a * a; v1[e] = b * b; }
                    u32x4 w; w.x = cvt_pk_bf16(v0[0], v0[1]); w.y = cvt_pk_bf16(v0[2], v0[3]); w.z = cvt_pk_bf16(v1[0], v1[1]); w.w = cvt_pk_bf16(v1[2], v1[3]);
                    *(u32x4*)(rowp + bj * HALF) = w; } }
    }
};
struct EpiResid {
    static constexpr bool PERM = false, AFTER_DRAIN = false, HAS_INIT = false; static constexpr int MIDT = 0;
    const float* in_p; const float* in_s; float* out; float* slab;
    __device__ __forceinline__ void operator()(const f32x4 (&acc)[2][2][4][2], const Unit& u, int wr, int wc, int fr, int fq) const {
        if (u.part >= 0) {
            float* sb = slab + (size_t)u.part * 65536 + (size_t)(wr * 64 + fr) * 256 + wc * 32 + 4 * fq;
#pragma unroll
            for (int ai = 0; ai < 2; ++ai)
#pragma unroll
                for (int m = 0; m < 4; ++m)
#pragma unroll
                    for (int bj = 0; bj < 2; ++bj)
#pragma unroll
                        for (int n = 0; n < 2; ++n) *(f32x4*)(sb + (ai * HALF + m * 16) * 256 + bj * HALF + n * 16) = acc[ai][bj][m][n];
            return;
        }
        const int row0 = u.pm * BM + wr * 64 + fr, col0 = u.pn * BM + wc * 32 + 4 * fq;
        const float* inb = (u.pm < 64) ? in_p + (size_t)row0 * 1024 : in_s + (size_t)(row0 - MP_ROWS) * 1024;
        float* outb = out + (size_t)row0 * 1024;
#pragma unroll
        for (int ai = 0; ai < 2; ++ai)
#pragma unroll
            for (int m = 0; m < 4; ++m) { const size_t off = (size_t)(ai * HALF + m * 16) * 1024 + col0;
#pragma unroll
                for (int bj = 0; bj < 2; ++bj)
#pragma unroll
                    for (int n = 0; n < 2; ++n) { const f32x4 xi = *(const f32x4*)(inb + off + bj * HALF + n * 16); *(f32x4*)(outb + off + bj * HALF + n * 16) = xi + acc[ai][bj][m][n]; } }
    }
};
template <int FUSE> struct EpiResidN {
    static constexpr bool PERM = false, AFTER_DRAIN = false, HAS_INIT = true;  static constexpr int MIDT = 0;
    const float* in_p; const float* in_s; float* out; float* slab; bf16_t* xn; const float* w; unsigned* slots; unsigned* cnt; PG8_LAS unsigned char* lx;
    __device__ __forceinline__ void init(f32x4 (&acc)[2][2][4][2], const Unit& u, int wr, int wc, int fr, int fq) const {
        if (u.part >= 0) { float z0_ = 0.f; asm volatile("" : "+v"(z0_));
#pragma unroll
            for (int ai = 0; ai < 2; ++ai)
#pragma unroll
                for (int bj = 0; bj < 2; ++bj)
#pragma unroll
                    for (int m = 0; m < 4; ++m)
#pragma unroll
                        for (int n = 0; n < 2; ++n) acc[ai][bj][m][n] = (f32x4){z0_, z0_, z0_, z0_};
            return; }
        const int row0 = u.pm * BM + wr * 64 + fr, col0 = u.pn * BM + wc * 32 + 4 * fq;
        const float* inb = ((u.pm < 64) ? in_p + (size_t)row0 * 1024 : in_s + (size_t)(row0 - MP_ROWS) * 1024) + col0;
#pragma unroll
        for (int ai = 0; ai < 2; ++ai)
#pragma unroll
            for (int m = 0; m < 4; ++m)
#pragma unroll
                for (int bj = 0; bj < 2; ++bj)
#pragma unroll
                    for (int n = 0; n < 2; ++n) acc[ai][bj][m][n] = *(const f32x4*)(inb + (size_t)(ai * HALF + m * 16) * 1024 + bj * HALF + n * 16);
    }
    __device__ __forceinline__ void operator()(f32x4 (&acc)[2][2][4][2], const Unit& u, int wr, int wc, int fr, int fq) const {
        if (u.part >= 0) {
            float* sb = slab + (size_t)u.part * 65536 + (size_t)(wr * 64 + fr) * 256 + wc * 32 + 4 * fq;
#pragma unroll
            for (int ai = 0; ai < 2; ++ai)
#pragma unroll
                for (int m = 0; m < 4; ++m)
#pragma unroll
                    for (int bj = 0; bj < 2; ++bj)
#pragma unroll
                        for (int n = 0; n < 2; ++n) *(f32x4*)(sb + (ai * HALF + m * 16) * 256 + bj * HALF + n * 16) = acc[ai][bj][m][n];
            return;
        }
        const int row0 = u.pm * BM + wr * 64 + fr, col0 = u.pn * BM + wc * 32 + 4 * fq;
        float* outb = out + (size_t)row0 * 1024;
        PG8_LAS float* P = (PG8_LAS float*)lx;
        PG8_LAS float* S = (PG8_LAS float*)(lx + 4096);
#pragma unroll
        for (int ai = 0; ai < 2; ++ai)
#pragma unroll
            for (int m = 0; m < 4; ++m) { float q = 0.f;
#pragma unroll
                for (int bj = 0; bj < 2; ++bj)
#pragma unroll
                    for (int n = 0; n < 2; ++n) { const f32x4 xo_ = acc[ai][bj][m][n];
                        if constexpr (FUSE == 1) *(f32x4*)(outb + (size_t)(ai * HALF + m * 16) * 1024 + col0 + bj * HALF + n * 16) = xo_;
                        q += (xo_[0] * xo_[0] + xo_[1] * xo_[1]) + (xo_[2] * xo_[2] + xo_[3] * xo_[3]); }
                q += __shfl_xor(q, 16); q += __shfl_xor(q, 32); if (fq == 0) P[(ai * HALF + wr * 64 + m * 16 + fr) * 4 + wc] = q; }
        asm volatile("s_waitcnt lgkmcnt(0)" ::: "memory"); __builtin_amdgcn_s_barrier(); asm volatile("" ::: "memory");
        const int wid = wr * 4 + wc, lane = fq * 16 + fr, row = wid * 32 + (lane & 31);
        unsigned* sl = slots + ((size_t)(u.pm * BM + row) * 4);
        if (lane < 32) { const f32x4 p = *(const PG8_LAS f32x4*)(P + row * 4);
            __hip_atomic_store(sl + u.pn, __builtin_bit_cast(unsigned, (p[0] + p[1]) + (p[2] + p[3])), __ATOMIC_RELAXED, __HIP_MEMORY_SCOPE_AGENT); }
        asm volatile("s_waitcnt vmcnt(0)" ::: "memory");
        if (lane == 0) (void)__hip_atomic_fetch_add(cnt + 64 * u.pm, 1u, __ATOMIC_RELAXED, __HIP_MEMORY_SCOPE_AGENT);
        if (wid == 0) { unsigned sp = 0;
            while ((unsigned)__builtin_amdgcn_readfirstlane(__hip_atomic_load(cnt + 64 * u.pm, __ATOMIC_RELAXED, __HIP_MEMORY_SCOPE_AGENT)) < 32u) { __builtin_amdgcn_s_sleep(2); if (++sp > (1u << 22)) break; }
            __builtin_amdgcn_fence(__ATOMIC_ACQUIRE, "agent"); }
        asm volatile("s_waitcnt vmcnt(0) lgkmcnt(0)" ::: "memory"); __builtin_amdgcn_s_barrier(); asm volatile("" ::: "memory");
        if (lane < 32) { float t = 0.f;
#pragma unroll
            for (int k = 0; k < 4; ++k) t += __builtin_bit_cast(float, __hip_atomic_load(sl + k, __ATOMIC_RELAXED, __HIP_MEMORY_SCOPE_AGENT));
            S[row] = __builtin_amdgcn_rsqf(t * (1.0f / 1024.0f) + 1e-6f); }
        asm volatile("s_waitcnt lgkmcnt(0)" ::: "memory"); __builtin_amdgcn_s_barrier(); asm volatile("" ::: "memory");
        f32x4 wv[2][2];
#pragma unroll
        for (int bj = 0; bj < 2; ++bj)
#pragma unroll
            for (int n = 0; n < 2; ++n) wv[bj][n] = *(const f32x4*)(w + col0 + bj * HALF + n * 16);
        typedef unsigned u32x2_ __attribute__((ext_vector_type(2)));
        bf16_t* xb = xn + (size_t)row0 * 1024 + col0;
#pragma unroll
        for (int ai = 0; ai < 2; ++ai)
#pragma unroll
            for (int m = 0; m < 4; ++m) { const float rs = S[ai * HALF + wr * 64 + m * 16 + fr];
#pragma unroll
                for (int bj = 0; bj < 2; ++bj)
#pragma unroll
                    for (int n = 0; n < 2; ++n) { const f32x4 v = acc[ai][bj][m][n] * rs * wv[bj][n];
                        if constexpr (FUSE == 1) { u32x2_ o; o.x = cvt_pk_bf16(v[0], v[1]); o.y = cvt_pk_bf16(v[2], v[3]);
                            *(u32x2_*)(xb + (size_t)(ai * HALF + m * 16) * 1024 + bj * HALF + n * 16) = o; }
                        else *(f32x4*)(outb + (size_t)(ai * HALF + m * 16) * 1024 + col0 + bj * HALF + n * 16) = v; } }
    }
};
struct EpiMerge {
    static constexpr bool PERM = true, AFTER_DRAIN = false, HAS_INIT = false; static constexpr int MIDT = 8;
    const bf16_t* GG; const bf16_t* GM; bf16_t* O; float* slab;
    __device__ __forceinline__ void mid(f32x4 (&acc)[2][2][4][2], const Unit& u, int wr, int wc, int fr, int fq) const {
        int z_ = 0; asm volatile("" : "+v"(z_));
        const int row0 = u.pm * BM + wr * 64 + fr + z_, col0 = u.pn * BM + wc * 32 + 8 * fq;
#pragma unroll
        for (int ai = 0; ai < 2; ++ai)
#pragma unroll
            for (int m = 0; m < 4; ++m) { const size_t ro = (size_t)(row0 + ai * HALF + m * 16) * LDP + col0;
#pragma unroll
                for (int bj = 0; bj < 2; ++bj) { const u32x4 a = *(const u32x4*)(GG + ro + bj * HALF), b = *(const u32x4*)(GM + ro + bj * HALF);
                    float ga[8] = {bf_lo(a.x), bf_hi(a.x), bf_lo(a.y), bf_hi(a.y), bf_lo(a.z), bf_hi(a.z), bf_lo(a.w), bf_hi(a.w)};
                    float gb[8] = {bf_lo(b.x), bf_hi(b.x), bf_lo(b.y), bf_hi(b.y), bf_lo(b.z), bf_hi(b.z), bf_lo(b.w), bf_hi(b.w)};
#pragma unroll
                    for (int e = 0; e < 8; ++e) { const float r = ga[e] * __builtin_amdgcn_rcpf(fmaxf(gb[e], 1e-30f));
                        if (e < 4) acc[ai][bj][m][0][e] *= r; else acc[ai][bj][m][1][e - 4] *= r; } }
                if (m == 3) asm volatile("" ::: "memory"); }
    }
    __device__ __forceinline__ void operator()(const f32x4 (&acc)[2][2][4][2], const Unit& u, int wr, int wc, int fr, int fq) const {
        if (u.part >= 0) {
            float* sb = slab + (size_t)u.part * 65536 + (size_t)(wr * 64 + fr) * 256 + wc * 32 + 8 * fq;
#pragma unroll
            for (int ai = 0; ai < 2; ++ai)
#pragma unroll
                for (int m = 0; m < 4; ++m)
#pragma unroll
                    for (int bj = 0; bj < 2; ++bj)
#pragma unroll
                        for (int n = 0; n < 2; ++n) *(f32x4*)(sb + (ai * HALF + m * 16) * 256 + bj * HALF + 4 * n) = acc[ai][bj][m][n];
            return;
        }
        const int row0 = u.pm * BM + wr * 64 + fr, col0 = u.pn * BM + wc * 32 + 8 * fq;
#pragma unroll
        for (int ai = 0; ai < 2; ++ai)
#pragma unroll
            for (int m = 0; m < 4; ++m) { const int r = row0 + ai * HALF + m * 16;
#pragma unroll
                for (int bj = 0; bj < 2; ++bj) { const u32x4 b = *(const u32x4*)(GM + (size_t)r * LDP + col0 + bj * HALF); const f32x4 v0 = acc[ai][bj][m][0], v1 = acc[ai][bj][m][1];
                    const float gb[8] = {bf_lo(b.x), bf_hi(b.x), bf_lo(b.y), bf_hi(b.y), bf_lo(b.z), bf_hi(b.z), bf_lo(b.w), bf_hi(b.w)};
                    float o[8];
#pragma unroll
                    for (int e = 0; e < 8; ++e) o[e] = (e < 4 ? v0[e] : v1[e - 4]) * fmaxf(gb[e], 1e-30f);
                    u32x4 w; w.x = cvt_pk_bf16(o[0], o[1]); w.y = cvt_pk_bf16(o[2], o[3]); w.z = cvt_pk_bf16(o[4], o[5]); w.w = cvt_pk_bf16(o[6], o[7]);
                    *(u32x4*)(O + (size_t)r * 1024 + col0 + bj * HALF) = w; } }
    }
};

template <class GemmT, class Epi, class Sched, bool ALIGN_EPI = false, bool SP2 = false>
__device__ __forceinline__ void gemm_phase(PG8_LAS unsigned char* lds, const GemmT g, const Sched& S, const Epi& E, const int tid) {
    const int wid = __builtin_amdgcn_readfirstlane(tid >> 6), lane = tid & 63, wr = wid >> 2, wc = wid & 3, fr = lane & 15, fq = lane >> 4;
    constexpr int K = GemmT::K;
    unsigned voffA[2], voffB[2];
#pragma unroll
    for (int i = 0; i < 2; ++i) { int R, C; stage_rc(tid * 16 + i * 8192, R, C); const int Rb = Epi::PERM ? ((R & ~31) + perm32(R & 31)) : R;
        voffA[i] = (unsigned)(R * GemmT::lda + C) * 2u; voffB[i] = (unsigned)(Rb * GemmT::ldb + C) * 2u; }
    constexpr size_t kstep = (size_t)(BK * 2);
    constexpr size_t hstepA = (size_t)HALF * GemmT::lda * 2, hstepB = (size_t)HALF * GemmT::ldb * 2;
    constexpr size_t tstepA = 2 * hstepA, tstepB = 2 * hstepB;
    const unsigned ldsw = (unsigned)wid * 1024u;
    const int aoff = lds_byte(wr * 64 + fr, fq * 8), boff = lds_byte(wc * 32 + fr, fq * 8);
#define PG8_SA(b, h) (((b) * 2 + (h)) * HTB)
#define PG8_SB(b, h) ((4 + (b) * 2 + (h)) * HTB)
#define PG8_STAGE(bufoff, gbase, voff) do { _Pragma("unroll") for (int _i = 0; _i < 2; ++_i) \
        __builtin_amdgcn_global_load_lds((const unsigned*)((const char*)(gbase) + (voff)[_i]), (PG8_LAS unsigned*)(lds + (bufoff) + ldsw + _i * 8192), 16, 0, 0); } while (0)
#define PG8_LDA(dst, b, h) do { _Pragma("unroll") for (int m = 0; m < 4; ++m) _Pragma("unroll") for (int k = 0; k < 2; ++k) dst[m][k] = *(const PG8_LAS bf16x8*)(lds + PG8_SA(b, h) + aoff + m * 2048 + k * 1024); } while (0)
#define PG8_LDB(dst, b, h) do { _Pragma("unroll") for (int n = 0; n < 2; ++n) _Pragma("unroll") for (int k = 0; k < 2; ++k) dst[n][k] = *(const PG8_LAS bf16x8*)(lds + PG8_SB(b, h) + boff + n * 2048 + k * 1024); } while (0)
#define PG8_MMA(ai, bj, At, Bt) do { __builtin_amdgcn_s_setprio(1); _Pragma("unroll") for (int m = 0; m < 4; ++m) _Pragma("unroll") for (int n = 0; n < 2; ++n) _Pragma("unroll") for (int k = 0; k < 2; ++k) \
        acc[ai][bj][m][n] = __builtin_amdgcn_mfma_f32_16x16x32_bf16(Bt[n][k], At[m][k], acc[ai][bj][m][n], 0, 0, 0); __builtin_amdgcn_s_setprio(0); } while (0)
#define PG8_WAIT_V(n) asm volatile("s_waitcnt vmcnt(" #n ")" ::: "memory")
#define PG8_WAIT_L(n) asm volatile("s_waitcnt lgkmcnt(" #n ")" ::: "memory")
#define PG8_BAR __builtin_amdgcn_s_barrier()
#define PG8_SCHED __builtin_amdgcn_sched_barrier(0)
    Unit cur, nxt; int ui = 0;
    if (!S.next(0, cur)) return;
    f32x4 acc[2][2][4][2];
    if constexpr (Epi::HAS_INIT) E.init(acc, cur, wr, wc, fr, fq);
    else {
#pragma unroll
    for (int a = 0; a < 2; ++a)
#pragma unroll
        for (int b = 0; b < 2; ++b)
#pragma unroll
            for (int m = 0; m < 4; ++m)
#pragma unroll
                for (int n = 0; n < 2; ++n) acc[a][b][m][n] = (f32x4){0.f, 0.f, 0.f, 0.f};
    }
    bf16x8 At[4][2], B0[2][2], B1[2][2];
    const char* cA = (const char*)g.A + (size_t)cur.pm * tstepA + (size_t)cur.k0 * 2; const char* cB = (const char*)g.Bt + (size_t)cur.pn * tstepB + (size_t)cur.k0 * 2;
    S.a_ready(cur);
    if constexpr (SP2) {
        PG8_STAGE(PG8_SB(0, 0), cB, voffB); PG8_STAGE(PG8_SB(0, 1), cB + hstepB, voffB); PG8_STAGE(PG8_SA(0, 0), cA, voffA); PG8_STAGE(PG8_SA(0, 1), cA + hstepA, voffA);
        if (wr == 1) PG8_BAR;
        PG8_WAIT_V(2); PG8_BAR;
        PG8_STAGE(PG8_SB(1, 0), cB + kstep, voffB); PG8_STAGE(PG8_SA(1, 0), cA + kstep, voffA); PG8_STAGE(PG8_SB(1, 1), cB + hstepB + kstep, voffB);
        PG8_WAIT_V(6); PG8_BAR;
    } else {
        PG8_STAGE(PG8_SB(0, 0), cB, voffB); PG8_STAGE(PG8_SA(0, 0), cA, voffA); PG8_STAGE(PG8_SB(0, 1), cB + hstepB, voffB); PG8_STAGE(PG8_SA(0, 1), cA + hstepA, voffA);
        if (wr == 1) PG8_BAR;
        PG8_WAIT_V(4); PG8_BAR;
        PG8_STAGE(PG8_SB(1, 0), cB + kstep, voffB); PG8_STAGE(PG8_SA(1, 0), cA + kstep, voffA); PG8_STAGE(PG8_SB(1, 1), cB + hstepB + kstep, voffB);
        PG8_WAIT_V(6); PG8_BAR;
    }
    for (;;) {
        const bool has_next = S.next(ui + 1, nxt);
        const char* nA = has_next ? (const char*)g.A + (size_t)nxt.pm * tstepA + (size_t)nxt.k0 * 2 : cA; const char* nB = has_next ? (const char*)g.Bt + (size_t)nxt.pn * tstepB + (size_t)nxt.k0 * 2 : cB;
        const int nt = cur.nt;
#pragma unroll 1
        for (int t = 0; t < nt; t += 2) {
            if constexpr (Epi::MIDT > 0) { if (t == Epi::MIDT) E.mid(acc, cur, wr, wc, fr, fq); }
            const bool last = (t == nt - 2);
            const char* a1 = cA + (size_t)(t + 1) * kstep;
            const char* a2 = last ? nA : cA + (size_t)(t + 2) * kstep; const char* b2 = last ? nB : cB + (size_t)(t + 2) * kstep;
            const char* a3 = a2 + kstep; const char* b3 = b2 + kstep;
            if (last && has_next) S.a_ready(nxt);
            if constexpr (SP2) {
            PG8_LDB(B0, 0, 0); PG8_LDB(B1, 0, 1); PG8_SCHED; PG8_LDA(At, 0, 0); PG8_STAGE(PG8_SA(1, 1), a1 + hstepA, voffA);
            PG8_WAIT_V(8); PG8_WAIT_L(0); PG8_BAR; PG8_MMA(0, 0, At, B0); PG8_MMA(0, 1, At, B1); PG8_BAR; PG8_SCHED;
            PG8_LDA(At, 0, 1); PG8_STAGE(PG8_SB(0, 0), b2, voffB); PG8_STAGE(PG8_SB(0, 1), b2 + hstepB, voffB); PG8_STAGE(PG8_SA(0, 0), a2, voffA);
            PG8_WAIT_V(8); PG8_WAIT_L(0); PG8_BAR; PG8_MMA(1, 0, At, B0); PG8_MMA(1, 1, At, B1); PG8_BAR; PG8_SCHED;
            PG8_LDB(B0, 1, 0); PG8_LDB(B1, 1, 1); PG8_SCHED; PG8_LDA(At, 1, 0); PG8_STAGE(PG8_SA(0, 1), a2 + hstepA, voffA);
            PG8_WAIT_V(8); PG8_WAIT_L(0); PG8_BAR; PG8_MMA(0, 0, At, B0); PG8_MMA(0, 1, At, B1); PG8_BAR; PG8_SCHED;
            PG8_LDA(At, 1, 1); PG8_STAGE(PG8_SB(1, 0), b3, voffB); PG8_STAGE(PG8_SB(1, 1), b3 + hstepB, voffB); PG8_STAGE(PG8_SA(1, 0), a3, voffA);
            PG8_WAIT_V(8); PG8_WAIT_L(0); PG8_BAR; PG8_MMA(1, 0, At, B0); PG8_MMA(1, 1, At, B1); PG8_BAR; PG8_SCHED;
            } else {
            PG8_LDB(B0, 0, 0); PG8_SCHED; PG8_LDA(At, 0, 0); PG8_STAGE(PG8_SA(1, 1), a1 + hstepA, voffA);
            PG8_WAIT_L(8); PG8_BAR; PG8_WAIT_L(0); PG8_MMA(0, 0, At, B0); PG8_BAR; PG8_SCHED;
            PG8_LDB(B1, 0, 1); PG8_STAGE(PG8_SB(0, 0), b2, voffB);
            PG8_BAR; PG8_WAIT_L(0); PG8_MMA(0, 1, At, B1); PG8_BAR;
            PG8_LDA(At, 0, 1); PG8_STAGE(PG8_SA(0, 0), a2, voffA);
            PG8_BAR; PG8_WAIT_L(0); PG8_MMA(1, 0, At, B0); PG8_BAR; PG8_SCHED;
            PG8_STAGE(PG8_SB(0, 1), b2 + hstepB, voffB);
            PG8_WAIT_V(6); PG8_BAR; PG8_MMA(1, 1, At, B1); PG8_BAR;
            PG8_LDB(B0, 1, 0); PG8_SCHED; PG8_LDA(At, 1, 0); PG8_STAGE(PG8_SA(0, 1), a2 + hstepA, voffA);
            PG8_WAIT_L(8); PG8_BAR; PG8_WAIT_L(0); PG8_MMA(0, 0, At, B0); PG8_BAR; PG8_SCHED;
            PG8_LDB(B1, 1, 1); PG8_STAGE(PG8_SB(1, 0), b3, voffB);
            PG8_BAR; PG8_WAIT_L(0); PG8_MMA(0, 1, At, B1); PG8_BAR;
            PG8_LDA(At, 1, 1); PG8_STAGE(PG8_SA(1, 0), a3, voffA);
            PG8_BAR; PG8_WAIT_L(0); PG8_MMA(1, 0, At, B0); PG8_BAR; PG8_SCHED;
            PG8_STAGE(PG8_SB(1, 1), b3 + hstepB, voffB);
            PG8_WAIT_V(6); PG8_BAR; PG8_MMA(1, 1, At, B1); PG8_BAR;
            }
        }
        if constexpr (ALIGN_EPI) { if (wr == 0) PG8_BAR; }
        if constexpr (!Epi::AFTER_DRAIN) { E(acc, cur, wr, wc, fr, fq); S.done(cur); }
        if (!has_next) break;
        if constexpr (Epi::HAS_INIT) E.init(acc, nxt, wr, wc, fr, fq);
        else {
#pragma unroll
        for (int a = 0; a < 2; ++a)
#pragma unroll
            for (int b = 0; b < 2; ++b)
#pragma unroll
                for (int m = 0; m < 4; ++m)
#pragma unroll
                    for (int n = 0; n < 2; ++n) acc[a][b][m][n] = (f32x4){0.f, 0.f, 0.f, 0.f};
        }
        cur = nxt; cA = nA; cB = nB; ++ui;
        if constexpr (ALIGN_EPI) { if (wr == 1) PG8_BAR; }
    }
    PG8_WAIT_V(0);
    if constexpr (!ALIGN_EPI) { if (wr == 0) PG8_BAR; }
    PG8_BAR;
    if constexpr (Epi::AFTER_DRAIN) { E.fused(acc, cur, wr, wc, fr, fq, lds, wid, lane); S.done(cur); }
#undef PG8_SA
#undef PG8_SB
#undef PG8_STAGE
#undef PG8_LDA
#undef PG8_LDB
#undef PG8_MMA
#undef PG8_WAIT_V
#undef PG8_WAIT_L
#undef PG8_BAR
#undef PG8_SCHED
}
}

constexpr int NWAVES = 8;
constexpr int DM = 1024, DEPTH = 2, FF = 4096;
constexpr int PB = 8, PT = 2048, SB = 128, ST = 4;
constexpr int MP = PB * PT, MS = SB * ST, M = MP + MS;
constexpr int IN_DIM = 5648, NPAD = 5888;
constexpr int GH = 4, GDK = 128, GDV = 128, MH = 4, MDK = 64, MDV = 128, CONVC = 1536;
constexpr int C_QG = 0, C_KG = 512, C_VG = 1024, C_QM = 1536, C_KM = 1792, C_VM = 2048, C_ZG = 2560, C_OM = 3072, C_GG = 3584, C_GM = 4608, C_SMALL = 5632;
constexpr float EPS = 1e-6f;
constexpr int NP_WO = 4, NP_DN = 8, NP_UP = 4;
static_assert(pg8::LDP == IN_DIM && pg8::MP_ROWS == MP, "shape constants");

constexpr size_t WS_CTL = 0, CTL_ZERO_BYTES = 1u << 20;
constexpr size_t SZ_WIN = (size_t)NPAD * DM * 2, SZ_WB = (size_t)DM * 512 * 2, SZ_WOUT = (size_t)DM * DM * 2, SZ_WUP = (size_t)FF * DM * 2, SZ_WDN = (size_t)DM * FF * 2;
constexpr size_t SZ_WLAYER = SZ_WIN + 2 * SZ_WB + SZ_WOUT + SZ_WUP + SZ_WDN;
constexpr size_t WS_W = CTL_ZERO_BYTES;
constexpr size_t WO_WIN = 0, WO_WBG = SZ_WIN, WO_WBM = WO_WBG + SZ_WB, WO_WOUT = WO_WBM + SZ_WB, WO_WUP = WO_WOUT + SZ_WOUT, WO_WDN = WO_WUP + SZ_WUP;
constexpr size_t WS_XN = WS_W + DEPTH * SZ_WLAYER;
constexpr size_t WS_PROJ = WS_XN + (size_t)M * DM * 2;
constexpr size_t WS_SLAB = WS_PROJ + (size_t)140 * 1024 * 1024;
static_assert((size_t)M * FF * 2 <= (size_t)140 * 1024 * 1024 && WS_SLAB + (size_t)128 * 65536 * 4 <= WS_PROJ + (size_t)M * IN_DIM * 2, "slab region");
constexpr size_t WS_GATES = WS_PROJ + (size_t)M * IN_DIM * 2;
constexpr size_t WS_HALO = WS_GATES + (size_t)M * 16 * 4;
constexpr size_t WS_GSCAL = WS_HALO + (size_t)256 * 3 * CONVC * 2;
constexpr size_t WS_MSCAL = WS_GSCAL + 4096;
constexpr size_t WS_XSLOT = WS_MSCAL + (size_t)1024 * 256 * 4;
constexpr size_t WS_END = WS_XSLOT + (size_t)4 * 16384 * 4 * 4;
constexpr size_t WS_XB1 = WS_PROJ + (size_t)140 * 1024 * 1024;
static_assert((size_t)16896 * 4096 * 2 <= (size_t)140 * 1024 * 1024 && WS_XB1 + (size_t)16896 * 1024 * 2 <= WS_PROJ + (size_t)16384 * 5648 * 2, "XB1 placement: after hidden, before the sample rows of proj (whose gate columns the w_out phase still reads)");
constexpr int XLDS_OFF = 131072;
static_assert(WS_XN % 256 == 0 && WS_PROJ % 256 == 0 && WS_GATES % 256 == 0 && WS_HALO % 256 == 0, "alignment");
static_assert(WS_END <= 305083472ull, "workspace budget (sum of inputs)");
constexpr size_t O_Y = 0, O_CONVP = (size_t)M * DM, O_SP = O_CONVP + (size_t)DEPTH * PB * 3 * CONVC, O_CP = O_SP + (size_t)DEPTH * PB * GH * GDK * GDV,
                 O_NP = O_CP + (size_t)DEPTH * PB * MH * MDK * MDV, O_MP = O_NP + (size_t)DEPTH * PB * MH * MDK, O_CONVS = O_MP + (size_t)DEPTH * PB * MH,
                 O_SS = O_CONVS + (size_t)DEPTH * SB * 3 * CONVC, O_CS = O_SS + (size_t)DEPTH * SB * GH * GDK * GDV, O_NS = O_CS + (size_t)DEPTH * SB * MH * MDK * MDV,
                 O_MS = O_NS + (size_t)DEPTH * SB * MH * MDK, O_END = O_MS + (size_t)DEPTH * SB * MH;
static_assert(O_END == 45364288ull, "output size");
constexpr int CW_BAR = 4096, CW_SOFT = 8192, CW_X = 16384;

constexpr int RING_OFF = 0, RING_BYTES = 143360;
constexpr int LDSCTL_OFF = RING_BYTES, MISC_OFF = LDSCTL_OFF + 320;
constexpr int LDS_BYTES = 147456;

#define GAS __attribute__((address_space(1)))
#define LAS __attribute__((address_space(3)))
typedef unsigned short bf16;
typedef unsigned v4u __attribute__((ext_vector_type(4)));
typedef unsigned v2u __attribute__((ext_vector_type(2)));
typedef float f32x4 __attribute__((ext_vector_type(4)));
typedef GAS unsigned gu32;
#define RLX_AGENT __ATOMIC_RELAXED, __HIP_MEMORY_SCOPE_AGENT
#define LDS_WAIT() asm volatile("s_waitcnt lgkmcnt(0)" ::: "memory")
__device__ __forceinline__ unsigned f2bf(float f) { return (unsigned)__builtin_bit_cast(unsigned short, (__bf16)f); }
__device__ __forceinline__ unsigned pk2(float lo, float hi) { return pg8::cvt_pk_bf16(lo, hi); }
__device__ __forceinline__ float bf2f(bf16 h) { return __builtin_bit_cast(float, (unsigned)h << 16); }
__device__ __forceinline__ float wave_sum(float v) {
#pragma unroll
    for (int o = 1; o < 64; o <<= 1) v += __shfl_xor(v, o);
    return v;
}
template <int CTRL> __device__ __forceinline__ float dpp_mov(float x) { return __builtin_bit_cast(float, __builtin_amdgcn_update_dpp(0, __builtin_bit_cast(int, x), CTRL, 0xf, 0xf, true)); }
__device__ __forceinline__ float row16_sum(float x) {
    x += dpp_mov<0x128>(x); x += dpp_mov<0x124>(x); x += dpp_mov<0x122>(x); x += dpp_mov<0x121>(x); return x;
}
template <int CTRL, int RMASK> __device__ __forceinline__ float dpp_src(float ident, float x) { return __builtin_bit_cast(float, __builtin_amdgcn_update_dpp(__builtin_bit_cast(int, ident), __builtin_bit_cast(int, x), CTRL, RMASK, 0xf, false)); }
__device__ __forceinline__ float wave_scan_add(float x) {
    x += dpp_src<0x111, 0xf>(0.f, x); x += dpp_src<0x112, 0xf>(0.f, x); x += dpp_src<0x114, 0xf>(0.f, x); x += dpp_src<0x118, 0xf>(0.f, x);
    x += dpp_src<0x142, 0xa>(0.f, x); x += dpp_src<0x143, 0xc>(0.f, x); return x;
}
__device__ __forceinline__ float wave_scan_max(float x) {
    const float ni = -__builtin_inff();
    x = fmaxf(x, dpp_src<0x111, 0xf>(ni, x)); x = fmaxf(x, dpp_src<0x112, 0xf>(ni, x)); x = fmaxf(x, dpp_src<0x114, 0xf>(ni, x)); x = fmaxf(x, dpp_src<0x118, 0xf>(ni, x));
    x = fmaxf(x, dpp_src<0x142, 0xa>(ni, x)); x = fmaxf(x, dpp_src<0x143, 0xc>(ni, x)); return x;
}
__device__ __forceinline__ float wave_sum_fast(float x) {
    x = row16_sum(x);
    const int xi = __builtin_bit_cast(int, x);
    return (__builtin_bit_cast(float, __builtin_amdgcn_readlane(xi, 0)) + __builtin_bit_cast(float, __builtin_amdgcn_readlane(xi, 16))) +
           (__builtin_bit_cast(float, __builtin_amdgcn_readlane(xi, 32)) + __builtin_bit_cast(float, __builtin_amdgcn_readlane(xi, 48)));
}
__device__ __forceinline__ float frcp(float x) { return __builtin_amdgcn_rcpf(x); }
__device__ __forceinline__ float frsq(float x) { return __builtin_amdgcn_rsqf(x); }
__device__ __forceinline__ float sigm(float x) { return frcp(1.0f + __expf(-x)); }
__device__ __forceinline__ float siluf(float x) { return x * frcp(1.0f + __expf(-x)); }
__device__ __forceinline__ float softplusf(float x) { return x > 20.f ? x : log1pf(__expf(x)); }

#define XB_TMO      128
#define XB_XCNT(j)  (256  + 64 * (j))
#define XB_XSUB(j)  (1280 + 64 * (j))
#define XB_XGEN(j)  (2304 + 64 * (j))
#define XB_TOP      3328
#define XB_TOPGEN   3392
#define XCD_BAR_WORDS 3456
#define XB_SPIN_CAP (1u << 18)
__device__ __forceinline__ unsigned xb_ld(unsigned* p)              { return __hip_atomic_load(p, __ATOMIC_RELAXED, __HIP_MEMORY_SCOPE_AGENT); }
__device__ __forceinline__ unsigned xb_add(unsigned* p, unsigned v) { return __hip_atomic_fetch_add(p, v, __ATOMIC_RELAXED, __HIP_MEMORY_SCOPE_AGENT); }
__device__ __forceinline__ unsigned xb_xcc_id() { return (unsigned)__builtin_amdgcn_s_getreg((3 << 11) | 20) & 0xFu; }
#define XB_SPIN(cond, bar) do { unsigned _sp = 0; while (cond) { __builtin_amdgcn_s_sleep(1); \
    if ((++_sp & 255u) == 0u) { if (xb_ld(&(bar)[XB_TMO])) break; if (_sp > XB_SPIN_CAP) { atomicAdd(&(bar)[XB_TMO], 1u); break; } } } } while (0)
struct XcdBarrier { unsigned* bar; unsigned x; volatile LAS unsigned* st; };
__device__ __forceinline__ XcdBarrier xcd_barrier_post(unsigned* bar, volatile LAS unsigned* st) {
    XcdBarrier b; b.bar = bar; b.x = xb_xcc_id(); b.st = st;
    if (threadIdx.x == 0) (void)xb_add(&bar[XB_XCNT(b.x)], 1u);
    return b;
}
__device__ __forceinline__ void xcd_barrier_complete(unsigned* bar, unsigned x, unsigned& nloc, unsigned& nx) {
    const unsigned G = gridDim.x * gridDim.y * gridDim.z;
    unsigned sum, cnt, mine, sp = 0u;
    for (;;) {
        sum = 0u; cnt = 0u; mine = 0u;
#pragma unroll
        for (unsigned j = 0; j < 16; ++j) { const unsigned c = xb_ld(&bar[XB_XCNT(j)]); sum += c; cnt += (c > 0u) ? 1u : 0u; mine = (j == x) ? c : mine; }
        if (sum == G) break;
        __builtin_amdgcn_s_sleep(1);
        if ((++sp & 255u) == 0u) { if (xb_ld(&bar[XB_TMO])) break; if (sp > XB_SPIN_CAP) { atomicAdd(&bar[XB_TMO], 1u); break; } }
    }
    nloc = mine > 0u ? mine : 1u; nx = cnt > 0u ? cnt : 1u;
}
template <bool CENSUS = true> __device__ __forceinline__ void xcd_barrier(const XcdBarrier& b) {
    asm volatile("s_waitcnt vmcnt(0)" ::: "memory");
    __syncthreads();
    if (threadIdx.x == 0) {
        unsigned* bar = b.bar; asm volatile("" : "+s"(bar));
        __builtin_amdgcn_s_waitcnt(0);
        unsigned nloc = b.st[0], nx = b.st[1]; unsigned bx = b.x; asm volatile("" : "+s"(bx));
        if (CENSUS) { if (nloc == 0u) { xcd_barrier_complete(bar, bx, nloc, nx); b.st[0] = nloc; b.st[1] = nx; } }
        const unsigned old = xb_add(&bar[XB_XSUB(bx)], 1u);
        const unsigned gen = old / nloc;
        if (old + 1u == (gen + 1u) * nloc) {
            __builtin_amdgcn_fence(__ATOMIC_RELEASE, "agent");
            asm volatile("s_waitcnt vmcnt(0)" ::: "memory");
            const unsigned og = xb_add(&bar[XB_TOP], 1u);
            const unsigned tg = og / nx;
            if (og + 1u == (tg + 1u) * nx) xb_add(&bar[XB_TOPGEN], 1u);
            else XB_SPIN(xb_ld(&bar[XB_TOPGEN]) == tg, bar);
            __builtin_amdgcn_fence(__ATOMIC_ACQUIRE, "agent");
            xb_add(&bar[XB_XGEN(bx)], 1u);
            asm volatile("s_waitcnt vmcnt(0)" ::: "memory");
        } else {
            XB_SPIN(xb_ld(&bar[XB_XGEN(bx)]) == gen, bar);
            __builtin_amdgcn_fence(__ATOMIC_ACQUIRE, "agent");
            asm volatile("s_waitcnt vmcnt(0)" ::: "memory");
        }
    }
    __syncthreads();
}

struct Args { const float* in[23]; float* out; unsigned char* ws; int ph_lo, ph_hi; };
static_assert(sizeof(Args) == 23 * 8 + 8 + 8 + 8, "Args has no padding");
enum { I_XP = 0, I_XS, I_SCONV, I_SS, I_SC, I_SN, I_SM, I_NMIX, I_WIN, I_CONVW, I_ALOG, I_DTB, I_GNORM, I_IB, I_FB, I_MNORM, I_WBG, I_WBM, I_WOUT, I_NMLP, I_WUP, I_WDN, I_NFIN };

struct Frame {
    LAS unsigned char* lds;
    int tid, lane, wave, G, bid;
    const __attribute__((address_space(4))) Args* a;
    unsigned char* ws; float* out;
};
__device__ __forceinline__ bf16* w_ptr(const Frame& F, int l, size_t off) { return (bf16*)(F.ws + WS_W + (size_t)l * SZ_WLAYER + off); }
__device__ __forceinline__ float* dn_slab(const Frame& F, int l) { return (float*)(F.ws + WS_W + (size_t)l * SZ_WLAYER); }
static_assert((size_t)2 * 4 * NP_DN * 65536 * 4 <= WO_WDN, "down slabs fit before w_down");
static_assert((size_t)2 * 4 * NP_WO * 65536 * 4 <= WO_WOUT, "w_out slabs (same place, earlier in the layer) fit before w_out");

__device__ __forceinline__ void p0_transpose_item(const float* W, int ldw, int K, bf16* WT, int nblk, LAS float* scr, int item, int lane) {
    const int kb = item / nblk, nb = item % nblk, k0 = 64 * kb, n0 = 32 * nb;
#pragma unroll 8
    for (int i = 0; i < 32; ++i) { const int kk = 2 * i + (lane >> 5); scr[kk * 33 + (lane & 31)] = W[(size_t)(k0 + kk) * ldw + n0 + (lane & 31)]; }
    LDS_WAIT(); asm volatile("" ::: "memory");
    const int c = lane & 7;
#pragma unroll
    for (int j = 0; j < 4; ++j) { const int n = (lane >> 3) + 8 * j; const LAS float* s = scr + (8 * c) * 33 + n;
        v4u o; o.x = pk2(s[0 * 33], s[1 * 33]); o.y = pk2(s[2 * 33], s[3 * 33]); o.z = pk2(s[4 * 33], s[5 * 33]); o.w = pk2(s[6 * 33], s[7 * 33]);
        *(GAS v4u*)(WT + (size_t)(n0 + n) * K + k0 + 8 * c) = o; }
    LDS_WAIT(); asm volatile("" ::: "memory");
}
__device__ __forceinline__ void p0_prologue(Frame& F, int l, int b0, int nb) {
    int tq_ = threadIdx.x; asm volatile("" : "+v"(tq_)); const int lane_ = tq_ & 63, wave_ = __builtin_amdgcn_readfirstlane(tq_ >> 6);
    LAS float* scr = (LAS float*)(F.lds + RING_OFF + wave_ * 16384);
    const int gw = (F.bid - b0) * NWAVES + wave_, NGW = nb * NWAVES;
    constexpr int I_A = 16 * 48, I_Z = 16 * 16, I_B = 16 * 32, I_OM = 16 * 16, I_C = 16 * 64, I_BG = 8 * 32, I_BM = 8 * 32, I_O = 16 * 32, I_U = 16 * 128, I_D = 64 * 32;
    constexpr int PER_LAYER = I_A + I_Z + I_B + I_OM + I_C + I_BG + I_BM + I_O + I_U + I_D;
    for (int it = gw; it < PER_LAYER; it += NGW) {
        int r = it;
        const float* win = F.a->in[I_WIN] + (size_t)l * DM * IN_DIM;
        bf16* wint = w_ptr(F, l, WO_WIN);
        if (r < I_A) { p0_transpose_item(win + 0, IN_DIM, DM, wint + (size_t)C_QG * DM, 48, scr, r, lane_); continue; } r -= I_A;
        if (r < I_Z) { p0_transpose_item(win + 1536, IN_DIM, DM, wint + (size_t)C_ZG * DM, 16, scr, r, lane_); continue; } r -= I_Z;
        if (r < I_B) { p0_transpose_item(win + 2056, IN_DIM, DM, wint + (size_t)C_QM * DM, 32, scr, r, lane_); continue; } r -= I_B;
        if (r < I_OM) { p0_transpose_item(win + 3080, IN_DIM, DM, wint + (size_t)C_OM * DM, 16, scr, r, lane_); continue; } r -= I_OM;
        if (r < I_C) { p0_transpose_item(win + 3600, IN_DIM, DM, wint + (size_t)C_GG * DM, 64, scr, r, lane_); continue; } r -= I_C;
        if (r < I_BG) { p0_transpose_item(F.a->in[I_WBG] + (size_t)l * 512 * DM, DM, 1024, w_ptr(F, l, WO_WBG), 32, scr, r, lane_); continue; } r -= I_BG;
        if (r < I_BM) { p0_transpose_item(F.a->in[I_WBM] + (size_t)l * 512 * DM, DM, 1024, w_ptr(F, l, WO_WBG) + 512, 32, scr, r, lane_); continue; } r -= I_BM;
        if (r < I_O) { p0_transpose_item(F.a->in[I_WOUT] + (size_t)l * DM * DM, DM, DM, w_ptr(F, l, WO_WOUT), 32, scr, r, lane_); continue; } r -= I_O;
        if (r < I_U) { p0_transpose_item(F.a->in[I_WUP] + (size_t)l * DM * FF, FF, DM, w_ptr(F, l, WO_WUP), 128, scr, r, lane_); continue; } r -= I_U;
        p0_transpose_item(F.a->in[I_WDN] + (size_t)l * FF * DM, DM, FF, w_ptr(F, l, WO_WDN), 32, scr, r, lane_);
    }
    const int gt = (F.bid - b0) * (NWAVES * 64) + tq_, NGT = nb * NWAVES * 64;
    for (int i = gt; i < 16 * DM; i += NGT) {
        const int n = i / DM, k = i % DM;
        const int src = (n < 8) ? 2048 + n : 3592 + (n - 8);
        w_ptr(F, l, WO_WIN)[(size_t)(C_SMALL + n) * DM + k] = (bf16)f2bf(F.a->in[I_WIN][(size_t)l * DM * IN_DIM + (size_t)k * IN_DIM + src]);
    }
    { unsigned zz = 0u; asm volatile("" : "+v"(zz));
      for (int i = gt; i < (NPAD - IN_DIM) * DM / 8; i += NGT) ((GAS v4u*)(w_ptr(F, l, WO_WIN) + (size_t)IN_DIM * DM))[i] = (v4u){zz, zz, zz, zz}; }
}

__device__ __forceinline__ const float* x_row(const Frame& F, int src, int m) {
    if (src == 0 || (src == 2 && m >= MP)) return (m < MP) ? F.a->in[I_XP] + (size_t)m * DM : F.a->in[I_XS] + (size_t)(m - MP) * DM;
    return F.out + O_Y + (size_t)m * DM;
}
__device__ __forceinline__ void wait_count(unsigned* cnt, unsigned need, int wave) {
    if (wave == 0) { unsigned sp = 0;
        while ((unsigned)__builtin_amdgcn_readfirstlane(__hip_atomic_load(cnt, __ATOMIC_RELAXED, __HIP_MEMORY_SCOPE_AGENT)) < need) { __builtin_amdgcn_s_sleep(2); if (++sp > (1u << 22)) break; }
        __builtin_amdgcn_fence(__ATOMIC_ACQUIRE, "agent");
        asm volatile("s_waitcnt vmcnt(0)" ::: "memory"); }
    __syncthreads();
}
__device__ __forceinline__ f32x4 slab_sum(const float* slab, int sr, int j, int lane, int np) {
    const float* p = slab + ((size_t)((sr >> 8) * 4 + j) * np * 256 + (sr & 255)) * 256 + 4 * lane;
    f32x4 s = (f32x4){0.f, 0.f, 0.f, 0.f};
    for (int q = 0; q < np; ++q) s += *(const GAS f32x4*)(p + (size_t)q * 65536);
    return s;
}
__device__ __forceinline__ void norm_phase(Frame& F, int src_layer, const float* w, bf16* xn, int np, const float* slab = nullptr, int m0 = 0, int m1 = M, int wk = 0, int nwk = 0) {
    int tq_ = threadIdx.x; asm volatile("" : "+v"(tq_)); const int lane_ = tq_ & 63, wave_ = __builtin_amdgcn_readfirstlane(tq_ >> 6);
    const int NGW = (nwk > 0 ? nwk : F.G) * NWAVES, gw = nwk == 0 ? F.bid * NWAVES + wave_ : NGW - 1 - (wave_ * nwk + wk);
    f32x4 wv[4];
#pragma unroll
    for (int j = 0; j < 4; ++j) wv[j] = ((const f32x4*)w)[lane_ + 64 * j];
    for (int m = m0 + NGW - 1 - gw; m < m1; m += NGW) {
        const GAS f32x4* xr = (const GAS f32x4*)x_row(F, src_layer, m) + lane_;
        f32x4 v[4]; float s = 0.f;
#pragma unroll
        for (int j = 0; j < 4; ++j) v[j] = xr[64 * j];
        if (np > 0 && m >= MP) { GAS f32x4* xo = (GAS f32x4*)(F.out + O_Y + (size_t)m * DM) + lane_;
#pragma unroll
            for (int j = 0; j < 4; ++j) { v[j] += slab_sum(slab, m - MP, j, lane_, np); xo[64 * j] = v[j]; } }
#pragma unroll
        for (int j = 0; j < 4; ++j) s += (v[j].x * v[j].x + v[j].y * v[j].y) + (v[j].z * v[j].z + v[j].w * v[j].w);
        const float r = frsq(wave_sum(s) * (1.f / DM) + EPS);
        GAS v2u* o8 = (GAS v2u*)(xn + (size_t)m * DM) + lane_;
#pragma unroll
        for (int j = 0; j < 4; ++j) { v2u o; o.x = pk2(v[j].x * r * wv[j].x, v[j].y * r * wv[j].y); o.y = pk2(v[j].z * r * wv[j].z, v[j].w * r * wv[j].w); o8[64 * j] = o; }
    }
}
__device__ __forceinline__ void final_norm_phase(Frame& F, int np, const float* slab, int m0 = 0) {
    int tq_ = threadIdx.x; asm volatile("" : "+v"(tq_)); const int lane_ = tq_ & 63, wave_ = __builtin_amdgcn_readfirstlane(tq_ >> 6);
    const int NGW = F.G * NWAVES, gw = m0 == 0 ? F.bid * NWAVES + wave_ : NGW - 1 - (wave_ * F.G + F.bid);
    const float* w = F.a->in[I_NFIN];
    f32x4 wv[4];
#pragma unroll
    for (int j = 0; j < 4; ++j) wv[j] = ((const f32x4*)w)[lane_ + 64 * j];
    for (int m = m0 + NGW - 1 - gw; m < M; m += NGW) {
        GAS f32x4* xr = (GAS f32x4*)(F.out + O_Y + (size_t)m * DM) + lane_;
        f32x4 v[4]; float s = 0.f;
#pragma unroll
        for (int j = 0; j < 4; ++j) v[j] = xr[64 * j];
        if (np > 0 && m >= MP) {
#pragma unroll
            for (int j = 0; j < 4; ++j) v[j] += slab_sum(slab, m - MP, j, lane_, np); }
#pragma unroll
        for (int j = 0; j < 4; ++j) s += (v[j].x * v[j].x + v[j].y * v[j].y) + (v[j].z * v[j].z + v[j].w * v[j].w);
        const float r = frsq(wave_sum(s) * (1.f / DM) + EPS);
#pragma unroll
        for (int j = 0; j < 4; ++j) xr[64 * j] = v[j] * r * wv[j];
    }
}


typedef short bf16x8 __attribute__((ext_vector_type(8)));
__device__ __forceinline__ int pos32(int kk) { return 8 * ((kk & 15) >> 2) + 4 * (kk >> 4) + (kk & 3); }
__device__ __forceinline__ int permk(int k) { return (k & ~31) + pos32(k & 31); }
__device__ __forceinline__ int lperm(int g, int j) { return j < 4 ? 4 * g + j : 16 + 4 * g + (j - 4); }
__device__ __forceinline__ bf16x8 pack_acc2(const f32x4 a, const f32x4 b) {
    v4u w; w.x = pg8::cvt_pk_bf16(a[0], a[1]); w.y = pg8::cvt_pk_bf16(a[2], a[3]); w.z = pg8::cvt_pk_bf16(b[0], b[1]); w.w = pg8::cvt_pk_bf16(b[2], b[3]);
    return __builtin_bit_cast(bf16x8, w);
}
#define MFMA16(a, b, c) __builtin_amdgcn_mfma_f32_16x16x32_bf16((a), (b), (c), 0, 0, 0)
#define SBAR() __builtin_amdgcn_sched_barrier(0)
#define LBAR() do { asm volatile("s_waitcnt lgkmcnt(0)" ::: "memory"); __builtin_amdgcn_s_barrier(); asm volatile("" ::: "memory"); } while (0)
constexpr size_t XN_WBUF = 0, XN_QKBUF = (size_t)1024 * 64 * 128 * 2, XN_PBUF = XN_QKBUF + (size_t)1024 * 64 * 64 * 2;
static_assert(XN_PBUF + (size_t)1024 * 64 * 64 * 2 <= (size_t)M * DM * 2, "prep buffers fit the XN region");

struct GdnIn { v4u rw[6], rz[2], rh; float gb, ga; };
struct GdnConst { float w0, w1, w2, w3, aexp, dtb; };
__device__ __forceinline__ void gdn_prep_load(Frame& F, int grp, int h, GdnIn& R) {
    const bf16* proj = (const bf16*)(F.ws + WS_PROJ); const bf16* halo = (const bf16*)(F.ws + WS_HALO); const float* gates = (const float*)(F.ws + WS_GATES);
    int tl = F.tid; asm volatile("" : "+v"(tl));
    const int r0 = grp * 64, c = grp & 31;
#pragma unroll
    for (int k = 0; k < 6; ++k) { const int q = tl + 512 * k, j = q / 48, rem = q - 48 * j; R.rw[k] = *(const GAS v4u*)(proj + (size_t)(r0 + j) * IN_DIM + (rem >> 4) * 512 + h * 128 + (rem & 15) * 8); }
#pragma unroll
    for (int k = 0; k < 2; ++k) { const int q = tl + 512 * k; R.rz[k] = *(const GAS v4u*)(proj + (size_t)(r0 + (q >> 4)) * IN_DIM + C_ZG + h * 128 + (q & 15) * 8); }
    { const int th = tl < 144 ? tl : 0, j = th / 48, rem = th - 48 * j, gp = grp > 0 ? grp - 1 : 0;
      R.rh = *(const GAS v4u*)(halo + ((size_t)gp * 3 + j) * CONVC + (rem >> 4) * 512 + h * 128 + (rem & 15) * 8);
      if (c == 0) { unsigned zz = 0u; asm volatile("" : "+v"(zz)); R.rh = (v4u){zz, zz, zz, zz}; } }
    { const int t6 = tl & 63; R.gb = gates[(size_t)(r0 + t6) * 16 + h]; R.ga = gates[(size_t)(r0 + t6) * 16 + 4 + h]; }
}
__device__ __forceinline__ void gdn_prep_item(Frame& F, int l, int grp, int h, GdnIn& R, const GdnConst& K, int nxt) {
    LAS unsigned char* L = F.lds + RING_OFF;
    LAS bf16* XPB = (LAS bf16*)L;
    LAS float* AM = (LAS float*)L;
    LAS bf16* WST = (LAS bf16*)(L + 16384);
    LAS bf16* QKS = (LAS bf16*)(L + 32768);
    constexpr int PIT = 136;
    LAS bf16* KB = (LAS bf16*)(L + 51456);
    LAS bf16* QB = (LAS bf16*)(L + 51456 + 17408);
    LAS bf16* VB = (LAS bf16*)(L + 51456 + 2 * 17408);
    LAS bf16* ZB = (LAS bf16*)(L + 51456 + 3 * 17408);
    LAS float* SC = (LAS float*)(L + 51456 + 4 * 17408);
    bf16* proj = (bf16*)(F.ws + WS_PROJ);
    const bf16* halo = (const bf16*)(F.ws + WS_HALO);
    const float* gates = (const float*)(F.ws + WS_GATES);
    const float* cw = F.a->in[I_CONVW] + (size_t)l * 4 * CONVC;
    const int r0 = grp * 64, c = grp & 31, item = grp * 4 + h;
    bf16* Wg = (bf16*)(F.ws + WS_XN + XN_WBUF) + (size_t)item * 8192;
    bf16* QKg = (bf16*)(F.ws + WS_XN + XN_QKBUF) + (size_t)item * 4096;
    LBAR();
    int tl = F.tid; asm volatile("" : "+v"(tl));
    {
#pragma unroll
        for (int k = 0; k < 6; ++k) { const int q = tl + 512 * k, j = q / 48, rem = q - 48 * j; *(LAS v4u*)(XPB + (j + 3) * 384 + (rem >> 4) * 128 + (rem & 15) * 8) = R.rw[k]; }
#pragma unroll
        for (int k = 0; k < 2; ++k) { const int q = tl + 512 * k; *(LAS v4u*)(ZB + (q >> 4) * PIT + (q & 15) * 8) = R.rz[k]; }
        if (tl < 144) { const int j = tl / 48, rem = tl - 48 * j; *(LAS v4u*)(XPB + j * 384 + (rem >> 4) * 128 + (rem & 15) * 8) = R.rh; }
        if (tl < 64) { SC[tl] = sigm(R.gb); SC[64 + tl] = -K.aexp * softplusf(R.ga + K.dtb); }
    }
    asm volatile("" ::: "memory");
    if (nxt >= 0) gdn_prep_load(F, nxt >> 2, nxt & 3, R);
    LBAR();
    {    {
        tl = F.tid; asm volatile("" : "+v"(tl));
        if (tl < 384) {
            const int s = tl >> 7, e = tl & 127;
            const float w0 = K.w0, w1 = K.w1, w2 = K.w2, w3 = K.w3;
            LAS bf16* dst = (s == 0 ? QB : s == 1 ? KB : VB) + e;
            const LAS bf16* src = XPB + tl;
            float x0 = bf2f(src[0]), x1 = bf2f(src[384]), x2 = bf2f(src[768]);
#pragma unroll 16
            for (int t = 0; t < 64; ++t) { const float x3 = bf2f(src[(t + 3) * 384]);
                const float a = ((x0 * w0 + x1 * w1) + (x2 * w2 + x3 * w3));
                dst[t * PIT] = (bf16)f2bf(siluf(a)); x0 = x1; x1 = x2; x2 = x3; }
        }
        if (c == 31) { float* cp = F.out + O_CONVP + ((size_t)l * PB + (grp >> 5)) * 3 * CONVC;
            for (int q = tl; q < 3 * 384; q += NWAVES * 64) { const int j = q / 384, x = q % 384; cp[(size_t)j * CONVC + (x >> 7) * 512 + h * 128 + (x & 127)] = bf2f(XPB[(64 + j) * 384 + x]); } }
        if (tl >= 448) {
            const int lane_ = tl & 63; const float x = wave_scan_add(SC[64 + lane_]);
            SC[128 + lane_] = x; SC[192 + lane_] = __expf(x);
        }
    }
    LBAR();
    {
        tl = F.tid; asm volatile("" : "+v"(tl));
        if (tl < 128) { const int t = tl & 63, wh = tl >> 6; const LAS bf16* row = (wh ? KB : QB) + t * PIT; float ss = 0.f;
#pragma unroll
            for (int k8 = 0; k8 < 16; ++k8) { const v4u w = *(const LAS v4u*)(row + 8 * k8);
                ss += (pg8::bf_lo(w.x) * pg8::bf_lo(w.x) + pg8::bf_hi(w.x) * pg8::bf_hi(w.x)) + (pg8::bf_lo(w.y) * pg8::bf_lo(w.y) + pg8::bf_hi(w.y) * pg8::bf_hi(w.y))
                    + (pg8::bf_lo(w.z) * pg8::bf_lo(w.z) + pg8::bf_hi(w.z) * pg8::bf_hi(w.z)) + (pg8::bf_lo(w.w) * pg8::bf_lo(w.w) + pg8::bf_hi(w.w) * pg8::bf_hi(w.w)); }
            SC[256 + tl] = frsq(ss + EPS) * (wh ? 1.0f : 0.08838834764831845f); }
    }
    LBAR();
    }
    {    {
        tl = F.tid; asm volatile("" : "+v"(tl)); const int lane_ = tl & 63, wave_ = __builtin_amdgcn_readfirstlane(tl >> 6);
        const int sel = wave_ >> 2, ti = wave_ & 3, fr = lane_ & 15, g = lane_ >> 4;
        const LAS bf16* X = sel ? QB : KB;
        for (int tj = 0; tj < 4; ++tj) {
            f32x4 acc = (f32x4){0.f, 0.f, 0.f, 0.f};
            if (tj <= ti) {
#pragma unroll
                for (int s = 0; s < 4; ++s) { const bf16x8 a = *(const LAS bf16x8*)(X + (16 * ti + fr) * PIT + 32 * s + 8 * g), bq = *(const LAS bf16x8*)(KB + (16 * tj + fr) * PIT + 32 * s + 8 * g);
                    acc = MFMA16(a, bq, acc); }
            }
            const int j = 16 * tj + fr; const float gcj = SC[128 + j], rkj = SC[320 + j];
#pragma unroll
            for (int r = 0; r < 4; ++r) { const int i = 16 * ti + 4 * g + r; const float dec = __expf(fminf(SC[128 + i] - gcj, 0.f)) * rkj;
                if (sel == 0) AM[i * 64 + j] = (j < i) ? SC[i] * SC[320 + i] * acc[r] * dec : 0.f;
                else QKS[i * 64 + permk(j)] = (bf16)f2bf((j <= i) ? SC[256 + i] * acc[r] * dec : 0.f); }
        }
    }
    LBAR();
    }
    const float gcL = SC[128 + 63];
    tl = F.tid; asm volatile("" : "+v"(tl));
    *(GAS v4u*)(QKg + tl * 8) = *(const LAS v4u*)(QKS + tl * 8);
    LAS float* DINV = (LAS float*)(L + 40960);
    if (tl < 64) {
        const int bb = tl >> 4, j = tl & 15; const LAS float* Ab = AM + (16 * bb) * 64 + 16 * bb; float t[16];
#pragma unroll
        for (int i = 0; i < 16; ++i) { float a0 = (i == j) ? 1.f : 0.f, a1 = 0.f;
#pragma unroll
            for (int k4 = 0; k4 < (i + 3) / 4; ++k4) { const f32x4 av = *(const LAS f32x4*)(Ab + i * 64 + 4 * k4);
#pragma unroll
                for (int e = 0; e < 4; ++e) if (4 * k4 + e < i) { if (e & 1) a1 -= av[e] * t[4 * k4 + e]; else a0 -= av[e] * t[4 * k4 + e]; } }
            t[i] = a0 + a1; DINV[(bb * 16 + i) * 16 + j] = t[i]; }
    } else {
        const int t2 = tl - 64;
#pragma unroll 1
        for (int q0 = t2; q0 < 3072; q0 += 448) { const int ty = q0 >> 10, q = q0 & 1023;
            if (ty == 0) { const int t = q >> 4, ch = q & 15, s = ch >> 2, gq = ch & 3; const float e = SC[192 + t] * SC[256 + t];
                const v2u a = *(const LAS v2u*)(QB + t * PIT + 32 * s + 4 * gq), b2 = *(const LAS v2u*)(QB + t * PIT + 32 * s + 16 + 4 * gq);
                v4u o; o.x = pk2(pg8::bf_lo(a.x) * e, pg8::bf_hi(a.x) * e); o.y = pk2(pg8::bf_lo(a.y) * e, pg8::bf_hi(a.y) * e); o.z = pk2(pg8::bf_lo(b2.x) * e, pg8::bf_hi(b2.x) * e); o.w = pk2(pg8::bf_lo(b2.y) * e, pg8::bf_hi(b2.y) * e);
                *(GAS v4u*)(proj + (size_t)(r0 + t) * IN_DIM + C_QG + h * 128 + ch * 8) = o;
            } else if (ty == 1) { const int dk = q >> 3, ch = q & 7, s = ch >> 2, gq = ch & 3; float v[8];
#pragma unroll
                for (int e = 0; e < 8; ++e) { const int tok = 32 * s + lperm(gq, e); v[e] = bf2f(KB[tok * PIT + dk]) * __expf(fminf(gcL - SC[128 + tok], 0.f)) * SC[320 + tok]; }
                v4u o; o.x = pk2(v[0], v[1]); o.y = pk2(v[2], v[3]); o.z = pk2(v[4], v[5]); o.w = pk2(v[6], v[7]);
                *(GAS v4u*)(proj + (size_t)(r0 + (dk >> 1)) * IN_DIM + C_KG + h * 128 + (dk & 1) * 64 + ch * 8) = o;
            } else { const int cp2 = q & 7, gq = (q >> 3) & 3, m = (q >> 5) & 3, w = q >> 7; unsigned short zv[8];
#pragma unroll
                for (int e = 0; e < 8; ++e) zv[e] = ZB[(16 * m + 4 * gq + (e & 3)) * PIT + 16 * w + 2 * cp2 + (e >> 2)];
                v4u o; o.x = zv[0] | ((unsigned)zv[1] << 16); o.y = zv[2] | ((unsigned)zv[3] << 16); o.z = zv[4] | ((unsigned)zv[5] << 16); o.w = zv[6] | ((unsigned)zv[7] << 16);
                *(GAS v4u*)(proj + (size_t)(r0 + (w * 4 + m) * 2 + (gq >> 1)) * IN_DIM + C_ZG + h * 128 + (gq & 1) * 64 + cp2 * 8) = o; }
        }
        if (t2 == 0) ((float*)(F.ws + WS_GSCAL))[item] = __expf(gcL);
    }
    LBAR();
    {
        tl = F.tid; asm volatile("" : "+v"(tl));
        const int lane_ = tl & 63, wave_ = __builtin_amdgcn_readfirstlane(tl >> 6), ci = lane_ & 15, gq = lane_ >> 4;
#pragma unroll
        for (int nn = 0; nn < 2; ++nn) {
            const int nt = 2 * wave_ + nn, col = 16 * nt + ci; f32x4 X[4];
#pragma unroll
            for (int b = 0; b < 4; ++b) {
                f32x4 y; const f32x4 be = *(const LAS f32x4*)(SC + 16 * b + 4 * gq);
                if (nt < 8) { const f32x4 eg = *(const LAS f32x4*)(SC + 192 + 16 * b + 4 * gq), rk = *(const LAS f32x4*)(SC + 320 + 16 * b + 4 * gq);
#pragma unroll
                    for (int r = 0; r < 4; ++r) y[r] = be[r] * eg[r] * rk[r] * bf2f(KB[(16 * b + 4 * gq + r) * PIT + col]);
                } else {
#pragma unroll
                    for (int r = 0; r < 4; ++r) y[r] = be[r] * bf2f(VB[(16 * b + 4 * gq + r) * PIT + col - 128]); }
#pragma unroll
                for (int bp = 0; bp < b; ++bp) { const f32x4 a = *(const LAS f32x4*)(AM + (16 * b + ci) * 64 + 16 * bp + 4 * gq);
#pragma unroll
                    for (int r = 0; r < 4; ++r) y = __builtin_amdgcn_mfma_f32_16x16x4f32(-a[r], X[bp][r], y, 0, 0, 0); }
                const f32x4 d = *(const LAS f32x4*)(DINV + (b * 16 + ci) * 16 + 4 * gq);
                f32x4 x = (f32x4){0.f, 0.f, 0.f, 0.f};
#pragma unroll
                for (int r = 0; r < 4; ++r) x = __builtin_amdgcn_mfma_f32_16x16x4f32(d[r], y[r], x, 0, 0, 0);
                X[b] = x;
                if (nt < 8) {
#pragma unroll
                    for (int r = 0; r < 4; ++r) WST[(16 * b + 4 * gq + r) * 128 + permk(col)] = (bf16)f2bf(x[r]);
                } else { v2u o; o.x = pk2(x[0], x[1]); o.y = pk2(x[2], x[3]);
                    *(GAS v2u*)(proj + (size_t)(r0 + ((nt - 8) * 4 + b) * 2 + (gq >> 1)) * IN_DIM + C_VG + h * 128 + (gq & 1) * 64 + ci * 4) = o; }
            }
        }
    }
    LBAR();
    tl = F.tid; asm volatile("" : "+v"(tl));
#pragma unroll
    for (int k = 0; k < 2; ++k) *(GAS v4u*)(Wg + (tl + 512 * k) * 8) = *(const LAS v4u*)(WST + (tl + 512 * k) * 8);
}

__device__ __forceinline__ void gdn_scan_prompt(Frame& F, int l, int b, int h) {
    LAS unsigned char* L = F.lds + RING_OFF;
    constexpr int BUFB = 57344, W_OFF = 0, QD_OFF = 16384, KDT_OFF = 32768, QK_OFF = 49152, RED_OFF = 2 * BUFB, RSV_OFF = RED_OFF + 4096, OGW_OFF = RSV_OFF + 2048;
    static_assert(OGW_OFF + 8 * 2048 <= RING_BYTES, "scan LDS map");
    bf16* proj = (bf16*)(F.ws + WS_PROJ);
    const bf16* Wb = (const bf16*)(F.ws + WS_XN + XN_WBUF);
    const bf16* QKb = (const bf16*)(F.ws + WS_XN + XN_QKBUF);
    const float* gscal = (const float*)(F.ws + WS_GSCAL);
    int tl_ = F.tid; asm volatile("" : "+v"(tl_));
    const int tid = tl_, lane = tid & 63, w = __builtin_amdgcn_readfirstlane(tid >> 6), c = lane & 15, g = lane >> 4;
    const float gn = F.a->in[I_GNORM][l * GDV + 16 * w + c];
    f32x4 S[8];
#pragma unroll
    for (int n = 0; n < 8; ++n) S[n] = (f32x4){0.f, 0.f, 0.f, 0.f};
    const int prow = tid >> 4, pch = tid & 15;
    const int krow = tid >> 3, kch = tid & 7;
    const unsigned dW0 = W_OFF + prow * 256 + ((pch ^ (prow & 15)) << 4), dW1 = dW0 + 32 * 256;
    const unsigned dK0 = KDT_OFF + krow * 128 + ((kch ^ ((krow >> 1) & 7)) << 4), dK1 = dK0 + 64 * 128;
    const unsigned dQ = QK_OFF + krow * 128 + ((kch ^ ((krow >> 1) & 7)) << 4);
    v4u st[7]; v2u un[4], zn[4]; float dln;
#define GS_LOAD(chunk) do { const int grp_ = b * 32 + (chunk), item_ = grp_ * 4 + h; const size_t r0_ = (size_t)grp_ * 64; \
        st[0] = *(const GAS v4u*)(Wb + (size_t)item_ * 8192 + prow * 128 + pch * 8); st[1] = *(const GAS v4u*)(Wb + (size_t)item_ * 8192 + (prow + 32) * 128 + pch * 8); \
        st[2] = *(const GAS v4u*)(proj + (r0_ + prow) * IN_DIM + C_QG + h * 128 + pch * 8); st[3] = *(const GAS v4u*)(proj + (r0_ + prow + 32) * IN_DIM + C_QG + h * 128 + pch * 8); \
        st[4] = *(const GAS v4u*)(proj + (r0_ + (krow >> 1)) * IN_DIM + C_KG + h * 128 + (krow & 1) * 64 + kch * 8); \
        st[5] = *(const GAS v4u*)(proj + (r0_ + 32 + (krow >> 1)) * IN_DIM + C_KG + h * 128 + (krow & 1) * 64 + kch * 8); \
        st[6] = *(const GAS v4u*)(QKb + (size_t)item_ * 4096 + krow * 64 + kch * 8); \
        _Pragma("unroll") for (int m_ = 0; m_ < 4; ++m_) { const bf16* p_ = proj + (r0_ + (w * 4 + m_) * 2 + (g >> 1)) * IN_DIM + h * 128 + (g & 1) * 64 + c * 4; \
            un[m_] = *(const GAS v2u*)(p_ + C_VG); zn[m_] = *(const GAS v2u*)(p_ + C_ZG); } \
        dln = gscal[item_]; } while (0)
#define GS_WRITE(buf) do { LAS unsigned char* B_ = L + (buf) * BUFB; \
        *(LAS v4u*)(B_ + dW0) = st[0]; *(LAS v4u*)(B_ + dW1) = st[1]; *(LAS v4u*)(B_ + QD_OFF + dW0) = st[2]; *(LAS v4u*)(B_ + QD_OFF + dW1) = st[3]; \
        *(LAS v4u*)(B_ + dK0) = st[4]; *(LAS v4u*)(B_ + dK1) = st[5]; *(LAS v4u*)(B_ + dQ) = st[6]; } while (0)
    unsigned fW[4], fK[2];
#pragma unroll
    for (int s = 0; s < 4; ++s) fW[s] = c * 256 + (((4 * s + g) ^ c) << 4);
#pragma unroll
    for (int s = 0; s < 2; ++s) fK[s] = c * 128 + (((4 * s + g) ^ ((c >> 1) & 7)) << 4);
    __syncthreads();
    GS_LOAD(0); GS_WRITE(0);
    v2u uw[4], zw[4]; float dl = dln;
#pragma unroll
    for (int m = 0; m < 4; ++m) { uw[m] = un[m]; zw[m] = zn[m]; }
    __syncthreads();
#pragma unroll 1
    for (int chunk = 0; chunk < 32; ++chunk) {
        const int cur = chunk & 1; const LAS unsigned char* B = L + cur * BUFB;
        const size_t r0 = (size_t)(b * 32 + chunk) * 64;
        if (((chunk + 1) & 7) == 0 && chunk + 1 < 32) wait_count((unsigned*)(F.ws + WS_CTL) + CW_SOFT + 64 * l + 48 + ((chunk + 1) >> 3), 192u, w);
        if (chunk + 1 < 32) GS_LOAD(chunk + 1);
        bf16x8 Sb[4];
#pragma unroll
        for (int s = 0; s < 4; ++s) Sb[s] = pack_acc2(S[2 * s], S[2 * s + 1]);
#define LD8_W(dst, off, m0) do { _Pragma("unroll") for (int mm_ = 0; mm_ < 2; ++mm_) _Pragma("unroll") for (int s_ = 0; s_ < 4; ++s_) dst[mm_ * 4 + s_] = *(const LAS bf16x8*)(B + (off) + ((m0) + mm_) * 4096 + fW[s_]); } while (0)
#define LD8_K(dst, off, n0) do { _Pragma("unroll") for (int nn_ = 0; nn_ < 4; ++nn_) _Pragma("unroll") for (int s_ = 0; s_ < 2; ++s_) dst[nn_ * 2 + s_] = *(const LAS bf16x8*)(B + (off) + ((n0) + nn_) * 2048 + fK[s_]); } while (0)
        bf16x8 fa[8], fb[8], fc[8];
        f32x4 Vn[4], O[4];
        LD8_W(fa, W_OFF, 0); LD8_W(fb, W_OFF, 2); SBAR();
#pragma unroll
        for (int mm = 0; mm < 2; ++mm) { f32x4 p = (f32x4){0.f, 0.f, 0.f, 0.f};
#pragma unroll
            for (int s = 0; s < 4; ++s) p = MFMA16(fa[mm * 4 + s], Sb[s], p);
            Vn[mm] = (f32x4){pg8::bf_lo(uw[mm].x), pg8::bf_hi(uw[mm].x), pg8::bf_lo(uw[mm].y), pg8::bf_hi(uw[mm].y)} - p; }
        LD8_W(fa, QD_OFF, 0); SBAR();
#pragma unroll
        for (int mm = 0; mm < 2; ++mm) { f32x4 p = (f32x4){0.f, 0.f, 0.f, 0.f};
#pragma unroll
            for (int s = 0; s < 4; ++s) p = MFMA16(fb[mm * 4 + s], Sb[s], p);
            Vn[2 + mm] = (f32x4){pg8::bf_lo(uw[2 + mm].x), pg8::bf_hi(uw[2 + mm].x), pg8::bf_lo(uw[2 + mm].y), pg8::bf_hi(uw[2 + mm].y)} - p; }
        LD8_W(fb, QD_OFF, 2); SBAR();
        bf16x8 Vb[2];
        Vb[0] = pack_acc2(Vn[0], Vn[1]); Vb[1] = pack_acc2(Vn[2], Vn[3]);
#pragma unroll
        for (int mm = 0; mm < 2; ++mm) { f32x4 o = (f32x4){0.f, 0.f, 0.f, 0.f};
#pragma unroll
            for (int s = 0; s < 4; ++s) o = MFMA16(fa[mm * 4 + s], Sb[s], o);
            O[mm] = o; }
        LD8_K(fc, QK_OFF, 0); SBAR();
#pragma unroll
        for (int mm = 0; mm < 2; ++mm) { f32x4 o = (f32x4){0.f, 0.f, 0.f, 0.f};
#pragma unroll
            for (int s = 0; s < 4; ++s) o = MFMA16(fb[mm * 4 + s], Sb[s], o);
            O[2 + mm] = o; }
        LD8_K(fa, KDT_OFF, 0); SBAR();
#pragma unroll
        for (int mm = 0; mm < 4; ++mm)
#pragma unroll
            for (int s = 0; s < 2; ++s) O[mm] = MFMA16(fc[mm * 2 + s], Vb[s], O[mm]);
        LD8_K(fb, KDT_OFF, 4); SBAR();
#pragma unroll
        for (int n = 0; n < 4; ++n) { f32x4 a = S[n] * dl;
#pragma unroll
            for (int s = 0; s < 2; ++s) a = MFMA16(fa[n * 2 + s], Vb[s], a);
            S[n] = a; }
        SBAR();
#pragma unroll
        for (int n = 0; n < 4; ++n) { f32x4 a = S[4 + n] * dl;
#pragma unroll
            for (int s = 0; s < 2; ++s) a = MFMA16(fb[n * 2 + s], Vb[s], a);
            S[4 + n] = a; }
#undef LD8_W
#undef LD8_K
        LAS float* RED = (LAS float*)(L + RED_OFF) + cur * 512;
#pragma unroll
        for (int m = 0; m < 4; ++m)
#pragma unroll
            for (int r = 0; r < 4; ++r) { const float q = row16_sum(O[m][r] * O[m][r]); if (c == 0) RED[(16 * m + 4 * g + r) * 8 + w] = q; }
               if (chunk + 1 < 32) GS_WRITE(cur ^ 1);
               LBAR();
                LAS float* RSV = (LAS float*)(L + RSV_OFF) + w * 64;
        { const f32x4 a = *(const LAS f32x4*)(RED + lane * 8), b2 = *(const LAS f32x4*)(RED + lane * 8 + 4);
          RSV[lane] = frsq(((a[0] + a[1]) + (a[2] + a[3]) + (b2[0] + b2[1]) + (b2[2] + b2[3])) * (1.f / GDV) + EPS); }
        LAS bf16* OGW = (LAS bf16*)(L + OGW_OFF) + w * 1024;
#pragma unroll
        for (int m = 0; m < 4; ++m) { const f32x4 rs = *(const LAS f32x4*)(RSV + 16 * m + 4 * g);
            const float z0 = pg8::bf_lo(zw[m].x), z1 = pg8::bf_hi(zw[m].x), z2 = pg8::bf_lo(zw[m].y), z3 = pg8::bf_hi(zw[m].y);
            OGW[(16 * m + 4 * g + 0) * 16 + c] = (bf16)f2bf(O[m][0] * rs[0] * gn * siluf(z0));
            OGW[(16 * m + 4 * g + 1) * 16 + c] = (bf16)f2bf(O[m][1] * rs[1] * gn * siluf(z1));
            OGW[(16 * m + 4 * g + 2) * 16 + c] = (bf16)f2bf(O[m][2] * rs[2] * gn * siluf(z2));
            OGW[(16 * m + 4 * g + 3) * 16 + c] = (bf16)f2bf(O[m][3] * rs[3] * gn * siluf(z3)); }
        { const v4u o0 = *(const LAS v4u*)(OGW + lane * 16), o1 = *(const LAS v4u*)(OGW + lane * 16 + 8);
          bf16* zp = proj + (r0 + lane) * IN_DIM + C_ZG + h * 128 + 16 * w;
          *(GAS v4u*)zp = o0; *(GAS v4u*)(zp + 8) = o1; }
#pragma unroll
        for (int m = 0; m < 4; ++m) { uw[m] = un[m]; zw[m] = zn[m]; }
        dl = dln;
    }
#undef GS_LOAD
#undef GS_WRITE
    int tz_ = threadIdx.x; asm volatile("" : "+v"(tz_));
    const int c2_ = tz_ & 15, g2_ = (tz_ >> 4) & 3, w2_ = __builtin_amdgcn_readfirstlane(tz_ >> 6);
    float* So = F.out + O_SP + (((size_t)l * PB + b) * GH + h) * GDK * GDV + (size_t)(4 * g2_) * GDV + 16 * w2_ + c2_;
#pragma unroll
    for (int n = 0; n < 8; ++n) { asm volatile("" : "+v"(So));
#pragma unroll
        for (int r = 0; r < 4; ++r) So[r * GDV] = S[n][r];
        So += 16 * GDV; }
}

struct MlIn { v4u rq, rk, rv[2], ro[2]; float gi, gf; };
__device__ __forceinline__ void mlstm_prep_load(Frame& F, int grp, int h, MlIn& R) {
    const bf16* proj = (const bf16*)(F.ws + WS_PROJ); const float* gates = (const float*)(F.ws + WS_GATES);
    int tl = F.tid; asm volatile("" : "+v"(tl));
    const int r0 = grp * 64, row = tl >> 3, ch = tl & 7;
    R.rq = *(const GAS v4u*)(proj + (size_t)(r0 + row) * IN_DIM + C_QM + h * 64 + ch * 8);
    R.rk = *(const GAS v4u*)(proj + (size_t)(r0 + row) * IN_DIM + C_KM + h * 64 + ch * 8);
#pragma unroll
    for (int k = 0; k < 2; ++k) { const int q = tl + 512 * k, vr = q >> 4, vc = q & 15;
        R.rv[k] = *(const GAS v4u*)(proj + (size_t)(r0 + vr) * IN_DIM + C_VM + h * 128 + vc * 8); R.ro[k] = *(const GAS v4u*)(proj + (size_t)(r0 + vr) * IN_DIM + C_OM + h * 128 + vc * 8); }
    { const int t6 = tl & 63; R.gi = gates[(size_t)(r0 + t6) * 16 + 8 + h]; R.gf = gates[(size_t)(r0 + t6) * 16 + 12 + h]; }
}
__device__ __forceinline__ void mlstm_prep_item(Frame& F, int l, int grp, int h, MlIn& R, int nxt) {
    LAS unsigned char* L = F.lds + RING_OFF;
    constexpr int PQ = 72, PV_ = 136;
    LAS bf16* QB = (LAS bf16*)L;
    LAS bf16* KB = (LAS bf16*)(L + 9216);
    LAS bf16* VB = (LAS bf16*)(L + 18432);
    LAS bf16* OB = (LAS bf16*)(L + 18432 + 17408);
    LAS bf16* PS = (LAS bf16*)(L + 18432 + 2 * 17408);
    LAS float* SC = (LAS float*)(L + 18432 + 2 * 17408 + 8192);
    bf16* proj = (bf16*)(F.ws + WS_PROJ);
    const float* gates = (const float*)(F.ws + WS_GATES);
    const int r0 = grp * 64, item = grp * 4 + h;
    bf16* Pg = (bf16*)(F.ws + WS_XN + XN_PBUF) + (size_t)item * 4096;
    float* msc = (float*)(F.ws + WS_MSCAL) + (size_t)item * 256;
    LBAR();
    int tl = F.tid; asm volatile("" : "+v"(tl));
    {
        const int row = tl >> 3, ch = tl & 7;
        *(LAS v4u*)(QB + row * PQ + ch * 8) = R.rq; *(LAS v4u*)(KB + row * PQ + ch * 8) = R.rk;
#pragma unroll
        for (int k = 0; k < 2; ++k) { const int q = tl + 512 * k, vr = q >> 4, vc = q & 15; *(LAS v4u*)(VB + vr * PV_ + vc * 8) = R.rv[k]; *(LAS v4u*)(OB + vr * PV_ + vc * 8) = R.ro[k]; }
        if (tl < 64) { SC[tl] = R.gi + F.a->in[I_IB][l * MH + h]; SC[64 + tl] = -softplusf(-(R.gf + F.a->in[I_FB][l * MH + h])); }
    }
    asm volatile("" ::: "memory");
    if (nxt >= 0) mlstm_prep_load(F, (nxt & 1023) >> 2, nxt & 3, R);
    LBAR();
    tl = F.tid; asm volatile("" : "+v"(tl));
    if (tl < 64) {
        const int lane = tl; const float x = wave_scan_add(SC[64 + lane]);
        const float u = SC[lane] - x; const float pm = wave_scan_max(u);
        const float pml = __builtin_bit_cast(float, __builtin_amdgcn_readlane(__builtin_bit_cast(int, pm), 63));
        SC[128 + lane] = x; SC[192 + lane] = u; SC[256 + lane] = pm; SC[320 + lane] = __expf(u - pml);
        msc[lane] = x; msc[64 + lane] = x + pm;
    }
    LBAR();
    tl = F.tid; asm volatile("" : "+v"(tl));
    if (tl < 256) {
        const int lane_ = tl & 63, ti = __builtin_amdgcn_readfirstlane(tl >> 6), fr = lane_ & 15, g = lane_ >> 4;
        float rsum[4] = {0.f, 0.f, 0.f, 0.f};
        for (int tj = 0; tj < 4; ++tj) {
            f32x4 acc = (f32x4){0.f, 0.f, 0.f, 0.f};
            if (tj <= ti) {
#pragma unroll
                for (int s = 0; s < 2; ++s) { const bf16x8 a = *(const LAS bf16x8*)(QB + (16 * ti + fr) * PQ + 32 * s + 8 * g), bq = *(const LAS bf16x8*)(KB + (16 * tj + fr) * PQ + 32 * s + 8 * g);
                    acc = MFMA16(a, bq, acc); }
            }
            const int j = 16 * tj + fr; const float uj = SC[192 + j];
#pragma unroll
            for (int r = 0; r < 4; ++r) { const int i = 16 * ti + 4 * g + r;
                const float p = (j <= i) ? __expf(fminf(uj - SC[256 + i], 0.f)) * 0.125f * acc[r] : 0.f;
                rsum[r] += p; PS[i * 64 + permk(j)] = (bf16)f2bf(p); }
        }
#pragma unroll
        for (int r = 0; r < 4; ++r) { float q = rsum[r]; q += __shfl_xor(q, 1); q += __shfl_xor(q, 2); q += __shfl_xor(q, 4); q += __shfl_xor(q, 8);
            if (fr == 0) msc[128 + 16 * ti + 4 * g + r] = q; }
    } else {
        const int t2 = tl - 256;
#pragma unroll
        for (int k = 0; k < 2; ++k) { const int q = t2 + 256 * k, t = q >> 3, ch = q & 7, s = ch >> 2, g = ch & 3;
            const v2u a = *(const LAS v2u*)(QB + t * PQ + 32 * s + 4 * g), b2 = *(const LAS v2u*)(QB + t * PQ + 32 * s + 16 + 4 * g);
            v4u o; o.x = pk2(pg8::bf_lo(a.x) * 0.125f, pg8::bf_hi(a.x) * 0.125f); o.y = pk2(pg8::bf_lo(a.y) * 0.125f, pg8::bf_hi(a.y) * 0.125f);
            o.z = pk2(pg8::bf_lo(b2.x) * 0.125f, pg8::bf_hi(b2.x) * 0.125f); o.w = pk2(pg8::bf_lo(b2.y) * 0.125f, pg8::bf_hi(b2.y) * 0.125f);
            *(GAS v4u*)(proj + (size_t)(r0 + t) * IN_DIM + C_QM + h * 64 + ch * 8) = o; }
#pragma unroll
        for (int k = 0; k < 2; ++k) { const int q = t2 + 256 * k, dk = q >> 3, ch = q & 7, s = ch >> 2, g = ch & 3; float v[8];
#pragma unroll
            for (int e = 0; e < 8; ++e) { const int tok = 32 * s + lperm(g, e); v[e] = bf2f(KB[tok * PQ + dk]) * SC[320 + tok]; }
            v4u o; o.x = pk2(v[0], v[1]); o.y = pk2(v[2], v[3]); o.z = pk2(v[4], v[5]); o.w = pk2(v[6], v[7]);
            *(GAS v4u*)(proj + (size_t)(r0 + dk) * IN_DIM + C_KM + h * 64 + ch * 8) = o; }
        if (t2 < 64) { float a = 0.f;
            for (int tok = 0; tok < 64; ++tok) a += bf2f(KB[tok * PQ + t2]) * SC[320 + tok];
            msc[192 + t2] = a; }
#pragma unroll
        for (int k = 0; k < 4; ++k) { const int q = t2 + 256 * k, cc = q & 15, g = (q >> 4) & 3, s = (q >> 6) & 1, w = q >> 7; float v[8];
#pragma unroll
            for (int e = 0; e < 8; ++e) v[e] = bf2f(VB[(32 * s + lperm(g, e)) * PV_ + 16 * w + cc]);
            v4u o; o.x = pk2(v[0], v[1]); o.y = pk2(v[2], v[3]); o.z = pk2(v[4], v[5]); o.w = pk2(v[6], v[7]);
            *(GAS v4u*)(proj + (size_t)(r0 + (w * 2 + s) * 4 + g) * IN_DIM + C_VM + h * 128 + cc * 8) = o; }
#pragma unroll
        for (int k = 0; k < 4; ++k) {
            const int q = t2 + 256 * k, cp2 = q & 7, g = (q >> 3) & 3, mm = (q >> 5) & 3, w = q >> 7; unsigned short zv[8];
#pragma unroll
            for (int e = 0; e < 8; ++e) zv[e] = OB[(16 * mm + 4 * g + (e & 3)) * PV_ + 16 * w + 2 * cp2 + (e >> 2)];
            v4u o; o.x = zv[0] | ((unsigned)zv[1] << 16); o.y = zv[2] | ((unsigned)zv[3] << 16); o.z = zv[4] | ((unsigned)zv[5] << 16); o.w = zv[6] | ((unsigned)zv[7] << 16);
            *(GAS v4u*)(proj + (size_t)(r0 + (w * 4 + mm) * 2 + (g >> 1)) * IN_DIM + C_OM + h * 128 + (g & 1) * 64 + cp2 * 8) = o; }
    }
    LBAR();
    tl = F.tid; asm volatile("" : "+v"(tl));
    *(GAS v4u*)(Pg + tl * 8) = *(const LAS v4u*)(PS + tl * 8);
}

__device__ __forceinline__ void mlstm_scan_prompt(Frame& F, int l, int b, int h) {
    LAS unsigned char* L = F.lds + RING_OFF;
    constexpr int BUFB = 24576, P_OFF = 0, QS_OFF = 8192, KGT_OFF = 16384, SCL_OFF = 2 * BUFB, RED_OFF = SCL_OFF + 2048, RSV_OFF = RED_OFF + 4096, OGW_OFF = RSV_OFF + 2048;
    bf16* proj = (bf16*)(F.ws + WS_PROJ);
    const bf16* Pb = (const bf16*)(F.ws + WS_XN + XN_PBUF);
    const float* mscal = (const float*)(F.ws + WS_MSCAL);
    int tl_ = F.tid; asm volatile("" : "+v"(tl_));
    const int tid = tl_, lane = tid & 63, w = __builtin_amdgcn_readfirstlane(tid >> 6), c = lane & 15, g = lane >> 4;
    const float mn = F.a->in[I_MNORM][(size_t)l * 512 + h * 128 + 16 * w + c];
    f32x4 C[4]; float nv[16]; float m = 0.f;
#pragma unroll
    for (int n = 0; n < 4; ++n) C[n] = (f32x4){0.f, 0.f, 0.f, 0.f};
#pragma unroll
    for (int i = 0; i < 16; ++i) nv[i] = 0.f;
    const int krow = tid >> 3, kch = tid & 7;
    const unsigned dP = krow * 128 + ((kch ^ ((krow >> 1) & 7)) << 4);
    v4u st[3]; f32x4 stsc; bf16x8 vfn[2]; v2u ogn[4];
#define MS_LOAD(chunk) do { const int grp_ = b * 32 + (chunk), item_ = grp_ * 4 + h; const size_t r0_ = (size_t)grp_ * 64; \
        st[0] = *(const GAS v4u*)(Pb + (size_t)item_ * 4096 + krow * 64 + kch * 8); \
        st[1] = *(const GAS v4u*)(proj + (r0_ + krow) * IN_DIM + C_QM + h * 64 + kch * 8); \
        st[2] = *(const GAS v4u*)(proj + (r0_ + krow) * IN_DIM + C_KM + h * 64 + kch * 8); \
        stsc = *(const GAS f32x4*)(mscal + (size_t)item_ * 256 + 4 * (tid & 63)); \
        _Pragma("unroll") for (int s_ = 0; s_ < 2; ++s_) vfn[s_] = *(const GAS bf16x8*)(proj + (r0_ + (w * 2 + s_) * 4 + g) * IN_DIM + C_VM + h * 128 + c * 8); \
        _Pragma("unroll") for (int m_ = 0; m_ < 4; ++m_) ogn[m_] = *(const GAS v2u*)(proj + (r0_ + (w * 4 + m_) * 2 + (g >> 1)) * IN_DIM + C_OM + h * 128 + (g & 1) * 64 + c * 4); } while (0)
#define MS_WRITE(buf) do { LAS unsigned char* B_ = L + (buf) * BUFB; \
        *(LAS v4u*)(B_ + P_OFF + dP) = st[0]; *(LAS v4u*)(B_ + QS_OFF + dP) = st[1]; *(LAS v4u*)(B_ + KGT_OFF + dP) = st[2]; \
        if (tid < 64) *(LAS f32x4*)(L + SCL_OFF + (buf) * 1024 + 16 * tid) = stsc; } while (0)
    unsigned fK[2];
#pragma unroll
    for (int s = 0; s < 2; ++s) fK[s] = c * 128 + (((4 * s + g) ^ ((c >> 1) & 7)) << 4);
    __syncthreads();
    MS_LOAD(0); MS_WRITE(0);
    bf16x8 Vf[2]; v2u ogw[4];
    Vf[0] = vfn[0]; Vf[1] = vfn[1];
#pragma unroll
    for (int mm = 0; mm < 4; ++mm) ogw[mm] = ogn[mm];
    __syncthreads();
#pragma unroll 1
    for (int chunk = 0; chunk < 32; ++chunk) {
        const int cur = chunk & 1; const LAS unsigned char* B = L + cur * BUFB; const LAS float* SCL = (const LAS float*)(L + SCL_OFF + cur * 1024);
        const size_t r0 = (size_t)(b * 32 + chunk) * 64;
        if (((chunk + 1) & 7) == 0 && chunk + 1 < 32) wait_count((unsigned*)(F.ws + WS_CTL) + CW_SOFT + 64 * l + 48 + ((chunk + 1) >> 3), 192u, w);
        if (chunk + 1 < 32) MS_LOAD(chunk + 1);
        bf16x8 Cb[2], nb[2];
#pragma unroll
        for (int s = 0; s < 2; ++s) { Cb[s] = pack_acc2(C[2 * s], C[2 * s + 1]);
            nb[s] = pack_acc2((f32x4){nv[8 * s], nv[8 * s + 1], nv[8 * s + 2], nv[8 * s + 3]}, (f32x4){nv[8 * s + 4], nv[8 * s + 5], nv[8 * s + 6], nv[8 * s + 7]}); }
        const float Fl = SCL[63], Gmax = SCL[127];
        f32x4 H[4];
#define LD8_K(dst, off) do { _Pragma("unroll") for (int nn_ = 0; nn_ < 4; ++nn_) _Pragma("unroll") for (int s_ = 0; s_ < 2; ++s_) dst[nn_ * 2 + s_] = *(const LAS bf16x8*)(B + (off) + nn_ * 2048 + fK[s_]); } while (0)
        bf16x8 fa[8], fb[8];
        LD8_K(fa, QS_OFF); LD8_K(fb, P_OFF); SBAR();
#pragma unroll
        for (int mm = 0; mm < 4; ++mm) {
            f32x4 qc = (f32x4){0.f, 0.f, 0.f, 0.f}, qn = qc, pv = qc;
#pragma unroll
            for (int s = 0; s < 2; ++s) { qc = MFMA16(fa[mm * 2 + s], Cb[s], qc); qn = MFMA16(fa[mm * 2 + s], nb[s], qn); pv = MFMA16(fb[mm * 2 + s], Vf[s], pv); }
            const f32x4 Fi = *(const LAS f32x4*)(SCL + 16 * mm + 4 * g), Dm = *(const LAS f32x4*)(SCL + 64 + 16 * mm + 4 * g), rsm = *(const LAS f32x4*)(SCL + 128 + 16 * mm + 4 * g);
#pragma unroll
            for (int r = 0; r < 4; ++r) { const float mrow = fmaxf(Dm[r], m + Fi[r]), a = __expf(m + Fi[r] - mrow), e = __expf(Dm[r] - mrow);
                const float num = a * qc[r] + e * pv[r], den = a * qn[r] + e * rsm[r];
                H[mm][r] = num * frcp(fmaxf(fabsf(den), __expf(-mrow))); }
        }
        SBAR();
        LD8_K(fa, KGT_OFF); SBAR();
        const float mnew = fmaxf(m + Fl, Gmax), dec = __expf(m + Fl - mnew), eGs = __expf(Gmax - mnew);
#pragma unroll
        for (int n = 0; n < 4; ++n) { f32x4 t = (f32x4){0.f, 0.f, 0.f, 0.f};
#pragma unroll
            for (int s = 0; s < 2; ++s) t = MFMA16(fa[n * 2 + s], Vf[s], t);
            C[n] = C[n] * dec + t * eGs; }
#undef LD8_K
#pragma unroll
        for (int s = 0; s < 2; ++s) { const f32x4 k0 = *(const LAS f32x4*)(SCL + 192 + 32 * s + 4 * g), k1 = *(const LAS f32x4*)(SCL + 192 + 32 * s + 16 + 4 * g);
#pragma unroll
            for (int j = 0; j < 4; ++j) { nv[8 * s + j] = dec * nv[8 * s + j] + eGs * k0[j]; nv[8 * s + 4 + j] = dec * nv[8 * s + 4 + j] + eGs * k1[j]; } }
        m = mnew;
        LAS float* RED = (LAS float*)(L + RED_OFF) + cur * 512;
#pragma unroll
        for (int mm = 0; mm < 4; ++mm)
#pragma unroll
            for (int r = 0; r < 4; ++r) { const float q = row16_sum(H[mm][r] * H[mm][r]); if (c == 0) RED[(16 * mm + 4 * g + r) * 8 + w] = q; }
        if (chunk + 1 < 32) MS_WRITE(cur ^ 1);
        LBAR();
        LAS float* RSV = (LAS float*)(L + RSV_OFF) + w * 64;
        { const f32x4 a = *(const LAS f32x4*)(RED + lane * 8), b2 = *(const LAS f32x4*)(RED + lane * 8 + 4);
          RSV[lane] = frsq(((a[0] + a[1]) + (a[2] + a[3]) + (b2[0] + b2[1]) + (b2[2] + b2[3])) * (1.f / MDV) + EPS); }
        LAS bf16* OGW = (LAS bf16*)(L + OGW_OFF) + w * 1024;
#pragma unroll
        for (int mm = 0; mm < 4; ++mm) { const f32x4 rs = *(const LAS f32x4*)(RSV + 16 * mm + 4 * g);
            const float z0 = pg8::bf_lo(ogw[mm].x), z1 = pg8::bf_hi(ogw[mm].x), z2 = pg8::bf_lo(ogw[mm].y), z3 = pg8::bf_hi(ogw[mm].y);
            OGW[(16 * mm + 4 * g + 0) * 16 + c] = (bf16)f2bf(H[mm][0] * rs[0] * mn * sigm(z0));
            OGW[(16 * mm + 4 * g + 1) * 16 + c] = (bf16)f2bf(H[mm][1] * rs[1] * mn * sigm(z1));
            OGW[(16 * mm + 4 * g + 2) * 16 + c] = (bf16)f2bf(H[mm][2] * rs[2] * mn * sigm(z2));
            OGW[(16 * mm + 4 * g + 3) * 16 + c] = (bf16)f2bf(H[mm][3] * rs[3] * mn * sigm(z3)); }
        { const v4u o0 = *(const LAS v4u*)(OGW + lane * 16), o1 = *(const LAS v4u*)(OGW + lane * 16 + 8);
          bf16* op = proj + (r0 + lane) * IN_DIM + C_OM + h * 128 + 16 * w;
          *(GAS v4u*)op = o0; *(GAS v4u*)(op + 8) = o1; }
        Vf[0] = vfn[0]; Vf[1] = vfn[1];
#pragma unroll
        for (int mm = 0; mm < 4; ++mm) ogw[mm] = ogn[mm];
    }
#undef MS_LOAD
#undef MS_WRITE
    const size_t sidx = ((size_t)l * PB + b) * MH + h;
    int tz_ = threadIdx.x; asm volatile("" : "+v"(tz_));
    const int c2_ = tz_ & 15, g2_ = (tz_ >> 4) & 3, w2_ = __builtin_amdgcn_readfirstlane(tz_ >> 6);
    float* Co = F.out + O_CP + sidx * MDK * MDV + (size_t)(4 * g2_) * MDV + 16 * w2_ + c2_;
#pragma unroll
    for (int n = 0; n < 4; ++n) { asm volatile("" : "+v"(Co));
#pragma unroll
        for (int r = 0; r < 4; ++r) Co[r * MDV] = C[n][r];
        Co += 16 * MDV; }
    if (w2_ == 0 && c2_ == 0) { float* no = F.out + O_NP + sidx * MDK;
#pragma unroll
        for (int s = 0; s < 2; ++s)
#pragma unroll
            for (int j = 0; j < 8; ++j) no[32 * s + lperm(g2_, j)] = nv[8 * s + j]; }
    if (tz_ == 0) F.out[O_MP + sidx] = m;
}
__device__ __forceinline__ void prep_group(Frame& F, int l, int g, int gw, int gnw, int mw, int mnw) {
    const float* cw = F.a->in[I_CONVW] + (size_t)l * 4 * CONVC;
#define PG_B(j) (((((j) >> 6) & 3) << 1) | (((j) >> 2) & 1))
#define PG_ITEM(j) ((((PG_B(j) * 32) + 8 * g + (((j) >> 3) & 7)) << 2) | ((j) & 3))
    if (gw >= 0) {
        GdnIn R; GdnConst K;
        { int tl = F.tid; asm volatile("" : "+v"(tl)); const int hh = gw & 3, s = tl >> 7, e = tl & 127; const int col = (tl < 384) ? s * 512 + hh * 128 + e : 0;
          K.w0 = cw[col]; K.w1 = cw[CONVC + col]; K.w2 = cw[2 * CONVC + col]; K.w3 = cw[3 * CONVC + col];
          K.aexp = __expf(F.a->in[I_ALOG][l * GH + hh]); K.dtb = F.a->in[I_DTB][l * GH + hh]; }
        if (gw < 256) { const int id = PG_ITEM(gw); gdn_prep_load(F, id >> 2, id & 3, R); }
        for (int j = gw; j < 256; j += gnw) { const int id = PG_ITEM(j), nj = j + gnw; gdn_prep_item(F, l, id >> 2, id & 3, R, K, nj < 256 ? PG_ITEM(nj) : -1); }
    }
    if (mw >= 0) {
        MlIn R;
        if (mw < 256) { const int id = PG_ITEM(mw); mlstm_prep_load(F, id >> 2, id & 3, R); }
        for (int j = mw; j < 256; j += mnw) { const int id = PG_ITEM(j), nj = j + mnw; mlstm_prep_item(F, l, id >> 2, id & 3, R, nj < 256 ? PG_ITEM(nj) : -1); }
    }
#undef PG_ITEM
#undef PG_B
}
__device__ __forceinline__ void fe_sample_items(Frame& F, int l) {
    int tq_ = threadIdx.x; asm volatile("" : "+v"(tq_)); const int lane_ = tq_ & 63, wave_ = __builtin_amdgcn_readfirstlane(tq_ >> 6);
    LAS float* XP = (LAS float*)(F.lds + RING_OFF);
    bf16* proj = (bf16*)(F.ws + WS_PROJ);
    const float* cw = F.a->in[I_CONVW] + (size_t)l * 4 * CONVC;
    constexpr int NP_ITEMS = 256 * GH, NS_ITEMS = 16 * GH;
    for (int it = 2 * NP_ITEMS + F.bid; it < 2 * NP_ITEMS + NS_ITEMS; it += F.G) {
        const bool prompt = false;
        const int h = it & 3, grp = (it - 2 * NP_ITEMS) >> 2;
        __syncthreads();
        {
            const int b0 = grp * 8;
            const float* st = F.a->in[I_SCONV] + (size_t)l * SB * 3 * CONVC;
            for (int q = tq_; q < 8 * 7 * 48; q += NWAVES * 64) {
                const int sq = q / (7 * 48), rem = q % (7 * 48), j = rem / 48, s = (rem % 48) >> 4, ch = rem & 15;
                LAS float* d = XP + (sq * 7 + j) * 384 + s * 128 + ch * 8;
                if (j >= 3) { const v4u w = *(const GAS v4u*)(proj + (size_t)(MP + (b0 + sq) * 4 + j - 3) * IN_DIM + s * 512 + h * 128 + ch * 8);
                    d[0] = pg8::bf_lo(w.x); d[1] = pg8::bf_hi(w.x); d[2] = pg8::bf_lo(w.y); d[3] = pg8::bf_hi(w.y); d[4] = pg8::bf_lo(w.z); d[5] = pg8::bf_hi(w.z); d[6] = pg8::bf_lo(w.w); d[7] = pg8::bf_hi(w.w);
                } else { const float* sp = st + ((size_t)(b0 + sq) * 3 + j) * CONVC + s * 512 + h * 128 + ch * 8;
#pragma unroll
                    for (int e = 0; e < 8; ++e) d[e] = sp[e]; }
            }
        }
        __syncthreads();
        float w4[3][2][4];
#pragma unroll
        for (int s = 0; s < 3; ++s)
#pragma unroll
            for (int e = 0; e < 2; ++e)
#pragma unroll
                for (int j = 0; j < 4; ++j) w4[s][e][j] = cw[(size_t)j * CONVC + s * 512 + h * 128 + lane_ + 64 * e];
        const int ntok = prompt ? 8 : 4;
        for (int tt = 0; tt < ntok; ++tt) {
            const LAS float* base; size_t row;
            if (prompt) { const int t = wave_ * 8 + tt; base = XP + t * 384; row = (size_t)grp * 64 + t; }
            else { base = XP + (wave_ * 7 + tt) * 384; row = (size_t)MP + (size_t)(grp * 8 + wave_) * 4 + tt; }
            float y[3][2];
#pragma unroll
            for (int s = 0; s < 3; ++s)
#pragma unroll
                for (int e = 0; e < 2; ++e) { float a = 0.f;
#pragma unroll
                    for (int j = 0; j < 4; ++j) a += base[j * 384 + s * 128 + lane_ + 64 * e] * w4[s][e][j];
                    y[s][e] = siluf(a); }
            const float sq = wave_sum(y[0][0] * y[0][0] + y[0][1] * y[0][1]), sk = wave_sum(y[1][0] * y[1][0] + y[1][1] * y[1][1]);
            const float rq = (frsq(sq + EPS)) * 0.08838834764831845f, rk = frsq(sk + EPS);
            bf16* pr = proj + row * IN_DIM + h * 128 + lane_;
            pr[C_QG] = (bf16)f2bf(y[0][0] * rq); pr[C_QG + 64] = (bf16)f2bf(y[0][1] * rq);
            pr[C_KG] = (bf16)f2bf(y[1][0] * rk); pr[C_KG + 64] = (bf16)f2bf(y[1][1] * rk);
            pr[C_VG] = (bf16)f2bf(y[2][0]);      pr[C_VG + 64] = (bf16)f2bf(y[2][1]);
        }
        if (prompt) {
            if ((grp & 31) == 31) { float* cp = F.out + O_CONVP + ((size_t)l * PB + (grp >> 5)) * 3 * CONVC;
                for (int q = tq_; q < 3 * 384; q += NWAVES * 64) { const int j = q / 384, x = q % 384; cp[(size_t)j * CONVC + (x >> 7) * 512 + h * 128 + (x & 127)] = XP[(64 + j) * 384 + x]; } }
        } else {
            float* cs = F.out + O_CONVS + ((size_t)l * SB + grp * 8) * 3 * CONVC;
            for (int q = tq_; q < 8 * 3 * 384; q += NWAVES * 64) { const int sq = q / (3 * 384), rem = q % (3 * 384), j = rem / 384, x = rem % 384;
                cs[((size_t)sq * 3 + j) * CONVC + (x >> 7) * 512 + h * 128 + (x & 127)] = XP[(sq * 7 + 4 + j) * 384 + x]; }
        }
    }
}

__device__ __forceinline__ void gdn_seq(Frame& F, int l, int h, int row0, int T, const float* S0, float* Sout) {
    LAS float* L = (LAS float*)(F.lds + RING_OFF);
    LAS float* QKVZ = L;
    LAS float* SC = L + 2048;
    LAS float* RED = L + 2048 + 8;
    LAS float* RED2 = RED + 512;
    LAS float* OB = RED2 + 512;
    bf16* proj = (bf16*)(F.ws + WS_PROJ);
    const float* gates = (const float*)(F.ws + WS_GATES);
    int tl_ = F.tid; asm volatile("" : "+v"(tl_)); const int tid_ = tl_, lane_ = tid_ & 63, wave_ = __builtin_amdgcn_readfirstlane(tid_ >> 6);
    const int dv = tid_ & 127, kq = tid_ >> 7;
    const float Aexp = __expf(F.a->in[I_ALOG][l * GH + h]), dtb = F.a->in[I_DTB][l * GH + h];
    const float gn0 = F.a->in[I_GNORM][l * GDV + lane_], gn1 = F.a->in[I_GNORM][l * GDV + lane_ + 64];
    float S[32];
    if (S0) {
#pragma unroll
        for (int i0 = 0; i0 < 32; i0 += 8) { const float* sp = S0 + (size_t)(32 * kq + i0) * GDV + dv; asm volatile("" : "+v"(sp));
#pragma unroll
            for (int i = 0; i < 8; ++i) S[i0 + i] = sp[i * GDV]; }
    } else {
#pragma unroll
        for (int i = 0; i < 32; ++i) S[i] = 0.f;
    }
    for (int t0 = 0; t0 < T; t0 += 4) {
        __syncthreads();
        { const int tok = tid_ >> 7, e = tid_ & 127; const size_t row = (size_t)row0 + t0 + tok; const bf16* pr = proj + row * IN_DIM + h * 128 + e;
          QKVZ[(tok * 4 + 0) * 128 + e] = bf2f(pr[C_QG]); QKVZ[(tok * 4 + 1) * 128 + e] = bf2f(pr[C_KG]); QKVZ[(tok * 4 + 2) * 128 + e] = bf2f(pr[C_VG]); QKVZ[(tok * 4 + 3) * 128 + e] = bf2f(pr[C_ZG]);
          if (e == 0) { SC[tok * 2] = sigm(gates[row * 16 + h]); SC[tok * 2 + 1] = __expf(-Aexp * softplusf(gates[row * 16 + 4 + h] + dtb)); } }
        __syncthreads();
#pragma unroll 1
        for (int tok = 0; tok < 4; ++tok) {
            const LAS float* q = QKVZ + (tok * 4 + 0) * 128 + 32 * kq; const LAS float* k = QKVZ + (tok * 4 + 1) * 128 + 32 * kq;
            const float v = QKVZ[(tok * 4 + 2) * 128 + dv], beta = SC[tok * 2], eg = SC[tok * 2 + 1];
            float kk[32]; float rp = 0.f;
#pragma unroll
            for (int i = 0; i < 32; ++i) { kk[i] = k[i]; rp += kk[i] * S[i]; }
            RED[kq * 128 + dv] = rp;
            __syncthreads();
            const float r = (RED[dv] + RED[128 + dv]) + (RED[256 + dv] + RED[384 + dv]);
            const float coef = beta * (v - eg * r);
            float op = 0.f;
#pragma unroll
            for (int i = 0; i < 32; ++i) { S[i] = eg * S[i] + kk[i] * coef; op += q[i] * S[i]; }
            RED2[kq * 128 + dv] = op;
            __syncthreads();
            if (kq == 0) OB[tok * 128 + dv] = (RED2[dv] + RED2[128 + dv]) + (RED2[256 + dv] + RED2[384 + dv]);
        }
        __syncthreads();
        if (wave_ < 4) { const int tok = wave_; const size_t row = (size_t)row0 + t0 + tok;
            const float o0 = OB[tok * 128 + lane_], o1 = OB[tok * 128 + lane_ + 64];
            const float rs = frsq(wave_sum(o0 * o0 + o1 * o1) * (1.f / GDV) + EPS);
            const float z0 = QKVZ[(tok * 4 + 3) * 128 + lane_], z1 = QKVZ[(tok * 4 + 3) * 128 + lane_ + 64];
            bf16* pr = proj + row * IN_DIM + C_ZG + h * 128 + lane_;
            pr[0] = (bf16)f2bf(o0 * rs * gn0 * siluf(z0)); pr[64] = (bf16)f2bf(o1 * rs * gn1 * siluf(z1)); }
    }
#pragma unroll
    for (int i0 = 0; i0 < 32; i0 += 8) { float* sp = Sout + (size_t)(32 * kq + i0) * GDV + dv; asm volatile("" : "+v"(sp));
#pragma unroll
        for (int i = 0; i < 8; ++i) sp[i * GDV] = S[i0 + i]; }
}
__device__ __forceinline__ void mlstm_seq(Frame& F, int l, int h, int row0, int T, const float* C0, const float* n0, const float* m0, float* Cout, float* nout, float* mout) {
    LAS float* L = (LAS float*)(F.lds + RING_OFF);
    LAS float* QK = L;
    LAS float* VO = L + 512;
    LAS float* SC = VO + 1024;
    LAS float* RED = SC + 8;
    LAS float* REDD = RED + 512;
    LAS float* OB = REDD + 4;
    bf16* proj = (bf16*)(F.ws + WS_PROJ);
    const float* gates = (const float*)(F.ws + WS_GATES);
    int tl_ = F.tid; asm volatile("" : "+v"(tl_)); const int tid_ = tl_, lane_ = tid_ & 63, wave_ = __builtin_amdgcn_readfirstlane(tid_ >> 6);
    const int dv = tid_ & 127, kq = tid_ >> 7;
    const float ib = F.a->in[I_IB][l * MH + h], fb = F.a->in[I_FB][l * MH + h];
    const float mn0 = F.a->in[I_MNORM][(size_t)l * 512 + h * 128 + lane_], mn1 = F.a->in[I_MNORM][(size_t)l * 512 + h * 128 + lane_ + 64];
    float C[16], n[16]; float m = m0 ? m0[0] : 0.f;
    if (C0) {
#pragma unroll
        for (int i0 = 0; i0 < 16; i0 += 8) { const float* sp = C0 + (size_t)(16 * kq + i0) * MDV + dv; asm volatile("" : "+v"(sp));
#pragma unroll
            for (int i = 0; i < 8; ++i) C[i0 + i] = sp[i * MDV]; }
#pragma unroll
        for (int i = 0; i < 16; ++i) n[i] = n0[16 * kq + i];
    } else {
#pragma unroll
        for (int i = 0; i < 16; ++i) { C[i] = 0.f; n[i] = 0.f; }
    }
    for (int t0 = 0; t0 < T; t0 += 4) {
        __syncthreads();
        { const int tok = tid_ >> 7, e = tid_ & 127; const size_t row = (size_t)row0 + t0 + tok; const bf16* pr = proj + row * IN_DIM;
          if (e < 64) QK[(tok * 2 + 0) * 64 + e] = bf2f(pr[C_QM + h * 64 + e]) * 0.125f; else QK[(tok * 2 + 1) * 64 + (e - 64)] = bf2f(pr[C_KM + h * 64 + (e - 64)]);
          VO[(tok * 2 + 0) * 128 + e] = bf2f(pr[C_VM + h * 128 + e]); VO[(tok * 2 + 1) * 128 + e] = bf2f(pr[C_OM + h * 128 + e]);
          if (e == 0) { SC[tok * 2] = gates[row * 16 + 8 + h] + ib; SC[tok * 2 + 1] = -softplusf(-(gates[row * 16 + 12 + h] + fb)); } }
        __syncthreads();
#pragma unroll 1
        for (int tok = 0; tok < 4; ++tok) {
            const LAS float* q = QK + (tok * 2 + 0) * 64 + 16 * kq; const LAS float* k = QK + (tok * 2 + 1) * 64 + 16 * kq;
            const float v = VO[(tok * 2 + 0) * 128 + dv], li = SC[tok * 2], lf = SC[tok * 2 + 1];
            const float mnew = fmaxf(lf + m, li), fd = __expf(lf + m - mnew), iw = __expf(li - mnew); m = mnew;
            float np = 0.f, dp = 0.f; const float iv = iw * v;
#pragma unroll
            for (int i = 0; i < 16; ++i) { const float ki = k[i], qi = q[i]; C[i] = fd * C[i] + ki * iv; n[i] = fd * n[i] + iw * ki; np += qi * C[i]; dp += qi * n[i]; }
            RED[kq * 128 + dv] = np; if (dv == 0) REDD[kq] = dp;
            __syncthreads();
            const float num = (RED[dv] + RED[128 + dv]) + (RED[256 + dv] + RED[384 + dv]), den = (REDD[0] + REDD[1]) + (REDD[2] + REDD[3]);
            if (kq == 0) OB[tok * 128 + dv] = num * frcp(fmaxf(fabsf(den), __expf(-m)));
            __syncthreads();
        }
        if (wave_ < 4) { const int tok = wave_; const size_t row = (size_t)row0 + t0 + tok;
            const float o0 = OB[tok * 128 + lane_], o1 = OB[tok * 128 + lane_ + 64];
            const float rs = frsq(wave_sum(o0 * o0 + o1 * o1) * (1.f / MDV) + EPS);
            const float g0 = VO[(tok * 2 + 1) * 128 + lane_], g1 = VO[(tok * 2 + 1) * 128 + lane_ + 64];
            bf16* pr = proj + row * IN_DIM + C_OM + h * 128 + lane_;
            pr[0] = (bf16)f2bf(o0 * rs * mn0 * sigm(g0)); pr[64] = (bf16)f2bf(o1 * rs * mn1 * sigm(g1)); }
    }
#pragma unroll
    for (int i0 = 0; i0 < 16; i0 += 8) { float* sp = Cout + (size_t)(16 * kq + i0) * MDV + dv; asm volatile("" : "+v"(sp));
#pragma unroll
        for (int i = 0; i < 8; ++i) sp[i * MDV] = C[i0 + i]; }
    if (dv == 0) {
#pragma unroll
        for (int i = 0; i < 16; ++i) nout[16 * kq + i] = n[i]; }
    if (tid_ == 0) mout[0] = m;
}
__device__ __forceinline__ void scan_item(Frame& F, int l, int it) {
    if (it < 32) { const int b = it >> 2, h = it & 3; gdn_scan_prompt(F, l, b, h); }
    else if (it < 64) { const int j = it - 32, b = j >> 2, h = j & 3; mlstm_scan_prompt(F, l, b, h); }
    else if (it < 576) { const int j = it - 64, b = j >> 2, h = j & 3; const size_t sidx = ((size_t)l * SB + b) * GH + h;
        gdn_seq(F, l, h, MP + b * ST, ST, F.a->in[I_SS] + sidx * GDK * GDV, F.out + O_SS + sidx * GDK * GDV); }
    else { const int j = it - 576, b = j >> 2, h = j & 3; const size_t sidx = ((size_t)l * SB + b) * MH + h;
        mlstm_seq(F, l, h, MP + b * ST, ST, F.a->in[I_SC] + sidx * MDK * MDV, F.a->in[I_SN] + sidx * MDK, F.a->in[I_SM] + sidx,
                  F.out + O_CS + sidx * MDK * MDV, F.out + O_NS + sidx * MDK, F.out + O_MS + sidx); }
}
__device__ __forceinline__ void mixer_phase(Frame& F, int l) {
#define MX_CNT(g) ((unsigned*)(F.ws + WS_CTL) + CW_SOFT + 64 * l + 48 + (g))
#pragma unroll 1
    for (int g = 0; g < 4; ++g) {
        int gw, gnw, mw, mnw;
        if (g == 0) { gw = F.bid; gnw = 256; mw = F.bid; mnw = 256; }
        else { if (F.bid < 64) break; const int w = F.bid - 64; if (w < 128) { gw = w; gnw = 128; mw = -1; mnw = 1; } else { gw = -1; gnw = 1; mw = w - 128; mnw = 64; } }
        prep_group(F, l, g, gw, gnw, mw, mnw);
        if (g == 0) fe_sample_items(F, l);
        pg8::soft_arrive(MX_CNT(g));
    }
    wait_count(MX_CNT(0), 256u, F.wave);
    if (F.bid < 64) scan_item(F, l, F.bid);
    else {
        for (int it = F.bid; it < 1088; it += 192) scan_item(F, l, it);
    }
#undef MX_CNT
}

__device__ __forceinline__ void sample_merge(Frame& F, int wk, int nwk) {
    int tq_ = threadIdx.x; asm volatile("" : "+v"(tq_)); const int lane_ = tq_ & 63, wave_ = __builtin_amdgcn_readfirstlane(tq_ >> 6);
    const float* slab = (const float*)(F.ws + WS_GATES); const bf16* proj = (const bf16*)(F.ws + WS_PROJ); bf16* xn = (bf16*)(F.ws + WS_XN);
    for (int sr = wave_ * nwk + wk; sr < MS; sr += NWAVES * nwk) {
        const int pmr = sr >> 8, r = sr & 255; const size_t row = (size_t)MP + sr;
#pragma unroll
        for (int pn = 0; pn < 4; ++pn) { const int t = pmr * 4 + pn;
            const f32x4 p1 = *(const GAS f32x4*)(slab + (size_t)(2 * t) * 65536 + r * 256 + 4 * lane_), p2 = *(const GAS f32x4*)(slab + (size_t)(2 * t + 1) * 65536 + r * 256 + 4 * lane_);
            const v2u gg = *(const GAS v2u*)(proj + row * IN_DIM + C_GG + pn * 256 + 4 * lane_), gm = *(const GAS v2u*)(proj + row * IN_DIM + C_GM + pn * 256 + 4 * lane_);
            v2u o; o.x = pk2(pg8::bf_lo(gg.x) * p1[0] + pg8::bf_lo(gm.x) * p2[0], pg8::bf_hi(gg.x) * p1[1] + pg8::bf_hi(gm.x) * p2[1]);
            o.y = pk2(pg8::bf_lo(gg.y) * p1[2] + pg8::bf_lo(gm.y) * p2[2], pg8::bf_hi(gg.y) * p1[3] + pg8::bf_hi(gm.y) * p2[3]);
            *(GAS v2u*)(xn + row * DM + pn * 256 + 4 * lane_) = o; }
    }
}

constexpr int PH_PER_LAYER = 9, N_PHASES = 1 + DEPTH * PH_PER_LAYER + 1;
__global__ void __launch_bounds__(NWAVES * 64, 2) trunk_fwd(Args args) {
    extern __shared__ __attribute__((aligned(16))) unsigned char lds[];
    Frame F;
    F.lds = (LAS unsigned char*)lds;
    F.tid = threadIdx.x; F.lane = F.tid & 63; F.wave = __builtin_amdgcn_readfirstlane(F.tid >> 6);
    F.G = gridDim.x; F.bid = blockIdx.x;
    { auto ap = (const __attribute__((address_space(4))) Args*)__builtin_amdgcn_kernarg_segment_ptr(); F.a = ap; F.ws = ap->ws; F.out = ap->out; }
    volatile LAS unsigned* MISC = (volatile LAS unsigned*)(F.lds + MISC_OFF);
    for (int u = F.tid; u < (LDS_BYTES - LDSCTL_OFF) / 4; u += NWAVES * 64) ((LAS unsigned*)(F.lds + LDSCTL_OFF))[u] = 0u;
    __syncthreads();
    gu32* ctl = (gu32*)(F.ws + WS_CTL);
    XcdBarrier bar; bar.bar = (unsigned*)(ctl + CW_BAR); bar.x = 0; bar.st = nullptr;
    const int lo = args.ph_lo, hi = args.ph_hi;
    if (hi - lo > 1) bar = xcd_barrier_post((unsigned*)(ctl + CW_BAR), MISC + 8);
#pragma unroll 1
    for (int p = lo; p < hi; ++p) {
        { auto ap = (const __attribute__((address_space(4))) Args*)__builtin_amdgcn_kernarg_segment_ptr(); asm volatile("" : "+s"(ap)); F.a = ap; F.ws = ap->ws; F.out = ap->out;
          int t_ = threadIdx.x; asm volatile("" : "+v"(t_)); F.tid = t_; F.lane = t_ & 63; F.wave = __builtin_amdgcn_readfirstlane(t_ >> 6);
          int g_ = gridDim.x, b_ = blockIdx.x; asm volatile("" : "+s"(g_), "+s"(b_)); F.G = g_; F.bid = b_; }
        bf16* xn = (bf16*)(F.ws + WS_XN); bf16* proj = (bf16*)(F.ws + WS_PROJ);
        float* xo = F.out + O_Y;
        if (p == N_PHASES - 1) final_norm_phase(F, NP_DN, dn_slab(F, DEPTH - 1), MP);
        else {
            int l = 0, k = 0;
            if (p == 0) { p0_prologue(F, 0, 0, F.G); __syncthreads(); p0_prologue(F, 1, 0, F.G); __syncthreads(); }
            else { l = (p - 1) / PH_PER_LAYER; k = (p - 1) % PH_PER_LAYER; if (k == 0 && l == 0) continue; }
            bf16* xb1 = (bf16*)(F.ws + WS_XB1);
            if (k == 0 || k == 6) { if (p == 0) norm_phase(F, 0, F.a->in[I_NMIX], xn, 0); else continue; }
            else if (k == 1) {
                unsigned* cnt = (unsigned*)(ctl + CW_SOFT + 64 * l + 16);
                if (l > 0 && F.bid >= 240) { norm_phase(F, 1, F.a->in[I_NMIX] + (size_t)l * DM, xn, NP_DN, dn_slab(F, l - 1), MP, M, F.bid - 240, 16); pg8::soft_arrive(cnt); }
                typedef pg8::Gemm<DM, DM, DM> GT; typedef pg8::StaticOrder<M, NPAD, DM> SO; GT g{xn, w_ptr(F, l, WO_WIN)}; SO S; S.init(F.G, F.bid); if (l > 0) { S.cnt = cnt; S.need = 16u; }
                pg8::EpiProj E{proj, (float*)(F.ws + WS_GATES), (bf16*)(F.ws + WS_HALO)};
                pg8::gemm_phase<GT, pg8::EpiProj, SO, true, true>(F.lds + RING_OFF, g, S, E, F.tid);
            }
            else if (k == 2) mixer_phase(F, l);
            else if (k == 3) continue;
            else if (k == 4) {
                typedef pg8::Gemm<IN_DIM, DM, DM> GT; typedef pg8::SplitSrcOrder SO; GT g{proj + C_ZG, w_ptr(F, l, WO_WBG)}; SO S; S.init(F.G, F.bid);
                pg8::EpiMerge E{proj + C_GG, proj + C_GM, xn, (float*)(F.ws + WS_GATES)};
                pg8::gemm_phase<GT, pg8::EpiMerge, SO, true, true>(F.lds + RING_OFF, g, S, E, F.tid);
            }
            else if (k == 5) {
                unsigned* cnt = (unsigned*)(ctl + CW_SOFT + 64 * l);
                { sample_merge(F, F.bid, 256); pg8::soft_arrive(cnt); }
                typedef pg8::Gemm<DM, DM, DM> GT; typedef pg8::SplitOrder<DM, NP_WO> SO; GT g{xn, w_ptr(F, l, WO_WOUT)}; SO S; S.init(F.G, F.bid); S.cnt = cnt; S.need = 256u;
                const bool first = (l == 0);
                pg8::EpiResidN<1> E{first ? F.a->in[I_XP] : xo, first ? F.a->in[I_XS] : xo + (size_t)MP * DM, xo, dn_slab(F, l), xb1, F.a->in[I_NMLP] + (size_t)l * DM,
                                    (unsigned*)(F.ws + WS_XSLOT) + (size_t)(2 * l) * 65536, (unsigned*)(ctl + CW_X + (2 * l) * 4096), F.lds + XLDS_OFF};
                pg8::gemm_phase<GT, pg8::EpiResidN<1>, SO, true, true>(F.lds + RING_OFF, g, S, E, F.tid);
            }
            else if (k == 8) {
                typedef pg8::Gemm<FF, FF, FF> GT; typedef pg8::SplitOrder<FF, NP_DN> SO; GT g{proj, w_ptr(F, l, WO_WDN)}; SO S; S.init(F.G, F.bid);
                unsigned* xs = (unsigned*)(F.ws + WS_XSLOT) + (size_t)(2 * l + 1) * 65536; unsigned* xc = (unsigned*)(ctl + CW_X + (2 * l + 1) * 4096);
                if (l + 1 < DEPTH) {
                    pg8::EpiResidN<1> E{xo, xo + (size_t)MP * DM, xo, dn_slab(F, l), xn, F.a->in[I_NMIX] + (size_t)(l + 1) * DM, xs, xc, F.lds + XLDS_OFF};
                    pg8::gemm_phase<GT, pg8::EpiResidN<1>, SO, true, true>(F.lds + RING_OFF, g, S, E, F.tid);
                } else {
                    pg8::EpiResidN<2> E{xo, xo + (size_t)MP * DM, xo, dn_slab(F, l), xn, F.a->in[I_NFIN], xs, xc, F.lds + XLDS_OFF};
                    pg8::gemm_phase<GT, pg8::EpiResidN<2>, SO, true, true>(F.lds + RING_OFF, g, S, E, F.tid);
                }
            }
            else {
                unsigned* cnt = (unsigned*)(ctl + CW_SOFT + 64 * l + 32);
                if (F.bid >= 192) { norm_phase(F, l == 0 ? 2 : 1, F.a->in[I_NMLP] + (size_t)l * DM, xb1, NP_WO, dn_slab(F, l), MP, M, F.bid - 192, 64); pg8::soft_arrive(cnt); }
                typedef pg8::Gemm<DM, DM, DM> GT; typedef pg8::StaticOrder<M, FF, DM> SO; GT g{xb1, w_ptr(F, l, WO_WUP)}; SO S; S.init(F.G, F.bid); S.cnt = cnt; S.need = 64u;
                pg8::EpiRelu2 E{proj, (float*)(F.ws + WS_SLAB)};
                pg8::gemm_phase<GT, pg8::EpiRelu2, SO, true, true>(F.lds + RING_OFF, g, S, E, F.tid);
            }
        }
        if (p + 1 < hi) xcd_barrier(bar);
    }
}

extern "C" void kernel_launch(void* const* d_in, const int* in_sizes, int n_in, void* d_out, int out_size, void* d_ws, size_t ws_size, hipStream_t stream) {
    static int grid = 0;
    if (grid == 0) {
        if (n_in != 23 || in_sizes[0] != MP * DM || (size_t)out_size != O_END || ws_size < WS_END) { fprintf(stderr, "kernel_launch: unexpected shapes (n_in %d, out %d, ws %zu); nothing launched\n", n_in, out_size, ws_size); grid = -1; return; }
        int dev = 0, cus = 0, per_cu = 0;
        if (hipGetDevice(&dev) != hipSuccess || hipDeviceGetAttribute(&cus, hipDeviceAttributeMultiprocessorCount, dev) != hipSuccess) { grid = -1; return; }
        if (hipFuncSetAttribute((const void*)trunk_fwd, hipFuncAttributeMaxDynamicSharedMemorySize, LDS_BYTES) != hipSuccess) { grid = -1; return; }
        if (hipOccupancyMaxActiveBlocksPerMultiprocessor(&per_cu, (const void*)trunk_fwd, NWAVES * 64, LDS_BYTES) != hipSuccess || per_cu < 1) { fprintf(stderr, "kernel_launch: occupancy query says %d\n", per_cu); grid = -1; (void)hipGetLastError(); return; }
        (void)hipGetLastError();
        if (cus < 128) { fprintf(stderr, "kernel_launch: built for a 256-CU device (%d CUs)\n", cus); grid = -1; return; }
        if (cus != 256) { fprintf(stderr, "kernel_launch: the mixer phase's role split is built for 256 CUs (got %d)\n", cus); grid = -1; return; }
        grid = cus & ~3;
    }
    if (grid < 0) return;
    (void)hipMemsetAsync((char*)d_ws + WS_CTL, 0, CTL_ZERO_BYTES, stream);
    Args a{};
    for (int i = 0; i < 23; ++i) a.in[i] = (const float*)d_in[i];
    a.out = (float*)d_out; a.ws = (unsigned char*)d_ws;
#if MK_ONE_LAUNCH
    a.ph_lo = 0; a.ph_hi = N_PHASES;
    hipLaunchKernelGGL(trunk_fwd, dim3(grid), dim3(NWAVES * 64), LDS_BYTES, stream, a);
#else
    for (int p = 0; p < N_PHASES; ++p) { a.ph_lo = p; a.ph_hi = p + 1; hipLaunchKernelGGL(trunk_fwd, dim3(grid), dim3(NWAVES * 64), LDS_BYTES, stream, a); }
#endif
}
```

```cpp
#include <hip/hip_runtime.h>
#include <cstdio>
#include <cstdint>

#ifndef MK_ONE_LAUNCH
#define MK_ONE_LAUNCH 1
#endif

namespace pg8 {
#define PG8_LAS __attribute__((address_space(3)))
typedef unsigned short bf16_t;
typedef short bf16x8 __attribute__((ext_vector_type(8)));
typedef float f32x4 __attribute__((ext_vector_type(4)));
typedef unsigned u32x4 __attribute__((ext_vector_type(4)));
constexpr int BM = 256, BK = 64, HALF = 128, HTB = HALF * BK * 2  , STAGE_BYTES = 8 * HTB, NXCD = 8, WGM = 2;

__host__ __device__ __forceinline__ int lds_byte(int r, int c) { const int st = (r >> 4) * 2 + (c >> 5), rr = r & 15, cc = c & 31, ob = rr * 64 + cc * 2; return st * 1024 + (ob ^ (((ob >> 9) & 1) << 5)); }
__host__ __device__ __forceinline__ void stage_rc(int b, int& R, int& C) { const int st = b / 1024, sb = b % 1024, swz = sb ^ (((sb >> 9) & 1) << 5); R = (st >> 1) * 16 + swz / 64; C = (st & 1) * 32 + (swz % 64) / 2; }
__host__ __device__ __forceinline__ int perm32(int rho) { const int n = rho >> 4, i = rho & 15; return 8 * (i >> 2) + 4 * n + (i & 3); }

struct Unit { int pm, pn, k0, nt, part; };
template <int LDA_, int LDB_, int K_> struct Gemm { static constexpr int lda = LDA_, ldb = LDB_, K = K_; const bf16_t* A; const bf16_t* Bt; };

template <int M_, int N_, int K_> struct StaticOrder {
    static constexpr int nM = M_ / BM, nN = N_ / BM, nwg = nM * nN;
    int G, c; unsigned* cnt; unsigned need;
    __host__ __device__ void init(int G_, int c_) { G = G_; c = c_; cnt = nullptr; need = 0u; }
    __host__ __device__ static void tile_of(int wgid, Unit& u) {
        { const int q = nwg / NXCD, r = nwg % NXCD, xcd = wgid % NXCD, off = wgid / NXCD; wgid = (xcd < r ? xcd * (q + 1) : r * (q + 1) + (xcd - r) * q) + off; }
        const int nig = WGM * nN, gid = wgid / nig, fm = gid * WGM, gsz = (nM - fm) < WGM ? (nM - fm) : WGM;
        u.pm = fm + ((wgid % nig) % gsz); u.pn = (wgid % nig) / gsz;
    }
    __host__ __device__ bool next(int i, Unit& u) const {
        const long L = (long)i * G + c; if (L >= nwg) return false;
        tile_of((int)L, u); u.k0 = 0; u.nt = K_ / BK; u.part = -1; return true;
    }
    __device__ __forceinline__ void a_ready(const Unit& u) const {
        if (cnt == nullptr || u.pm < 64) return;
        if (threadIdx.x < 64) { unsigned sp = 0;
            while ((unsigned)__builtin_amdgcn_readfirstlane(__hip_atomic_load(cnt, __ATOMIC_RELAXED, __HIP_MEMORY_SCOPE_AGENT)) < need) { __builtin_amdgcn_s_sleep(2); if (++sp > (1u << 22)) break; }
            __builtin_amdgcn_fence(__ATOMIC_ACQUIRE, "agent");
            asm volatile("s_waitcnt vmcnt(0)" ::: "memory"); }
        asm volatile("" ::: "memory"); __builtin_amdgcn_s_barrier(); asm volatile("" ::: "memory");
    }
    __device__ __forceinline__ void done(const Unit&) const {}
};
__device__ __forceinline__ void soft_arrive(unsigned* cnt) {
    asm volatile("s_waitcnt vmcnt(0)" ::: "memory");
    __syncthreads();
    if (threadIdx.x == 0) { __builtin_amdgcn_fence(__ATOMIC_RELEASE, "agent"); asm volatile("s_waitcnt vmcnt(0)" ::: "memory");
        (void)__hip_atomic_fetch_add(cnt, 1u, __ATOMIC_RELAXED, __HIP_MEMORY_SCOPE_AGENT); }
}
template <int K_, int NP_, int N_ = 1024> struct SplitOrder {
    typedef StaticOrder<16384, N_, K_> Base;
    static constexpr int NTS = N_ / BM, NSUB = 2 * NTS * NP_;
    int G, c; unsigned* cnt; unsigned need;
    __host__ __device__ void init(int G_, int c_) { G = G_; c = c_; cnt = nullptr; need = 0u; }
    __host__ __device__ bool next(int i, Unit& u) const {
        const long L = (long)i * G + c; if (L >= Base::nwg + NSUB) return false;
        if (L < Base::nwg) { Base::tile_of((int)L, u); u.k0 = 0; u.nt = K_ / BK; u.part = -1; return true; }
        const int s = (int)L - Base::nwg, t = s / NP_, p = s % NP_;
        u.pm = 64 + t / NTS; u.pn = t % NTS; u.k0 = p * (K_ / NP_); u.nt = K_ / NP_ / BK; u.part = s; return true;
    }
    __device__ __forceinline__ void a_ready(const Unit& u) const {
        if (cnt == nullptr || u.part < 0) return;
        if (threadIdx.x < 64) { unsigned sp = 0;
            while ((unsigned)__builtin_amdgcn_readfirstlane(__hip_atomic_load(cnt, __ATOMIC_RELAXED, __HIP_MEMORY_SCOPE_AGENT)) < need) { __builtin_amdgcn_s_sleep(2); if (++sp > (1u << 22)) break; }
            __builtin_amdgcn_fence(__ATOMIC_ACQUIRE, "agent");
            asm volatile("s_waitcnt vmcnt(0)" ::: "memory"); }
        asm volatile("" ::: "memory"); __builtin_amdgcn_s_barrier(); asm volatile("" ::: "memory");
    }
    __device__ __forceinline__ void done(const Unit&) const {}
};
struct SplitSrcOrder {
    typedef StaticOrder<16384, 1024, 1024> Base;
    int G, c;
    __host__ __device__ void init(int G_, int c_) { G = G_; c = c_; }
    __host__ __device__ bool next(int i, Unit& u) const {
        const long L = (long)i * G + c; if (L >= Base::nwg + 16) return false;
        if (L < Base::nwg) { Base::tile_of((int)L, u); u.k0 = 0; u.nt = 16; u.part = -1; return true; }
        const int s = (int)L - Base::nwg, t = s >> 1;
        u.pm = 64 + (t >> 2); u.pn = t & 3; u.k0 = 512 * (s & 1); u.nt = 8; u.part = s; return true;
    }
    __device__ __forceinline__ void a_ready(const Unit&) const {}
    __device__ __forceinline__ void done(const Unit&) const {}
};

typedef __bf16 bf16x2_hw __attribute__((ext_vector_type(2)));
__device__ __forceinline__ unsigned cvt_pk_bf16(float lo, float hi) { const bf16x2_hw v = {(__bf16)lo, (__bf16)hi}; return __builtin_bit_cast(unsigned, v); }
__device__ __forceinline__ void st16_wt(void* p, u32x4 v) { asm volatile("global_store_dwordx4 %0, %1, off sc1\n\ts_nop 1" :: "v"(p), "v"(v) : "memory"); }
__device__ __forceinline__ void st16_wt(void* p, f32x4 v) { st16_wt(p, __builtin_bit_cast(u32x4, v)); }
__device__ __forceinline__ float bf_lo(unsigned w) { return __builtin_bit_cast(float, w << 16); }
__device__ __forceinline__ float bf_hi(unsigned w) { return __builtin_bit_cast(float, w & 0xffff0000u); }
__device__ __forceinline__ float sigmoidf_(float x) { return __builtin_amdgcn_rcpf(1.0f + __expf(-x)); }

constexpr int MP_ROWS = 16384;
constexpr int LDP = 5648;

struct EpiProj {
    static constexpr bool PERM = true, AFTER_DRAIN = false, HAS_INIT = false; static constexpr int MIDT = 0;
    bf16_t* P; float* gates; bf16_t* halo;
    __device__ __forceinline__ void operator()(const f32x4 (&acc)[2][2][4][2], const Unit& u, int wr, int wc, int fr, int fq) const {
        const int row0 = u.pm * BM + wr * 64 + fr;
        if (u.pn < 22) {
            const int col0 = u.pn * BM + wc * 32 + 8 * fq;
#pragma unroll
            for (int ai = 0; ai < 2; ++ai)
#pragma unroll
                for (int m = 0; m < 4; ++m) { const int r = row0 + ai * HALF + m * 16; bf16_t* rowp = P + (size_t)r * LDP + col0;
#pragma unroll
                    for (int bj = 0; bj < 2; ++bj) { f32x4 v0 = acc[ai][bj][m][0], v1 = acc[ai][bj][m][1];
                        if (u.pn >= 14) {
#pragma unroll
                            for (int e = 0; e < 4; ++e) { v0[e] = sigmoidf_(v0[e]); v1[e] = sigmoidf_(v1[e]); } }
                        u32x4 w; w.x = cvt_pk_bf16(v0[0], v0[1]); w.y = cvt_pk_bf16(v0[2], v0[3]); w.z = cvt_pk_bf16(v1[0], v1[1]); w.w = cvt_pk_bf16(v1[2], v1[3]);
                        *(u32x4*)(rowp + bj * HALF) = w;
                        if (m == 3 && u.pn < 6 && fr >= 13 && r < MP_ROWS) *(u32x4*)(halo + ((size_t)(r >> 6) * 3 + (fr - 13)) * 1536 + col0 + bj * HALF) = w; } }
        } else if (wc == 0 && fq < 2) {
#pragma unroll
            for (int ai = 0; ai < 2; ++ai)
#pragma unroll
                for (int m = 0; m < 4; ++m) { const int r = row0 + ai * HALF + m * 16; float* gp = gates + (size_t)r * 16 + 8 * fq;
                    *(f32x4*)gp = acc[ai][0][m][0]; *(f32x4*)(gp + 4) = acc[ai][0][m][1]; }
        }
    }
};
struct EpiRelu2 {
    static constexpr bool PERM = true, AFTER_DRAIN = false, HAS_INIT = false; static constexpr int MIDT = 0;
    bf16_t* H; float* slab;
    __device__ __forceinline__ void operator()(const f32x4 (&acc)[2][2][4][2], const Unit& u, int wr, int wc, int fr, int fq) const {
        if (u.part >= 0) {
            float* sb = slab + (size_t)u.part * 65536 + (size_t)(wr * 64 + fr) * 256 + wc * 32 + 8 * fq;
#pragma unroll
            for (int ai = 0; ai < 2; ++ai)
#pragma unroll
                for (int m = 0; m < 4; ++m)
#pragma unroll
                    for (int bj = 0; bj < 2; ++bj)
#pragma unroll
                        for (int n = 0; n < 2; ++n) *(f32x4*)(sb + (ai * HALF + m * 16) * 256 + bj * HALF + 4 * n) = acc[ai][bj][m][n];
            return;
        }
        const int row0 = u.pm * BM + wr * 64 + fr, col0 = u.pn * BM + wc * 32 + 8 * fq;
#pragma unroll
        for (int ai = 0; ai < 2; ++ai)
#pragma unroll
            for (int m = 0; m < 4; ++m) { bf16_t* rowp = H + (size_t)(row0 + ai * HALF + m * 16) * 4096 + col0;
#pragma unroll
                for (int bj = 0; bj < 2; ++bj) { f32x4 v0 = acc[ai][bj][m][0], v1 = acc[ai][bj][m][1];
#pragma unroll
                    for (int e = 0; e < 4; ++e) { const float a = fmaxf(v0[e], 0.f), b = fmaxf(v1[e], 0.f); v0[e] = a * a; v1[e] = b * b; }
                    u32x4 w; w.x = cvt_pk_bf16(v0[0], v0[1]); w.y = cvt_pk_bf16(v0[2], v0[3]); w.z = cvt_pk_bf16(v1[0], v1[1]); w.w = cvt_pk_bf16(v1[2], v1[3]);
                    *(u32x4*)(rowp + bj * HALF) = w; } }
    }
};
struct EpiResid {
    static constexpr bool PERM = false, AFTER_DRAIN = false, HAS_INIT = false; static constexpr int MIDT = 0;
    const float* in_p; const float* in_s; float* out; float* slab;
    __device__ __forceinline__ void operator()(const f32x4 (&acc)[2][2][4][2], const Unit& u, int wr, int wc, int fr, int fq) const {
        if (u.part >= 0) {
            float* sb = slab + (size_t)u.part * 65536 + (size_t)(wr * 64 + fr) * 256 + wc * 32 + 4 * fq;
#pragma unroll
            for (int ai = 0; ai < 2; ++ai)
#pragma unroll
                for (int m = 0; m < 4; ++m)
#pragma unroll
                    for (int bj = 0; bj < 2; ++bj)
#pragma unroll
                        for (int n = 0; n < 2; ++n) *(f32x4*)(sb + (ai * HALF + m * 16) * 256 + bj * HALF + n * 16) = acc[ai][bj][m][n];
            return;
        }
        const int row0 = u.pm * BM + wr * 64 + fr, col0 = u.pn * BM + wc * 32 + 4 * fq;
        const float* inb = (u.pm < 64) ? in_p + (size_t)row0 * 1024 : in_s + (size_t)(row0 - MP_ROWS) * 1024;
        float* outb = out + (size_t)row0 * 1024;
#pragma unroll
        for (int ai = 0; ai < 2; ++ai)
#pragma unroll
            for (int m = 0; m < 4; ++m) { const size_t off = (size_t)(ai * HALF + m * 16) * 1024 + col0;
#pragma unroll
                for (int bj = 0; bj < 2; ++bj)
#pragma unroll
                    for (int n = 0; n < 2; ++n) { const f32x4 xi = *(const f32x4*)(inb + off + bj * HALF + n * 16); *(f32x4*)(outb + off + bj * HALF + n * 16) = xi + acc[ai][bj][m][n]; } }
    }
};
template <int FUSE> struct EpiResidN {
    static constexpr bool PERM = false, AFTER_DRAIN = false, HAS_INIT = true;  static constexpr int MIDT = 0;
    const float* in_p; const float* in_s; float* out; float* slab; bf16_t* xn; const float* w; unsigned* slots; unsigned* cnt; PG8_LAS unsigned char* lx;
    __device__ __forceinline__ void init(f32x4 (&acc)[2][2][4][2], const Unit& u, int wr, int wc, int fr, int fq) const {
        if (u.part >= 0) { float z0_ = 0.f; asm volatile("" : "+v"(z0_));
#pragma unroll
            for (int ai = 0; ai < 2; ++ai)
#pragma unroll
                for (int bj = 0; bj < 2; ++bj)
#pragma unroll
                    for (int m = 0; m < 4; ++m)
#pragma unroll
                        for (int n = 0; n < 2; ++n) acc[ai][bj][m][n] = (f32x4){z0_, z0_, z0_, z0_};
            return; }
        const int row0 = u.pm * BM + wr * 64 + fr, col0 = u.pn * BM + wc * 32 + 4 * fq;
        const float* inb = ((u.pm < 64) ? in_p + (size_t)row0 * 1024 : in_s + (size_t)(row0 - MP_ROWS) * 1024) + col0;
#pragma unroll
        for (int ai = 0; ai < 2; ++ai)
#pragma unroll
            for (int m = 0; m < 4; ++m)
#pragma unroll
                for (int bj = 0; bj < 2; ++bj)
#pragma unroll
                    for (int n = 0; n < 2; ++n) acc[ai][bj][m][n] = *(const f32x4*)(inb + (size_t)(ai * HALF + m * 16) * 1024 + bj * HALF + n * 16);
    }
    __device__ __forceinline__ void operator()(f32x4 (&acc)[2][2][4][2], const Unit& u, int wr, int wc, int fr, int fq) const {
        if (u.part >= 0) {
            float* sb = slab + (size_t)u.part * 65536 + (size_t)(wr * 64 + fr) * 256 + wc * 32 + 4 * fq;
#pragma unroll
            for (int ai = 0; ai < 2; ++ai)
#pragma unroll
                for (int m = 0; m < 4; ++m)
#pragma unroll
                    for (int bj = 0; bj < 2; ++bj)
#pragma unroll
                        for (int n = 0; n < 2; ++n) *(f32x4*)(sb + (ai * HALF + m * 16) * 256 + bj * HALF + n * 16) = acc[ai][bj][m][n];
            return;
        }
        const int row0 = u.pm * BM + wr * 64 + fr, col0 = u.pn * BM + wc * 32 + 4 * fq;
        float* outb = out + (size_t)row0 * 1024;
        PG8_LAS float* P = (PG8_LAS float*)lx;
        PG8_LAS float* S = (PG8_LAS float*)(lx + 4096);
#pragma unroll
        for (int ai = 0; ai < 2; ++ai)
#pragma unroll
            for (int m = 0; m < 4; ++m) { float q = 0.f;
#pragma unroll
                for (int bj = 0; bj < 2; ++bj)
#pragma unroll
                    for (int n = 0; n < 2; ++n) { const f32x4 xo_ = acc[ai][bj][m][n];
                        if constexpr (FUSE == 1) *(f32x4*)(outb + (size_t)(ai * HALF + m * 16) * 1024 + col0 + bj * HALF + n * 16) = xo_;
                        q += (xo_[0] * xo_[0] + xo_[1] * xo_[1]) + (xo_[2] * xo_[2] + xo_[3] * xo_[3]); }
                q += __shfl_xor(q, 16); q += __shfl_xor(q, 32); if (fq == 0) P[(ai * HALF + wr * 64 + m * 16 + fr) * 4 + wc] = q; }
        asm volatile("s_waitcnt lgkmcnt(0)" ::: "memory"); __builtin_amdgcn_s_barrier(); asm volatile("" ::: "memory");
        const int wid = wr * 4 + wc, lane = fq * 16 + fr, row = wid * 32 + (lane & 31);
        unsigned* sl = slots + ((size_t)(u.pm * BM + row) * 4);
        if (lane < 32) { const f32x4 p = *(const PG8_LAS f32x4*)(P + row * 4);
            __hip_atomic_store(sl + u.pn, __builtin_bit_cast(unsigned, (p[0] + p[1]) + (p[2] + p[3])), __ATOMIC_RELAXED, __HIP_MEMORY_SCOPE_AGENT); }
        asm volatile("s_waitcnt vmcnt(0)" ::: "memory");
        if (lane == 0) (void)__hip_atomic_fetch_add(cnt + 64 * u.pm, 1u, __ATOMIC_RELAXED, __HIP_MEMORY_SCOPE_AGENT);
        if (wid == 0) { unsigned sp = 0;
            while ((unsigned)__builtin_amdgcn_readfirstlane(__hip_atomic_load(cnt + 64 * u.pm, __ATOMIC_RELAXED, __HIP_MEMORY_SCOPE_AGENT)) < 32u) { __builtin_amdgcn_s_sleep(2); if (++sp > (1u << 22)) break; }
            __builtin_amdgcn_fence(__ATOMIC_ACQUIRE, "agent"); }
        asm volatile("s_waitcnt vmcnt(0) lgkmcnt(0)" ::: "memory"); __builtin_amdgcn_s_barrier(); asm volatile("" ::: "memory");
        if (lane < 32) { float t = 0.f;
#pragma unroll
            for (int k = 0; k < 4; ++k) t += __builtin_bit_cast(float, __hip_atomic_load(sl + k, __ATOMIC_RELAXED, __HIP_MEMORY_SCOPE_AGENT));
            S[row] = __builtin_amdgcn_rsqf(t * (1.0f / 1024.0f) + 1e-6f); }
        asm volatile("s_waitcnt lgkmcnt(0)" ::: "memory"); __builtin_amdgcn_s_barrier(); asm volatile("" ::: "memory");
        f32x4 wv[2][2];
#pragma unroll
        for (int bj = 0; bj < 2; ++bj)
#pragma unroll
            for (int n = 0; n < 2; ++n) wv[bj][n] = *(const f32x4*)(w + col0 + bj * HALF + n * 16);
        typedef unsigned u32x2_ __attribute__((ext_vector_type(2)));
        bf16_t* xb = xn + (size_t)row0 * 1024 + col0;
#pragma unroll
        for (int ai = 0; ai < 2; ++ai)
#pragma unroll
            for (int m = 0; m < 4; ++m) { const float rs = S[ai * HALF + wr * 64 + m * 16 + fr];
#pragma unroll
                for (int bj = 0; bj < 2; ++bj)
#pragma unroll
                    for (int n = 0; n < 2; ++n) { const f32x4 v = acc[ai][bj][m][n] * rs * wv[bj][n];
                        if constexpr (FUSE == 1) { u32x2_ o; o.x = cvt_pk_bf16(v[0], v[1]); o.y = cvt_pk_bf16(v[2], v[3]);
                            *(u32x2_*)(xb + (size_t)(ai * HALF + m * 16) * 1024 + bj * HALF + n * 16) = o; }
                        else *(f32x4*)(outb + (size_t)(ai * HALF + m * 16) * 1024 + col0 + bj * HALF + n * 16) = v; } }
    }
};
struct EpiMerge {
    static constexpr bool PERM = true, AFTER_DRAIN = false, HAS_INIT = false; static constexpr int MIDT = 8;
    const bf16_t* GG; const bf16_t* GM; bf16_t* O; float* slab;
    __device__ __forceinline__ void mid(f32x4 (&acc)[2][2][4][2], const Unit& u, int wr, int wc, int fr, int fq) const {
        int z_ = 0; asm volatile("" : "+v"(z_));
        const int row0 = u.pm * BM + wr * 64 + fr + z_, col0 = u.pn * BM + wc * 32 + 8 * fq;
#pragma unroll
        for (int ai = 0; ai < 2; ++ai)
#pragma unroll
            for (int m = 0; m < 4; ++m) { const size_t ro = (size_t)(row0 + ai * HALF + m * 16) * LDP + col0;
#pragma unroll
                for (int bj = 0; bj < 2; ++bj) { const u32x4 a = *(const u32x4*)(GG + ro + bj * HALF), b = *(const u32x4*)(GM + ro + bj * HALF);
                    float ga[8] = {bf_lo(a.x), bf_hi(a.x), bf_lo(a.y), bf_hi(a.y), bf_lo(a.z), bf_hi(a.z), bf_lo(a.w), bf_hi(a.w)};
                    float gb[8] = {bf_lo(b.x), bf_hi(b.x), bf_lo(b.y), bf_hi(b.y), bf_lo(b.z), bf_hi(b.z), bf_lo(b.w), bf_hi(b.w)};
#pragma unroll
                    for (int e = 0; e < 8; ++e) { const float r = ga[e] * __builtin_amdgcn_rcpf(fmaxf(gb[e], 1e-30f));
                        if (e < 4) acc[ai][bj][m][0][e] *= r; else acc[ai][bj][m][1][e - 4] *= r; } }
                if (m == 3) asm volatile("" ::: "memory"); }
    }
    __device__ __forceinline__ void operator()(const f32x4 (&acc)[2][2][4][2], const Unit& u, int wr, int wc, int fr, int fq) const {
        if (u.part >= 0) {
            float* sb = slab + (size_t)u.part * 65536 + (size_t)(wr * 64 + fr) * 256 + wc * 32 + 8 * fq;
#pragma unroll
            for (int ai = 0; ai < 2; ++ai)
#pragma unroll
                for (int m = 0; m < 4; ++m)
#pragma unroll
                    for (int bj = 0; bj < 2; ++bj)
#pragma unroll
                        for (int n = 0; n < 2; ++n) *(f32x4*)(sb + (ai * HALF + m * 16) * 256 + bj * HALF + 4 * n) = acc[ai][bj][m][n];
            return;
        }
        const int row0 = u.pm * BM + wr * 64 + fr, col0 = u.pn * BM + wc * 32 + 8 * fq;
#pragma unroll
        for (int ai = 0; ai < 2; ++ai)
#pragma unroll
            for (int m = 0; m < 4; ++m) { const int r = row0 + ai * HALF + m * 16;
#pragma unroll
                for (int bj = 0; bj < 2; ++bj) { const u32x4 b = *(const u32x4*)(GM + (size_t)r * LDP + col0 + bj * HALF); const f32x4 v0 = acc[ai][bj][m][0], v1 = acc[ai][bj][m][1];
                    const float gb[8] = {bf_lo(b.x), bf_hi(b.x), bf_lo(b.y), bf_hi(b.y), bf_lo(b.z), bf_hi(b.z), bf_lo(b.w), bf_hi(b.w)};
                    float o[8];
#pragma unroll
                    for (int e = 0; e < 8; ++e) o[e] = (e < 4 ? v0[e] : v1[e - 4]) * fmaxf(gb[e], 1e-30f);
                    u32x4 w; w.x = cvt_pk_bf16(o[0], o[1]); w.y = cvt_pk_bf16(o[2], o[3]); w.z = cvt_pk_bf16(o[4], o[5]); w.w = cvt_pk_bf16(o[6], o[7]);
                    *(u32x4*)(O + (size_t)r * 1024 + col0 + bj * HALF) = w; } }
    }
};

template <class GemmT, class Epi, class Sched, bool ALIGN_EPI = false, bool SP2 = false>
__device__ __forceinline__ void gemm_phase(PG8_LAS unsigned char* lds, const GemmT g, const Sched& S, const Epi& E, const int tid) {
    const int wid = __builtin_amdgcn_readfirstlane(tid >> 6), lane = tid & 63, wr = wid >> 2, wc = wid & 3, fr = lane & 15, fq = lane >> 4;
    constexpr int K = GemmT::K;
    unsigned voffA[2], voffB[2];
#pragma unroll
    for (int i = 0; i < 2; ++i) { int R, C; stage_rc(tid * 16 + i * 8192, R, C); const int Rb = Epi::PERM ? ((R & ~31) + perm32(R & 31)) : R;
        voffA[i] = (unsigned)(R * GemmT::lda + C) * 2u; voffB[i] = (unsigned)(Rb * GemmT::ldb + C) * 2u; }
    constexpr size_t kstep = (size_t)(BK * 2);
    constexpr size_t hstepA = (size_t)HALF * GemmT::lda * 2, hstepB = (size_t)HALF * GemmT::ldb * 2;
    constexpr size_t tstepA = 2 * hstepA, tstepB = 2 * hstepB;
    const unsigned ldsw = (unsigned)wid * 1024u;
    const int aoff = lds_byte(wr * 64 + fr, fq * 8), boff = lds_byte(wc * 32 + fr, fq * 8);
#define PG8_SA(b, h) (((b) * 2 + (h)) * HTB)
#define PG8_SB(b, h) ((4 + (b) * 2 + (h)) * HTB)
#define PG8_STAGE(bufoff, gbase, voff) do { _Pragma("unroll") for (int _i = 0; _i < 2; ++_i) \
        __builtin_amdgcn_global_load_lds((const unsigned*)((const char*)(gbase) + (voff)[_i]), (PG8_LAS unsigned*)(lds + (bufoff) + ldsw + _i * 8192), 16, 0, 0); } while (0)
#define PG8_LDA(dst, b, h) do { _Pragma("unroll") for (int m = 0; m < 4; ++m) _Pragma("unroll") for (int k = 0; k < 2; ++k) dst[m][k] = *(const PG8_LAS bf16x8*)(lds + PG8_SA(b, h) + aoff + m * 2048 + k * 1024); } while (0)
#define PG8_LDB(dst, b, h) do { _Pragma("unroll") for (int n = 0; n < 2; ++n) _Pragma("unroll") for (int k = 0; k < 2; ++k) dst[n][k] = *(const PG8_LAS bf16x8*)(lds + PG8_SB(b, h) + boff + n * 2048 + k * 1024); } while (0)
#define PG8_MMA(ai, bj, At, Bt) do { __builtin_amdgcn_s_setprio(1); _Pragma("unroll") for (int m = 0; m < 4; ++m) _Pragma("unroll") for (int n = 0; n < 2; ++n) _Pragma("unroll") for (int k = 0; k < 2; ++k) \
        acc[ai][bj][m][n] = __builtin_amdgcn_mfma_f32_16x16x32_bf16(Bt[n][k], At[m][k], acc[ai][bj][m][n], 0, 0, 0); __builtin_amdgcn_s_setprio(0); } while (0)
#define PG8_WAIT_V(n) asm volatile("s_waitcnt vmcnt(" #n ")" ::: "memory")
#define PG8_WAIT_L(n) asm volatile("s_waitcnt lgkmcnt(" #n ")" ::: "memory")
#define PG8_BAR __builtin_amdgcn_s_barrier()
#define PG8_SCHED __builtin_amdgcn_sched_barrier(0)
    Unit cur, nxt; int ui = 0;
    if (!S.next(0, cur)) return;
    f32x4 acc[2][2][4][2];
    if constexpr (Epi::HAS_INIT) E.init(acc, cur, wr, wc, fr, fq);
    else {
#pragma unroll
    for (int a = 0; a < 2; ++a)
#pragma unroll
        for (int b = 0; b < 2; ++b)
#pragma unroll
            for (int m = 0; m < 4; ++m)
#pragma unroll
                for (int n = 0; n < 2; ++n) acc[a][b][m][n] = (f32x4){0.f, 0.f, 0.f, 0.f};
    }
    bf16x8 At[4][2], B0[2][2], B1[2][2];
    const char* cA = (const char*)g.A + (size_t)cur.pm * tstepA + (size_t)cur.k0 * 2; const char* cB = (const char*)g.Bt + (size_t)cur.pn * tstepB + (size_t)cur.k0 * 2;
    S.a_ready(cur);
    if constexpr (SP2) {
        PG8_STAGE(PG8_SB(0, 0), cB, voffB); PG8_STAGE(PG8_SB(0, 1), cB + hstepB, voffB); PG8_STAGE(PG8_SA(0, 0), cA, voffA); PG8_STAGE(PG8_SA(0, 1), cA + hstepA, voffA);
        if (wr == 1) PG8_BAR;
        PG8_WAIT_V(2); PG8_BAR;
        PG8_STAGE(PG8_SB(1, 0), cB + kstep, voffB); PG8_STAGE(PG8_SA(1, 0), cA + kstep, voffA); PG8_STAGE(PG8_SB(1, 1), cB + hstepB + kstep, voffB);
        PG8_WAIT_V(6); PG8_BAR;
    } else {
        PG8_STAGE(PG8_SB(0, 0), cB, voffB); PG8_STAGE(PG8_SA(0, 0), cA, voffA); PG8_STAGE(PG8_SB(0, 1), cB + hstepB, voffB); PG8_STAGE(PG8_SA(0, 1), cA + hstepA, voffA);
        if (wr == 1) PG8_BAR;
        PG8_WAIT_V(4); PG8_BAR;
        PG8_STAGE(PG8_SB(1, 0), cB + kstep, voffB); PG8_STAGE(PG8_SA(1, 0), cA + kstep, voffA); PG8_STAGE(PG8_SB(1, 1), cB + hstepB + kstep, voffB);
        PG8_WAIT_V(6); PG8_BAR;
    }
    for (;;) {
        const bool has_next = S.next(ui + 1, nxt);
        const char* nA = has_next ? (const char*)g.A + (size_t)nxt.pm * tstepA + (size_t)nxt.k0 * 2 : cA; const char* nB = has_next ? (const char*)g.Bt + (size_t)nxt.pn * tstepB + (size_t)nxt.k0 * 2 : cB;
        const int nt = cur.nt;
#pragma unroll 1
        for (int t = 0; t < nt; t += 2) {
            if constexpr (Epi::MIDT > 0) { if (t == Epi::MIDT) E.mid(acc, cur, wr, wc, fr, fq); }
            const bool last = (t == nt - 2);
            const char* a1 = cA + (size_t)(t + 1) * kstep;
            const char* a2 = last ? nA : cA + (size_t)(t + 2) * kstep; const char* b2 = last ? nB : cB + (size_t)(t + 2) * kstep;
            const char* a3 = a2 + kstep; const char* b3 = b2 + kstep;
            if (last && has_next) S.a_ready(nxt);
            if constexpr (SP2) {
            PG8_LDB(B0, 0, 0); PG8_LDB(B1, 0, 1); PG8_SCHED; PG8_LDA(At, 0, 0); PG8_STAGE(PG8_SA(1, 1), a1 + hstepA, voffA);
            PG8_WAIT_V(8); PG8_WAIT_L(0); PG8_BAR; PG8_MMA(0, 0, At, B0); PG8_MMA(0, 1, At, B1); PG8_BAR; PG8_SCHED;
            PG8_LDA(At, 0, 1); PG8_STAGE(PG8_SB(0, 0), b2, voffB); PG8_STAGE(PG8_SB(0, 1), b2 + hstepB, voffB); PG8_STAGE(PG8_SA(0, 0), a2, voffA);
            PG8_WAIT_V(8); PG8_WAIT_L(0); PG8_BAR; PG8_MMA(1, 0, At, B0); PG8_MMA(1, 1, At, B1); PG8_BAR; PG8_SCHED;
            PG8_LDB(B0, 1, 0); PG8_LDB(B1, 1, 1); PG8_SCHED; PG8_LDA(At, 1, 0); PG8_STAGE(PG8_SA(0, 1), a2 + hstepA, voffA);
            PG8_WAIT_V(8); PG8_WAIT_L(0); PG8_BAR; PG8_MMA(0, 0, At, B0); PG8_MMA(0, 1, At, B1); PG8_BAR; PG8_SCHED;
            PG8_LDA(At, 1, 1); PG8_STAGE(PG8_SB(1, 0), b3, voffB); PG8_STAGE(PG8_SB(1, 1), b3 + hstepB, voffB); PG8_STAGE(PG8_SA(1, 0), a3, voffA);
            PG8_WAIT_V(8); PG8_WAIT_L(0); PG8_BAR; PG8_MMA(1, 0, At, B0); PG8_MMA(1, 1, At, B1); PG8_BAR; PG8_SCHED;
            } else {
            PG8_LDB(B0, 0, 0); PG8_SCHED; PG8_LDA(At, 0, 0); PG8_STAGE(PG8_SA(1, 1), a1 + hstepA, voffA);
            PG8_WAIT_L(8); PG8_BAR; PG8_WAIT_L(0); PG8_MMA(0, 0, At, B0); PG8_BAR; PG8_SCHED;
            PG8_LDB(B1, 0, 1); PG8_STAGE(PG8_SB(0, 0), b2, voffB);
            PG8_BAR; PG8_WAIT_L(0); PG8_MMA(0, 1, At, B1); PG8_BAR;
            PG8_LDA(At, 0, 1); PG8_STAGE(PG8_SA(0, 0), a2, voffA);
            PG8_BAR; PG8_WAIT_L(0); PG8_MMA(1, 0, At, B0); PG8_BAR; PG8_SCHED;
            PG8_STAGE(PG8_SB(0, 1), b2 + hstepB, voffB);
            PG8_WAIT_V(6); PG8_BAR; PG8_MMA(1, 1, At, B1); PG8_BAR;
            PG8_LDB(B0, 1, 0); PG8_SCHED; PG8_LDA(At, 1, 0); PG8_STAGE(PG8_SA(0, 1), a2 + hstepA, voffA);
            PG8_WAIT_L(8); PG8_BAR; PG8_WAIT_L(0); PG8_MMA(0, 0, At, B0); PG8_BAR; PG8_SCHED;
            PG8_LDB(B1, 1, 1); PG8_STAGE(PG8_SB(1, 0), b3, voffB);
            PG8_BAR; PG8_WAIT_L(0); PG8_MMA(0, 1, At, B1); PG8_BAR;
            PG8_LDA(At, 1, 1); PG8_STAGE(PG8_SA(1, 0), a3, voffA);
            PG8_BAR; PG8_WAIT_L(0); PG8_MMA(1, 0, At, B0); PG8_BAR; PG8_SCHED;
            PG8_STAGE(PG8_SB(1, 1), b3 + hstepB, voffB);
            PG8_WAIT_V(6); PG8_BAR; PG8_MMA(1, 1, At, B1); PG8_BAR;
            }
        }
        if constexpr (ALIGN_EPI) { if (wr == 0) PG8_BAR; }
        if constexpr (!Epi::AFTER_DRAIN) { E(acc, cur, wr, wc, fr, fq); S.done(cur); }
        if (!has_next) break;
        if constexpr (Epi::HAS_INIT) E.init(acc, nxt, wr, wc, fr, fq);
        else {
#pragma unroll
        for (int a = 0; a < 2; ++a)
#pragma unroll
            for (int b = 0; b < 2; ++b)
#pragma unroll
                for (int m = 0; m < 4; ++m)
#pragma unroll
                    for (int n = 0; n < 2; ++n) acc[a][b][m][n] = (f32x4){0.f, 0.f, 0.f, 0.f};
        }
        cur = nxt; cA = nA; cB = nB; ++ui;
        if constexpr (ALIGN_EPI) { if (wr == 1) PG8_BAR; }
    }
    PG8_WAIT_V(0);
    if constexpr (!ALIGN_EPI) { if (wr == 0) PG8_BAR; }
    PG8_BAR;
    if constexpr (Epi::AFTER_DRAIN) { E.fused(acc, cur, wr, wc, fr, fq, lds, wid, lane); S.done(cur); }
#undef PG8_SA
#undef PG8_SB
#undef PG8_STAGE
#undef PG8_LDA
#undef PG8_LDB
#undef PG8_MMA
#undef PG8_WAIT_V
#undef PG8_WAIT_L
#undef PG8_BAR
#undef PG8_SCHED
}
}

constexpr int NWAVES = 8;
constexpr int DM = 1024, DEPTH = 2, FF = 4096;
constexpr int PB = 8, PT = 2048, SB = 128, ST = 4;
constexpr int MP = PB * PT, MS = SB * ST, M = MP + MS;
constexpr int IN_DIM = 5648, NPAD = 5888;
constexpr int GH = 4, GDK = 128, GDV = 128, MH = 4, MDK = 64, MDV = 128, CONVC = 1536;
constexpr int C_QG = 0, C_KG = 512, C_VG = 1024, C_QM = 1536, C_KM = 1792, C_VM = 2048, C_ZG = 2560, C_OM = 3072, C_GG = 3584, C_GM = 4608, C_SMALL = 5632;
constexpr float EPS = 1e-6f;
constexpr int NP_WO = 4, NP_DN = 8, NP_UP = 4;
static_assert(pg8::LDP == IN_DIM && pg8::MP_ROWS == MP, "shape constants");

constexpr size_t WS_CTL = 0, CTL_ZERO_BYTES = 1u << 20;
constexpr size_t SZ_WIN = (size_t)NPAD * DM * 2, SZ_WB = (size_t)DM * 512 * 2, SZ_WOUT = (size_t)DM * DM * 2, SZ_WUP = (size_t)FF * DM * 2, SZ_WDN = (size_t)DM * FF * 2;
constexpr size_t SZ_WLAYER = SZ_WIN + 2 * SZ_WB + SZ_WOUT + SZ_WUP + SZ_WDN;
constexpr size_t WS_W = CTL_ZERO_BYTES;
constexpr size_t WO_WIN = 0, WO_WBG = SZ_WIN, WO_WBM = WO_WBG + SZ_WB, WO_WOUT = WO_WBM + SZ_WB, WO_WUP = WO_WOUT + SZ_WOUT, WO_WDN = WO_WUP + SZ_WUP;
constexpr size_t WS_XN = WS_W + DEPTH * SZ_WLAYER;
constexpr size_t WS_PROJ = WS_XN + (size_t)M * DM * 2;
constexpr size_t WS_SLAB = WS_PROJ + (size_t)140 * 1024 * 1024;
static_assert((size_t)M * FF * 2 <= (size_t)140 * 1024 * 1024 && WS_SLAB + (size_t)128 * 65536 * 4 <= WS_PROJ + (size_t)M * IN_DIM * 2, "slab region");
constexpr size_t WS_GATES = WS_PROJ + (size_t)M * IN_DIM * 2;
constexpr size_t WS_HALO = WS_GATES + (size_t)M * 16 * 4;
constexpr size_t WS_GSCAL = WS_HALO + (size_t)256 * 3 * CONVC * 2;
constexpr size_t WS_MSCAL = WS_GSCAL + 4096;
constexpr size_t WS_XSLOT = WS_MSCAL + (size_t)1024 * 256 * 4;
constexpr size_t WS_END = WS_XSLOT + (size_t)4 * 16384 * 4 * 4;
constexpr size_t WS_XB1 = WS_PROJ + (size_t)140 * 1024 * 1024;
static_assert((size_t)16896 * 4096 * 2 <= (size_t)140 * 1024 * 1024 && WS_XB1 + (size_t)16896 * 1024 * 2 <= WS_PROJ + (size_t)16384 * 5648 * 2, "XB1 placement: after hidden, before the sample rows of proj (whose gate columns the w_out phase still reads)");
constexpr int XLDS_OFF = 131072;
static_assert(WS_XN % 256 == 0 && WS_PROJ % 256 == 0 && WS_GATES % 256 == 0 && WS_HALO % 256 == 0, "alignment");
static_assert(WS_END <= 305083472ull, "workspace budget (sum of inputs)");
constexpr size_t O_Y = 0, O_CONVP = (size_t)M * DM, O_SP = O_CONVP + (size_t)DEPTH * PB * 3 * CONVC, O_CP = O_SP + (size_t)DEPTH * PB * GH * GDK * GDV,
                 O_NP = O_CP + (size_t)DEPTH * PB * MH * MDK * MDV, O_MP = O_NP + (size_t)DEPTH * PB * MH * MDK, O_CONVS = O_MP + (size_t)DEPTH * PB * MH,
                 O_SS = O_CONVS + (size_t)DEPTH * SB * 3 * CONVC, O_CS = O_SS + (size_t)DEPTH * SB * GH * GDK * GDV, O_NS = O_CS + (size_t)DEPTH * SB * MH * MDK * MDV,
                 O_MS = O_NS + (size_t)DEPTH * SB * MH * MDK, O_END = O_MS + (size_t)DEPTH * SB * MH;
static_assert(O_END == 45364288ull, "output size");
constexpr int CW_BAR = 4096, CW_SOFT = 8192, CW_X = 16384;

constexpr int RING_OFF = 0, RING_BYTES = 143360;
constexpr int LDSCTL_OFF = RING_BYTES, MISC_OFF = LDSCTL_OFF + 320;
constexpr int LDS_BYTES = 147456;

#define GAS __attribute__((address_space(1)))
#define LAS __attribute__((address_space(3)))
typedef unsigned short bf16;
typedef unsigned v4u __attribute__((ext_vector_type(4)));
typedef unsigned v2u __attribute__((ext_vector_type(2)));
typedef float f32x4 __attribute__((ext_vector_type(4)));
typedef GAS unsigned gu32;
#define RLX_AGENT __ATOMIC_RELAXED, __HIP_MEMORY_SCOPE_AGENT
#define LDS_WAIT() asm volatile("s_waitcnt lgkmcnt(0)" ::: "memory")
__device__ __forceinline__ unsigned f2bf(float f) { return (unsigned)__builtin_bit_cast(unsigned short, (__bf16)f); }
__device__ __forceinline__ unsigned pk2(float lo, float hi) { return pg8::cvt_pk_bf16(lo, hi); }
__device__ __forceinline__ float bf2f(bf16 h) { return __builtin_bit_cast(float, (unsigned)h << 16); }
__device__ __forceinline__ float wave_sum(float v) {
#pragma unroll
    for (int o = 1; o < 64; o <<= 1) v += __shfl_xor(v, o);
    return v;
}
template <int CTRL> __device__ __forceinline__ float dpp_mov(float x) { return __builtin_bit_cast(float, __builtin_amdgcn_update_dpp(0, __builtin_bit_cast(int, x), CTRL, 0xf, 0xf, true)); }
__device__ __forceinline__ float row16_sum(float x) {
    x += dpp_mov<0x128>(x); x += dpp_mov<0x124>(x); x += dpp_mov<0x122>(x); x += dpp_mov<0x121>(x); return x;
}
template <int CTRL, int RMASK> __device__ __forceinline__ float dpp_src(float ident, float x) { return __builtin_bit_cast(float, __builtin_amdgcn_update_dpp(__builtin_bit_cast(int, ident), __builtin_bit_cast(int, x), CTRL, RMASK, 0xf, false)); }
__device__ __forceinline__ float wave_scan_add(float x) {
    x += dpp_src<0x111, 0xf>(0.f, x); x += dpp_src<0x112, 0xf>(0.f, x); x += dpp_src<0x114, 0xf>(0.f, x); x += dpp_src<0x118, 0xf>(0.f, x);
    x += dpp_src<0x142, 0xa>(0.f, x); x += dpp_src<0x143, 0xc>(0.f, x); return x;
}
__device__ __forceinline__ float wave_scan_max(float x) {
    const float ni = -__builtin_inff();
    x = fmaxf(x, dpp_src<0x111, 0xf>(ni, x)); x = fmaxf(x, dpp_src<0x112, 0xf>(ni, x)); x = fmaxf(x, dpp_src<0x114, 0xf>(ni, x)); x = fmaxf(x, dpp_src<0x118, 0xf>(ni, x));
    x = fmaxf(x, dpp_src<0x142, 0xa>(ni, x)); x = fmaxf(x, dpp_src<0x143, 0xc>(ni, x)); return x;
}
__device__ __forceinline__ float wave_sum_fast(float x) {
    x = row16_sum(x);
    const int xi = __builtin_bit_cast(int, x);
    return (__builtin_bit_cast(float, __builtin_amdgcn_readlane(xi, 0)) + __builtin_bit_cast(float, __builtin_amdgcn_readlane(xi, 16))) +
           (__builtin_bit_cast(float, __builtin_amdgcn_readlane(xi, 32)) + __builtin_bit_cast(float, __builtin_amdgcn_readlane(xi, 48)));
}
__device__ __forceinline__ float frcp(float x) { return __builtin_amdgcn_rcpf(x); }
__device__ __forceinline__ float frsq(float x) { return __builtin_amdgcn_rsqf(x); }
__device__ __forceinline__ float sigm(float x) { return frcp(1.0f + __expf(-x)); }
__device__ __forceinline__ float siluf(float x) { return x * frcp(1.0f + __expf(-x)); }
__device__ __forceinline__ float softplusf(float x) { return x > 20.f ? x : log1pf(__expf(x)); }

#define XB_TMO      128
#define XB_XCNT(j)  (256  + 64 * (j))
#define XB_XSUB(j)  (1280 + 64 * (j))
#define XB_XGEN(j)  (2304 + 64 * (j))
#define XB_TOP      3328
#define XB_TOPGEN   3392
#define XCD_BAR_WORDS 3456
#define XB_SPIN_CAP (1u << 18)
__device__ __forceinline__ unsigned xb_ld(unsigned* p)              { return __hip_atomic_load(p, __ATOMIC_RELAXED, __HIP_MEMORY_SCOPE_AGENT); }
__device__ __forceinline__ unsigned xb_add(unsigned* p, unsigned v) { return __hip_atomic_fetch_add(p, v, __ATOMIC_RELAXED, __HIP_MEMORY_SCOPE_AGENT); }
__device__ __forceinline__ unsigned xb_xcc_id() { return (unsigned)__builtin_amdgcn_s_getreg((3 << 11) | 20) & 0xFu; }
#define XB_SPIN(cond, bar) do { unsigned _sp = 0; while (cond) { __builtin_amdgcn_s_sleep(1); \
    if ((++_sp & 255u) == 0u) { if (xb_ld(&(bar)[XB_TMO])) break; if (_sp > XB_SPIN_CAP) { atomicAdd(&(bar)[XB_TMO], 1u); break; } } } } while (0)
struct XcdBarrier { unsigned* bar; unsigned x; volatile LAS unsigned* st; };
__device__ __forceinline__ XcdBarrier xcd_barrier_post(unsigned* bar, volatile LAS unsigned* st) {
    XcdBarrier b; b.bar = bar; b.x = xb_xcc_id(); b.st = st;
    if (threadIdx.x == 0) (void)xb_add(&bar[XB_XCNT(b.x)], 1u);
    return b;
}
__device__ __forceinline__ void xcd_barrier_complete(unsigned* bar, unsigned x, unsigned& nloc, unsigned& nx) {
    const unsigned G = gridDim.x * gridDim.y * gridDim.z;
    unsigned sum, cnt, mine, sp = 0u;
    for (;;) {
        sum = 0u; cnt = 0u; mine = 0u;
#pragma unroll
        for (unsigned j = 0; j < 16; ++j) { const unsigned c = xb_ld(&bar[XB_XCNT(j)]); sum += c; cnt += (c > 0u) ? 1u : 0u; mine = (j == x) ? c : mine; }
        if (sum == G) break;
        __builtin_amdgcn_s_sleep(1);
        if ((++sp & 255u) == 0u) { if (xb_ld(&bar[XB_TMO])) break; if (sp > XB_SPIN_CAP) { atomicAdd(&bar[XB_TMO], 1u); break; } }
    }
    nloc = mine > 0u ? mine : 1u; nx = cnt > 0u ? cnt : 1u;
}
template <bool CENSUS = true> __device__ __forceinline__ void xcd_barrier(const XcdBarrier& b) {
    asm volatile("s_waitcnt vmcnt(0)" ::: "memory");
    __syncthreads();
    if (threadIdx.x == 0) {
        unsigned* bar = b.bar; asm volatile("" : "+s"(bar));
        __builtin_amdgcn_s_waitcnt(0);
        unsigned nloc = b.st[0], nx = b.st[1]; unsigned bx = b.x; asm volatile("" : "+s"(bx));
        if (CENSUS) { if (nloc == 0u) { xcd_barrier_complete(bar, bx, nloc, nx); b.st[0] = nloc; b.st[1] = nx; } }
        const unsigned old = xb_add(&bar[XB_XSUB(bx)], 1u);
        const unsigned gen = old / nloc;
        if (old + 1u == (gen + 1u) * nloc) {
            __builtin_amdgcn_fence(__ATOMIC_RELEASE, "agent");
            asm volatile("s_waitcnt vmcnt(0)" ::: "memory");
            const unsigned og = xb_add(&bar[XB_TOP], 1u);
            const unsigned tg = og / nx;
            if (og + 1u == (tg + 1u) * nx) xb_add(&bar[XB_TOPGEN], 1u);
            else XB_SPIN(xb_ld(&bar[XB_TOPGEN]) == tg, bar);
            __builtin_amdgcn_fence(__ATOMIC_ACQUIRE, "agent");
            xb_add(&bar[XB_XGEN(bx)], 1u);
            asm volatile("s_waitcnt vmcnt(0)" ::: "memory");
        } else {
            XB_SPIN(xb_ld(&bar[XB_XGEN(bx)]) == gen, bar);
            __builtin_amdgcn_fence(__ATOMIC_ACQUIRE, "agent");
            asm volatile("s_waitcnt vmcnt(0)" ::: "memory");
        }
    }
    __syncthreads();
}

struct Args { const float* in[23]; float* out; unsigned char* ws; int ph_lo, ph_hi; };
static_assert(sizeof(Args) == 23 * 8 + 8 + 8 + 8, "Args has no padding");
enum { I_XP = 0, I_XS, I_SCONV, I_SS, I_SC, I_SN, I_SM, I_NMIX, I_WIN, I_CONVW, I_ALOG, I_DTB, I_GNORM, I_IB, I_FB, I_MNORM, I_WBG, I_WBM, I_WOUT, I_NMLP, I_WUP, I_WDN, I_NFIN };

struct Frame {
    LAS unsigned char* lds;
    int tid, lane, wave, G, bid;
    const __attribute__((address_space(4))) Args* a;
    unsigned char* ws; float* out;
};
__device__ __forceinline__ bf16* w_ptr(const Frame& F, int l, size_t off) { return (bf16*)(F.ws + WS_W + (size_t)l * SZ_WLAYER + off); }
__device__ __forceinline__ float* dn_slab(const Frame& F, int l) { return (float*)(F.ws + WS_W + (size_t)l * SZ_WLAYER); }
static_assert((size_t)2 * 4 * NP_DN * 65536 * 4 <= WO_WDN, "down slabs fit before w_down");
static_assert((size_t)2 * 4 * NP_WO * 65536 * 4 <= WO_WOUT, "w_out slabs (same place, earlier in the layer) fit before w_out");

__device__ __forceinline__ void p0_transpose_item(const float* W, int ldw, int K, bf16* WT, int nblk, LAS float* scr, int item, int lane) {
    const int kb = item / nblk, nb = item % nblk, k0 = 64 * kb, n0 = 32 * nb;
#pragma unroll 8
    for (int i = 0; i < 32; ++i) { const int kk = 2 * i + (lane >> 5); scr[kk * 33 + (lane & 31)] = W[(size_t)(k0 + kk) * ldw + n0 + (lane & 31)]; }
    LDS_WAIT(); asm volatile("" ::: "memory");
    const int c = lane & 7;
#pragma unroll
    for (int j = 0; j < 4; ++j) { const int n = (lane >> 3) + 8 * j; const LAS float* s = scr + (8 * c) * 33 + n;
        v4u o; o.x = pk2(s[0 * 33], s[1 * 33]); o.y = pk2(s[2 * 33], s[3 * 33]); o.z = pk2(s[4 * 33], s[5 * 33]); o.w = pk2(s[6 * 33], s[7 * 33]);
        *(GAS v4u*)(WT + (size_t)(n0 + n) * K + k0 + 8 * c) = o; }
    LDS_WAIT(); asm volatile("" ::: "memory");
}
__device__ __forceinline__ void p0_prologue(Frame& F, int l, int b0, int nb) {
    int tq_ = threadIdx.x; asm volatile("" : "+v"(tq_)); const int lane_ = tq_ & 63, wave_ = __builtin_amdgcn_readfirstlane(tq_ >> 6);
    LAS float* scr = (LAS float*)(F.lds + RING_OFF + wave_ * 16384);
    const int gw = (F.bid - b0) * NWAVES + wave_, NGW = nb * NWAVES;
    constexpr int I_A = 16 * 48, I_Z = 16 * 16, I_B = 16 * 32, I_OM = 16 * 16, I_C = 16 * 64, I_BG = 8 * 32, I_BM = 8 * 32, I_O = 16 * 32, I_U = 16 * 128, I_D = 64 * 32;
    constexpr int PER_LAYER = I_A + I_Z + I_B + I_OM + I_C + I_BG + I_BM + I_O + I_U + I_D;
    for (int it = gw; it < PER_LAYER; it += NGW) {
        int r = it;
        const float* win = F.a->in[I_WIN] + (size_t)l * DM * IN_DIM;
        bf16* wint = w_ptr(F, l, WO_WIN);
        if (r < I_A) { p0_transpose_item(win + 0, IN_DIM, DM, wint + (size_t)C_QG * DM, 48, scr, r, lane_); continue; } r -= I_A;
        if (r < I_Z) { p0_transpose_item(win + 1536, IN_DIM, DM, wint + (size_t)C_ZG * DM, 16, scr, r, lane_); continue; } r -= I_Z;
        if (r < I_B) { p0_transpose_item(win + 2056, IN_DIM, DM, wint + (size_t)C_QM * DM, 32, scr, r, lane_); continue; } r -= I_B;
        if (r < I_OM) { p0_transpose_item(win + 3080, IN_DIM, DM, wint + (size_t)C_OM * DM, 16, scr, r, lane_); continue; } r -= I_OM;
        if (r < I_C) { p0_transpose_item(win + 3600, IN_DIM, DM, wint + (size_t)C_GG * DM, 64, scr, r, lane_); continue; } r -= I_C;
        if (r < I_BG) { p0_transpose_item(F.a->in[I_WBG] + (size_t)l * 512 * DM, DM, 1024, w_ptr(F, l, WO_WBG), 32, scr, r, lane_); continue; } r -= I_BG;
        if (r < I_BM) { p0_transpose_item(F.a->in[I_WBM] + (size_t)l * 512 * DM, DM, 1024, w_ptr(F, l, WO_WBG) + 512, 32, scr, r, lane_); continue; } r -= I_BM;
        if (r < I_O) { p0_transpose_item(F.a->in[I_WOUT] + (size_t)l * DM * DM, DM, DM, w_ptr(F, l, WO_WOUT), 32, scr, r, lane_); continue; } r -= I_O;
        if (r < I_U) { p0_transpose_item(F.a->in[I_WUP] + (size_t)l * DM * FF, FF, DM, w_ptr(F, l, WO_WUP), 128, scr, r, lane_); continue; } r -= I_U;
        p0_transpose_item(F.a->in[I_WDN] + (size_t)l * FF * DM, DM, FF, w_ptr(F, l, WO_WDN), 32, scr, r, lane_);
    }
    const int gt = (F.bid - b0) * (NWAVES * 64) + tq_, NGT = nb * NWAVES * 64;
    for (int i = gt; i < 16 * DM; i += NGT) {
        const int n = i / DM, k = i % DM;
        const int src = (n < 8) ? 2048 + n : 3592 + (n - 8);
        w_ptr(F, l, WO_WIN)[(size_t)(C_SMALL + n) * DM + k] = (bf16)f2bf(F.a->in[I_WIN][(size_t)l * DM * IN_DIM + (size_t)k * IN_DIM + src]);
    }
    { unsigned zz = 0u; asm volatile("" : "+v"(zz));
      for (int i = gt; i < (NPAD - IN_DIM) * DM / 8; i += NGT) ((GAS v4u*)(w_ptr(F, l, WO_WIN) + (size_t)IN_DIM * DM))[i] = (v4u){zz, zz, zz, zz}; }
}

__device__ __forceinline__ const float* x_row(const Frame& F, int src, int m) {
    if (src == 0 || (src == 2 && m >= MP)) return (m < MP) ? F.a->in[I_XP] + (size_t)m * DM : F.a->in[I_XS] + (size_t)(m - MP) * DM;
    return F.out + O_Y + (size_t)m * DM;
}
__device__ __forceinline__ void wait_count(unsigned* cnt, unsigned need, int wave) {
    if (wave == 0) { unsigned sp = 0;
        while ((unsigned)__builtin_amdgcn_readfirstlane(__hip_atomic_load(cnt, __ATOMIC_RELAXED, __HIP_MEMORY_SCOPE_AGENT)) < need) { __builtin_amdgcn_s_sleep(2); if (++sp > (1u << 22)) break; }
        __builtin_amdgcn_fence(__ATOMIC_ACQUIRE, "agent");
        asm volatile("s_waitcnt vmcnt(0)" ::: "memory"); }
    __syncthreads();
}
__device__ __forceinline__ f32x4 slab_sum(const float* slab, int sr, int j, int lane, int np) {
    const float* p = slab + ((size_t)((sr >> 8) * 4 + j) * np * 256 + (sr & 255)) * 256 + 4 * lane;
    f32x4 s = (f32x4){0.f, 0.f, 0.f, 0.f};
    for (int q = 0; q < np; ++q) s += *(const GAS f32x4*)(p + (size_t)q * 65536);
    return s;
}
__device__ __forceinline__ void norm_phase(Frame& F, int src_layer, const float* w, bf16* xn, int np, const float* slab = nullptr, int m0 = 0, int m1 = M, int wk = 0, int nwk = 0) {
    int tq_ = threadIdx.x; asm volatile("" : "+v"(tq_)); const int lane_ = tq_ & 63, wave_ = __builtin_amdgcn_readfirstlane(tq_ >> 6);
    const int NGW = (nwk > 0 ? nwk : F.G) * NWAVES, gw = nwk == 0 ? F.bid * NWAVES + wave_ : NGW - 1 - (wave_ * nwk + wk);
    f32x4 wv[4];
#pragma unroll
    for (int j = 0; j < 4; ++j) wv[j] = ((const f32x4*)w)[lane_ + 64 * j];
    for (int m = m0 + NGW - 1 - gw; m < m1; m += NGW) {
        const GAS f32x4* xr = (const GAS f32x4*)x_row(F, src_layer, m) + lane_;
        f32x4 v[4]; float s = 0.f;
#pragma unroll
        for (int j = 0; j < 4; ++j) v[j] = xr[64 * j];
        if (np > 0 && m >= MP) { GAS f32x4* xo = (GAS f32x4*)(F.out + O_Y + (size_t)m * DM) + lane_;
#pragma unroll
            for (int j = 0; j < 4; ++j) { v[j] += slab_sum(slab, m - MP, j, lane_, np); xo[64 * j] = v[j]; } }
#pragma unroll
        for (int j = 0; j < 4; ++j) s += (v[j].x * v[j].x + v[j].y * v[j].y) + (v[j].z * v[j].z + v[j].w * v[j].w);
        const float r = frsq(wave_sum(s) * (1.f / DM) + EPS);
        GAS v2u* o8 = (GAS v2u*)(xn + (size_t)m * DM) + lane_;
#pragma unroll
        for (int j = 0; j < 4; ++j) { v2u o; o.x = pk2(v[j].x * r * wv[j].x, v[j].y * r * wv[j].y); o.y = pk2(v[j].z * r * wv[j].z, v[j].w * r * wv[j].w); o8[64 * j] = o; }
    }
}
__device__ __forceinline__ void final_norm_phase(Frame& F, int np, const float* slab, int m0 = 0) {
    int tq_ = threadIdx.x; asm volatile("" : "+v"(tq_)); const int lane_ = tq_ & 63, wave_ = __builtin_amdgcn_readfirstlane(tq_ >> 6);
    const int NGW = F.G * NWAVES, gw = m0 == 0 ? F.bid * NWAVES + wave_ : NGW - 1 - (wave_ * F.G + F.bid);
    const float* w = F.a->in[I_NFIN];
    f32x4 wv[4];
#pragma unroll
    for (int j = 0; j < 4; ++j) wv[j] = ((const f32x4*)w)[lane_ + 64 * j];
    for (int m = m0 + NGW - 1 - gw; m < M; m += NGW) {
        GAS f32x4* xr = (GAS f32x4*)(F.out + O_Y + (size_t)m * DM) + lane_;
        f32x4 v[4]; float s = 0.f;
#pragma unroll
        for (int j = 0; j < 4; ++j) v[j] = xr[64 * j];
        if (np > 0 && m >= MP) {
#pragma unroll
            for (int j = 0; j < 4; ++j) v[j] += slab_sum(slab, m - MP, j, lane_, np); }
#pragma unroll
        for (int j = 0; j < 4; ++j) s += (v[j].x * v[j].x + v[j].y * v[j].y) + (v[j].z * v[j].z + v[j].w * v[j].w);
        const float r = frsq(wave_sum(s) * (1.f / DM) + EPS);
#pragma unroll
        for (int j = 0; j < 4; ++j) xr[64 * j] = v[j] * r * wv[j];
    }
}


typedef short bf16x8 __attribute__((ext_vector_type(8)));
__device__ __forceinline__ int pos32(int kk) { return 8 * ((kk & 15) >> 2) + 4 * (kk >> 4) + (kk & 3); }
__device__ __forceinline__ int permk(int k) { return (k & ~31) + pos32(k & 31); }
__device__ __forceinline__ int lperm(int g, int j) { return j < 4 ? 4 * g + j : 16 + 4 * g + (j - 4); }
__device__ __forceinline__ bf16x8 pack_acc2(const f32x4 a, const f32x4 b) {
    v4u w; w.x = pg8::cvt_pk_bf16(a[0], a[1]); w.y = pg8::cvt_pk_bf16(a[2], a[3]); w.z = pg8::cvt_pk_bf16(b[0], b[1]); w.w = pg8::cvt_pk_bf16(b[2], b[3]);
    return __builtin_bit_cast(bf16x8, w);
}
#define MFMA16(a, b, c) __builtin_amdgcn_mfma_f32_16x16x32_bf16((a), (b), (c), 0, 0, 0)
#define SBAR() __builtin_amdgcn_sched_barrier(0)
#define LBAR() do { asm volatile("s_waitcnt lgkmcnt(0)" ::: "memory"); __builtin_amdgcn_s_barrier(); asm volatile("" ::: "memory"); } while (0)
constexpr size_t XN_WBUF = 0, XN_QKBUF = (size_t)1024 * 64 * 128 * 2, XN_PBUF = XN_QKBUF + (size_t)1024 * 64 * 64 * 2;
static_assert(XN_PBUF + (size_t)1024 * 64 * 64 * 2 <= (size_t)M * DM * 2, "prep buffers fit the XN region");

struct GdnIn { v4u rw[6], rz[2], rh; float gb, ga; };
struct GdnConst { float w0, w1, w2, w3, aexp, dtb; };
__device__ __forceinline__ void gdn_prep_load(Frame& F, int grp, int h, GdnIn& R) {
    const bf16* proj = (const bf16*)(F.ws + WS_PROJ); const bf16* halo = (const bf16*)(F.ws + WS_HALO); const float* gates = (const float*)(F.ws + WS_GATES);
    int tl = F.tid; asm volatile("" : "+v"(tl));
    const int r0 = grp * 64, c = grp & 31;
#pragma unroll
    for (int k = 0; k < 6; ++k) { const int q = tl + 512 * k, j = q / 48, rem = q - 48 * j; R.rw[k] = *(const GAS v4u*)(proj + (size_t)(r0 + j) * IN_DIM + (rem >> 4) * 512 + h * 128 + (rem & 15) * 8); }
#pragma unroll
    for (int k = 0; k < 2; ++k) { const int q = tl + 512 * k; R.rz[k] = *(const GAS v4u*)(proj + (size_t)(r0 + (q >> 4)) * IN_DIM + C_ZG + h * 128 + (q & 15) * 8); }
    { const int th = tl < 144 ? tl : 0, j = th / 48, rem = th - 48 * j, gp = grp > 0 ? grp - 1 : 0;
      R.rh = *(const GAS v4u*)(halo + ((size_t)gp * 3 + j) * CONVC + (rem >> 4) * 512 + h * 128 + (rem & 15) * 8);
      if (c == 0) { unsigned zz = 0u; asm volatile("" : "+v"(zz)); R.rh = (v4u){zz, zz, zz, zz}; } }
    { const int t6 = tl & 63; R.gb = gates[(size_t)(r0 + t6) * 16 + h]; R.ga = gates[(size_t)(r0 + t6) * 16 + 4 + h]; }
}
__device__ __forceinline__ void gdn_prep_item(Frame& F, int l, int grp, int h, GdnIn& R, const GdnConst& K, int nxt) {
    LAS unsigned char* L = F.lds + RING_OFF;
    LAS bf16* XPB = (LAS bf16*)L;
    LAS float* AM = (LAS float*)L;
    LAS bf16* WST = (LAS bf16*)(L + 16384);
    LAS bf16* QKS = (LAS bf16*)(L + 32768);
    constexpr int PIT = 136;
    LAS bf16* KB = (LAS bf16*)(L + 51456);
    LAS bf16* QB = (LAS bf16*)(L + 51456 + 17408);
    LAS bf16* VB = (LAS bf16*)(L + 51456 + 2 * 17408);
    LAS bf16* ZB = (LAS bf16*)(L + 51456 + 3 * 17408);
    LAS float* SC = (LAS float*)(L + 51456 + 4 * 17408);
    bf16* proj = (bf16*)(F.ws + WS_PROJ);
    const bf16* halo = (const bf16*)(F.ws + WS_HALO);
    const float* gates = (const float*)(F.ws + WS_GATES);
    const float* cw = F.a->in[I_CONVW] + (size_t)l * 4 * CONVC;
    const int r0 = grp * 64, c = grp & 31, item = grp * 4 + h;
    bf16* Wg = (bf16*)(F.ws + WS_XN + XN_WBUF) + (size_t)item * 8192;
    bf16* QKg = (bf16*)(F.ws + WS_XN + XN_QKBUF) + (size_t)item * 4096;
    LBAR();
    int tl = F.tid; asm volatile("" : "+v"(tl));
    {
#pragma unroll
        for (int k = 0; k < 6; ++k) { const int q = tl + 512 * k, j = q / 48, rem = q - 48 * j; *(LAS v4u*)(XPB + (j + 3) * 384 + (rem >> 4) * 128 + (rem & 15) * 8) = R.rw[k]; }
#pragma unroll
        for (int k = 0; k < 2; ++k) { const int q = tl + 512 * k; *(LAS v4u*)(ZB + (q >> 4) * PIT + (q & 15) * 8) = R.rz[k]; }
        if (tl < 144) { const int j = tl / 48, rem = tl - 48 * j; *(LAS v4u*)(XPB + j * 384 + (rem >> 4) * 128 + (rem & 15) * 8) = R.rh; }
        if (tl < 64) { SC[tl] = sigm(R.gb); SC[64 + tl] = -K.aexp * softplusf(R.ga + K.dtb); }
    }
    asm volatile("" ::: "memory");
    if (nxt >= 0) gdn_prep_load(F, nxt >> 2, nxt & 3, R);
    LBAR();
    {    {
        tl = F.tid; asm volatile("" : "+v"(tl));
        if (tl < 384) {
            const int s = tl >> 7, e = tl & 127;
            const float w0 = K.w0, w1 = K.w1, w2 = K.w2, w3 = K.w3;
            LAS bf16* dst = (s == 0 ? QB : s == 1 ? KB : VB) + e;
            const LAS bf16* src = XPB + tl;
            float x0 = bf2f(src[0]), x1 = bf2f(src[384]), x2 = bf2f(src[768]);
#pragma unroll 16
            for (int t = 0; t < 64; ++t) { const float x3 = bf2f(src[(t + 3) * 384]);
                const float a = ((x0 * w0 + x1 * w1) + (x2 * w2 + x3 * w3));
                dst[t * PIT] = (bf16)f2bf(siluf(a)); x0 = x1; x1 = x2; x2 = x3; }
        }
        if (c == 31) { float* cp = F.out + O_CONVP + ((size_t)l * PB + (grp >> 5)) * 3 * CONVC;
            for (int q = tl; q < 3 * 384; q += NWAVES * 64) { const int j = q / 384, x = q % 384; cp[(size_t)j * CONVC + (x >> 7) * 512 + h * 128 + (x & 127)] = bf2f(XPB[(64 + j) * 384 + x]); } }
        if (tl >= 448) {
            const int lane_ = tl & 63; const float x = wave_scan_add(SC[64 + lane_]);
            SC[128 + lane_] = x; SC[192 + lane_] = __expf(x);
        }
    }
    LBAR();
    {
        tl = F.tid; asm volatile("" : "+v"(tl));
        if (tl < 128) { const int t = tl & 63, wh = tl >> 6; const LAS bf16* row = (wh ? KB : QB) + t * PIT; float ss = 0.f;
#pragma unroll
            for (int k8 = 0; k8 < 16; ++k8) { const v4u w = *(const LAS v4u*)(row + 8 * k8);
                ss += (pg8::bf_lo(w.x) * pg8::bf_lo(w.x) + pg8::bf_hi(w.x) * pg8::bf_hi(w.x)) + (pg8::bf_lo(w.y) * pg8::bf_lo(w.y) + pg8::bf_hi(w.y) * pg8::bf_hi(w.y))
                    + (pg8::bf_lo(w.z) * pg8::bf_lo(w.z) + pg8::bf_hi(w.z) * pg8::bf_hi(w.z)) + (pg8::bf_lo(w.w) * pg8::bf_lo(w.w) + pg8::bf_hi(w.w) * pg8::bf_hi(w.w)); }
            SC[256 + tl] = frsq(ss + EPS) * (wh ? 1.0f : 0.08838834764831845f); }
    }
    LBAR();
    }
    {    {
        tl = F.tid; asm volatile("" : "+v"(tl)); const int lane_ = tl & 63, wave_ = __builtin_amdgcn_readfirstlane(tl >> 6);
        const int sel = wave_ >> 2, ti = wave_ & 3, fr = lane_ & 15, g = lane_ >> 4;
        const LAS bf16* X = sel ? QB : KB;
        for (int tj = 0; tj < 4; ++tj) {
            f32x4 acc = (f32x4){0.f, 0.f, 0.f, 0.f};
            if (tj <= ti) {
#pragma unroll
                for (int s = 0; s < 4; ++s) { const bf16x8 a = *(const LAS bf16x8*)(X + (16 * ti + fr) * PIT + 32 * s + 8 * g), bq = *(const LAS bf16x8*)(KB + (16 * tj + fr) * PIT + 32 * s + 8 * g);
                    acc = MFMA16(a, bq, acc); }
            }
            const int j = 16 * tj + fr; const float gcj = SC[128 + j], rkj = SC[320 + j];
#pragma unroll
            for (int r = 0; r < 4; ++r) { const int i = 16 * ti + 4 * g + r; const float dec = __expf(fminf(SC[128 + i] - gcj, 0.f)) * rkj;
                if (sel == 0) AM[i * 64 + j] = (j < i) ? SC[i] * SC[320 + i] * acc[r] * dec : 0.f;
                else QKS[i * 64 + permk(j)] = (bf16)f2bf((j <= i) ? SC[256 + i] * acc[r] * dec : 0.f); }
        }
    }
    LBAR();
    }
    const float gcL = SC[128 + 63];
    tl = F.tid; asm volatile("" : "+v"(tl));
    *(GAS v4u*)(QKg + tl * 8) = *(const LAS v4u*)(QKS + tl * 8);
    LAS float* DINV = (LAS float*)(L + 40960);
    if (tl < 64) {
        const int bb = tl >> 4, j = tl & 15; const LAS float* Ab = AM + (16 * bb) * 64 + 16 * bb; float t[16];
#pragma unroll
        for (int i = 0; i < 16; ++i) { float a0 = (i == j) ? 1.f : 0.f, a1 = 0.f;
#pragma unroll
            for (int k4 = 0; k4 < (i + 3) / 4; ++k4) { const f32x4 av = *(const LAS f32x4*)(Ab + i * 64 + 4 * k4);
#pragma unroll
                for (int e = 0; e < 4; ++e) if (4 * k4 + e < i) { if (e & 1) a1 -= av[e] * t[4 * k4 + e]; else a0 -= av[e] * t[4 * k4 + e]; } }
            t[i] = a0 + a1; DINV[(bb * 16 + i) * 16 + j] = t[i]; }
    } else {
        const int t2 = tl - 64;
#pragma unroll 1
        for (int q0 = t2; q0 < 3072; q0 += 448) { const int ty = q0 >> 10, q = q0 & 1023;
            if (ty == 0) { const int t = q >> 4, ch = q & 15, s = ch >> 2, gq = ch & 3; const float e = SC[192 + t] * SC[256 + t];
                const v2u a = *(const LAS v2u*)(QB + t * PIT + 32 * s + 4 * gq), b2 = *(const LAS v2u*)(QB + t * PIT + 32 * s + 16 + 4 * gq);
                v4u o; o.x = pk2(pg8::bf_lo(a.x) * e, pg8::bf_hi(a.x) * e); o.y = pk2(pg8::bf_lo(a.y) * e, pg8::bf_hi(a.y) * e); o.z = pk2(pg8::bf_lo(b2.x) * e, pg8::bf_hi(b2.x) * e); o.w = pk2(pg8::bf_lo(b2.y) * e, pg8::bf_hi(b2.y) * e);
                *(GAS v4u*)(proj + (size_t)(r0 + t) * IN_DIM + C_QG + h * 128 + ch * 8) = o;
            } else if (ty == 1) { const int dk = q >> 3, ch = q & 7, s = ch >> 2, gq = ch & 3; float v[8];
#pragma unroll
                for (int e = 0; e < 8; ++e) { const int tok = 32 * s + lperm(gq, e); v[e] = bf2f(KB[tok * PIT + dk]) * __expf(fminf(gcL - SC[128 + tok], 0.f)) * SC[320 + tok]; }
                v4u o; o.x = pk2(v[0], v[1]); o.y = pk2(v[2], v[3]); o.z = pk2(v[4], v[5]); o.w = pk2(v[6], v[7]);
                *(GAS v4u*)(proj + (size_t)(r0 + (dk >> 1)) * IN_DIM + C_KG + h * 128 + (dk & 1) * 64 + ch * 8) = o;
            } else { const int cp2 = q & 7, gq = (q >> 3) & 3, m = (q >> 5) & 3, w = q >> 7; unsigned short zv[8];
#pragma unroll
                for (int e = 0; e < 8; ++e) zv[e] = ZB[(16 * m + 4 * gq + (e & 3)) * PIT + 16 * w + 2 * cp2 + (e >> 2)];
                v4u o; o.x = zv[0] | ((unsigned)zv[1] << 16); o.y = zv[2] | ((unsigned)zv[3] << 16); o.z = zv[4] | ((unsigned)zv[5] << 16); o.w = zv[6] | ((unsigned)zv[7] << 16);
                *(GAS v4u*)(proj + (size_t)(r0 + (w * 4 + m) * 2 + (gq >> 1)) * IN_DIM + C_ZG + h * 128 + (gq & 1) * 64 + cp2 * 8) = o; }
        }
        if (t2 == 0) ((float*)(F.ws + WS_GSCAL))[item] = __expf(gcL);
    }
    LBAR();
    {
        tl = F.tid; asm volatile("" : "+v"(tl));
        const int lane_ = tl & 63, wave_ = __builtin_amdgcn_readfirstlane(tl >> 6), ci = lane_ & 15, gq = lane_ >> 4;
#pragma unroll
        for (int nn = 0; nn < 2; ++nn) {
            const int nt = 2 * wave_ + nn, col = 16 * nt + ci; f32x4 X[4];
#pragma unroll
            for (int b = 0; b < 4; ++b) {
                f32x4 y; const f32x4 be = *(const LAS f32x4*)(SC + 16 * b + 4 * gq);
                if (nt < 8) { const f32x4 eg = *(const LAS f32x4*)(SC + 192 + 16 * b + 4 * gq), rk = *(const LAS f32x4*)(SC + 320 + 16 * b + 4 * gq);
#pragma unroll
                    for (int r = 0; r < 4; ++r) y[r] = be[r] * eg[r] * rk[r] * bf2f(KB[(16 * b + 4 * gq + r) * PIT + col]);
                } else {
#pragma unroll
                    for (int r = 0; r < 4; ++r) y[r] = be[r] * bf2f(VB[(16 * b + 4 * gq + r) * PIT + col - 128]); }
#pragma unroll
                for (int bp = 0; bp < b; ++bp) { const f32x4 a = *(const LAS f32x4*)(AM + (16 * b + ci) * 64 + 16 * bp + 4 * gq);
#pragma unroll
                    for (int r = 0; r < 4; ++r) y = __builtin_amdgcn_mfma_f32_16x16x4f32(-a[r], X[bp][r], y, 0, 0, 0); }
                const f32x4 d = *(const LAS f32x4*)(DINV + (b * 16 + ci) * 16 + 4 * gq);
                f32x4 x = (f32x4){0.f, 0.f, 0.f, 0.f};
#pragma unroll
                for (int r = 0; r < 4; ++r) x = __builtin_amdgcn_mfma_f32_16x16x4f32(d[r], y[r], x, 0, 0, 0);
                X[b] = x;
                if (nt < 8) {
#pragma unroll
                    for (int r = 0; r < 4; ++r) WST[(16 * b + 4 * gq + r) * 128 + permk(col)] = (bf16)f2bf(x[r]);
                } else { v2u o; o.x = pk2(x[0], x[1]); o.y = pk2(x[2], x[3]);
                    *(GAS v2u*)(proj + (size_t)(r0 + ((nt - 8) * 4 + b) * 2 + (gq >> 1)) * IN_DIM + C_VG + h * 128 + (gq & 1) * 64 + ci * 4) = o; }
            }
        }
    }
    LBAR();
    tl = F.tid; asm volatile("" : "+v"(tl));
#pragma unroll
    for (int k = 0; k < 2; ++k) *(GAS v4u*)(Wg + (tl + 512 * k) * 8) = *(const LAS v4u*)(WST + (tl + 512 * k) * 8);
}

__device__ __forceinline__ void gdn_scan_prompt(Frame& F, int l, int b, int h) {
    LAS unsigned char* L = F.lds + RING_OFF;
    constexpr int BUFB = 57344, W_OFF = 0, QD_OFF = 16384, KDT_OFF = 32768, QK_OFF = 49152, RED_OFF = 2 * BUFB, RSV_OFF = RED_OFF + 4096, OGW_OFF = RSV_OFF + 2048;
    static_assert(OGW_OFF + 8 * 2048 <= RING_BYTES, "scan LDS map");
    bf16* proj = (bf16*)(F.ws + WS_PROJ);
    const bf16* Wb = (const bf16*)(F.ws + WS_XN + XN_WBUF);
    const bf16* QKb = (const bf16*)(F.ws + WS_XN + XN_QKBUF);
    const float* gscal = (const float*)(F.ws + WS_GSCAL);
    int tl_ = F.tid; asm volatile("" : "+v"(tl_));
    const int tid = tl_, lane = tid & 63, w = __builtin_amdgcn_readfirstlane(tid >> 6), c = lane & 15, g = lane >> 4;
    const float gn = F.a->in[I_GNORM][l * GDV + 16 * w + c];
    f32x4 S[8];
#pragma unroll
    for (int n = 0; n < 8; ++n) S[n] = (f32x4){0.f, 0.f, 0.f, 0.f};
    const int prow = tid >> 4, pch = tid & 15;
    const int krow = tid >> 3, kch = tid & 7;
    const unsigned dW0 = W_OFF + prow * 256 + ((pch ^ (prow & 15)) << 4), dW1 = dW0 + 32 * 256;
    const unsigned dK0 = KDT_OFF + krow * 128 + ((kch ^ ((krow >> 1) & 7)) << 4), dK1 = dK0 + 64 * 128;
    const unsigned dQ = QK_OFF + krow * 128 + ((kch ^ ((krow >> 1) & 7)) << 4);
    v4u st[7]; v2u un[4], zn[4]; float dln;
#define GS_LOAD(chunk) do { const int grp_ = b * 32 + (chunk), item_ = grp_ * 4 + h; const size_t r0_ = (size_t)grp_ * 64; \
        st[0] = *(const GAS v4u*)(Wb + (size_t)item_ * 8192 + prow * 128 + pch * 8); st[1] = *(const GAS v4u*)(Wb + (size_t)item_ * 8192 + (prow + 32) * 128 + pch * 8); \
        st[2] = *(const GAS v4u*)(proj + (r0_ + prow) * IN_DIM + C_QG + h * 128 + pch * 8); st[3] = *(const GAS v4u*)(proj + (r0_ + prow + 32) * IN_DIM + C_QG + h * 128 + pch * 8); \
        st[4] = *(const GAS v4u*)(proj + (r0_ + (krow >> 1)) * IN_DIM + C_KG + h * 128 + (krow & 1) * 64 + kch * 8); \
        st[5] = *(const GAS v4u*)(proj + (r0_ + 32 + (krow >> 1)) * IN_DIM + C_KG + h * 128 + (krow & 1) * 64 + kch * 8); \
        st[6] = *(const GAS v4u*)(QKb + (size_t)item_ * 4096 + krow * 64 + kch * 8); \
        _Pragma("unroll") for (int m_ = 0; m_ < 4; ++m_) { const bf16* p_ = proj + (r0_ + (w * 4 + m_) * 2 + (g >> 1)) * IN_DIM + h * 128 + (g & 1) * 64 + c * 4; \
            un[m_] = *(const GAS v2u*)(p_ + C_VG); zn[m_] = *(const GAS v2u*)(p_ + C_ZG); } \
        dln = gscal[item_]; } while (0)
#define GS_WRITE(buf) do { LAS unsigned char* B_ = L + (buf) * BUFB; \
        *(LAS v4u*)(B_ + dW0) = st[0]; *(LAS v4u*)(B_ + dW1) = st[1]; *(LAS v4u*)(B_ + QD_OFF + dW0) = st[2]; *(LAS v4u*)(B_ + QD_OFF + dW1) = st[3]; \
        *(LAS v4u*)(B_ + dK0) = st[4]; *(LAS v4u*)(B_ + dK1) = st[5]; *(LAS v4u*)(B_ + dQ) = st[6]; } while (0)
    unsigned fW[4], fK[2];
#pragma unroll
    for (int s = 0; s < 4; ++s) fW[s] = c * 256 + (((4 * s + g) ^ c) << 4);
#pragma unroll
    for (int s = 0; s < 2; ++s) fK[s] = c * 128 + (((4 * s + g) ^ ((c >> 1) & 7)) << 4);
    __syncthreads();
    GS_LOAD(0); GS_WRITE(0);
    v2u uw[4], zw[4]; float dl = dln;
#pragma unroll
    for (int m = 0; m < 4; ++m) { uw[m] = un[m]; zw[m] = zn[m]; }
    __syncthreads();
#pragma unroll 1
    for (int chunk = 0; chunk < 32; ++chunk) {
        const int cur = chunk & 1; const LAS unsigned char* B = L + cur * BUFB;
        const size_t r0 = (size_t)(b * 32 + chunk) * 64;
        if (((chunk + 1) & 7) == 0 && chunk + 1 < 32) wait_count((unsigned*)(F.ws + WS_CTL) + CW_SOFT + 64 * l + 48 + ((chunk + 1) >> 3), 192u, w);
        if (chunk + 1 < 32) GS_LOAD(chunk + 1);
        bf16x8 Sb[4];
#pragma unroll
        for (int s = 0; s < 4; ++s) Sb[s] = pack_acc2(S[2 * s], S[2 * s + 1]);
#define LD8_W(dst, off, m0) do { _Pragma("unroll") for (int mm_ = 0; mm_ < 2; ++mm_) _Pragma("unroll") for (int s_ = 0; s_ < 4; ++s_) dst[mm_ * 4 + s_] = *(const LAS bf16x8*)(B + (off) + ((m0) + mm_) * 4096 + fW[s_]); } while (0)
#define LD8_K(dst, off, n0) do { _Pragma("unroll") for (int nn_ = 0; nn_ < 4; ++nn_) _Pragma("unroll") for (int s_ = 0; s_ < 2; ++s_) dst[nn_ * 2 + s_] = *(const LAS bf16x8*)(B + (off) + ((n0) + nn_) * 2048 + fK[s_]); } while (0)
        bf16x8 fa[8], fb[8], fc[8];
        f32x4 Vn[4], O[4];
        LD8_W(fa, W_OFF, 0); LD8_W(fb, W_OFF, 2); SBAR();
#pragma unroll
        for (int mm = 0; mm < 2; ++mm) { f32x4 p = (f32x4){0.f, 0.f, 0.f, 0.f};
#pragma unroll
            for (int s = 0; s < 4; ++s) p = MFMA16(fa[mm * 4 + s], Sb[s], p);
            Vn[mm] = (f32x4){pg8::bf_lo(uw[mm].x), pg8::bf_hi(uw[mm].x), pg8::bf_lo(uw[mm].y), pg8::bf_hi(uw[mm].y)} - p; }
        LD8_W(fa, QD_OFF, 0); SBAR();
#pragma unroll
        for (int mm = 0; mm < 2; ++mm) { f32x4 p = (f32x4){0.f, 0.f, 0.f, 0.f};
#pragma unroll
            for (int s = 0; s < 4; ++s) p = MFMA16(fb[mm * 4 + s], Sb[s], p);
            Vn[2 + mm] = (f32x4){pg8::bf_lo(uw[2 + mm].x), pg8::bf_hi(uw[2 + mm].x), pg8::bf_lo(uw[2 + mm].y), pg8::bf_hi(uw[2 + mm].y)} - p; }
        LD8_W(fb, QD_OFF, 2); SBAR();
        bf16x8 Vb[2];
        Vb[0] = pack_acc2(Vn[0], Vn[1]); Vb[1] = pack_acc2(Vn[2], Vn[3]);
#pragma unroll
        for (int mm = 0; mm < 2; ++mm) { f32x4 o = (f32x4){0.f, 0.f, 0.f, 0.f};
#pragma unroll
            for (int s = 0; s < 4; ++s) o = MFMA16(fa[mm * 4 + s], Sb[s], o);
            O[mm] = o; }
        LD8_K(fc, QK_OFF, 0); SBAR();
#pragma unroll
        for (int mm = 0; mm < 2; ++mm) { f32x4 o = (f32x4){0.f, 0.f, 0.f, 0.f};
#pragma unroll
            for (int s = 0; s < 4; ++s) o = MFMA16(fb[mm * 4 + s], Sb[s], o);
            O[2 + mm] = o; }
        LD8_K(fa, KDT_OFF, 0); SBAR();
#pragma unroll
        for (int mm = 0; mm < 4; ++mm)
#pragma unroll
            for (int s = 0; s < 2; ++s) O[mm] = MFMA16(fc[mm * 2 + s], Vb[s], O[mm]);
        LD8_K(fb, KDT_OFF, 4); SBAR();
#pragma unroll
        for (int n = 0; n < 4; ++n) { f32x4 a = S[n] * dl;
#pragma unroll
            for (int s = 0; s < 2; ++s) a = MFMA16(fa[n * 2 + s], Vb[s], a);
            S[n] = a; }
        SBAR();
#pragma unroll
        for (int n = 0; n < 4; ++n) { f32x4 a = S[4 + n] * dl;
#pragma unroll
            for (int s = 0; s < 2; ++s) a = MFMA16(fb[n * 2 + s], Vb[s], a);
            S[4 + n] = a; }
#undef LD8_W
#undef LD8_K
        LAS float* RED = (LAS float*)(L + RED_OFF) + cur * 512;
#pragma unroll
        for (int m = 0; m < 4; ++m)
#pragma unroll
            for (int r = 0; r < 4; ++r) { const float q = row16_sum(O[m][r] * O[m][r]); if (c == 0) RED[(16 * m + 4 * g + r) * 8 + w] = q; }
               if (chunk + 1 < 32) GS_WRITE(cur ^ 1);
               LBAR();
                LAS float* RSV = (LAS float*)(L + RSV_OFF) + w * 64;
        { const f32x4 a = *(const LAS f32x4*)(RED + lane * 8), b2 = *(const LAS f32x4*)(RED + lane * 8 + 4);
          RSV[lane] = frsq(((a[0] + a[1]) + (a[2] + a[3]) + (b2[0] + b2[1]) + (b2[2] + b2[3])) * (1.f / GDV) + EPS); }
        LAS bf16* OGW = (LAS bf16*)(L + OGW_OFF) + w * 1024;
#pragma unroll
        for (int m = 0; m < 4; ++m) { const f32x4 rs = *(const LAS f32x4*)(RSV + 16 * m + 4 * g);
            const float z0 = pg8::bf_lo(zw[m].x), z1 = pg8::bf_hi(zw[m].x), z2 = pg8::bf_lo(zw[m].y), z3 = pg8::bf_hi(zw[m].y);
            OGW[(16 * m + 4 * g + 0) * 16 + c] = (bf16)f2bf(O[m][0] * rs[0] * gn * siluf(z0));
            OGW[(16 * m + 4 * g + 1) * 16 + c] = (bf16)f2bf(O[m][1] * rs[1] * gn * siluf(z1));
            OGW[(16 * m + 4 * g + 2) * 16 + c] = (bf16)f2bf(O[m][2] * rs[2] * gn * siluf(z2));
            OGW[(16 * m + 4 * g + 3) * 16 + c] = (bf16)f2bf(O[m][3] * rs[3] * gn * siluf(z3)); }
        { const v4u o0 = *(const LAS v4u*)(OGW + lane * 16), o1 = *(const LAS v4u*)(OGW + lane * 16 + 8);
          bf16* zp = proj + (r0 + lane) * IN_DIM + C_ZG + h * 128 + 16 * w;
          *(GAS v4u*)zp = o0; *(GAS v4u*)(zp + 8) = o1; }
#pragma unroll
        for (int m = 0; m < 4; ++m) { uw[m] = un[m]; zw[m] = zn[m]; }
        dl = dln;
    }
#undef GS_LOAD
#undef GS_WRITE
    int tz_ = threadIdx.x; asm volatile("" : "+v"(tz_));
    const int c2_ = tz_ & 15, g2_ = (tz_ >> 4) & 3, w2_ = __builtin_amdgcn_readfirstlane(tz_ >> 6);
    float* So = F.out + O_SP + (((size_t)l * PB + b) * GH + h) * GDK * GDV + (size_t)(4 * g2_) * GDV + 16 * w2_ + c2_;
#pragma unroll
    for (int n = 0; n < 8; ++n) { asm volatile("" : "+v"(So));
#pragma unroll
        for (int r = 0; r < 4; ++r) So[r * GDV] = S[n][r];
        So += 16 * GDV; }
}

struct MlIn { v4u rq, rk, rv[2], ro[2]; float gi, gf; };
__device__ __forceinline__ void mlstm_prep_load(Frame& F, int grp, int h, MlIn& R) {
    const bf16* proj = (const bf16*)(F.ws + WS_PROJ); const float* gates = (const float*)(F.ws + WS_GATES);
    int tl = F.tid; asm volatile("" : "+v"(tl));
    const int r0 = grp * 64, row = tl >> 3, ch = tl & 7;
    R.rq = *(const GAS v4u*)(proj + (size_t)(r0 + row) * IN_DIM + C_QM + h * 64 + ch * 8);
    R.rk = *(const GAS v4u*)(proj + (size_t)(r0 + row) * IN_DIM + C_KM + h * 64 + ch * 8);
#pragma unroll
    for (int k = 0; k < 2; ++k) { const int q = tl + 512 * k, vr = q >> 4, vc = q & 15;
        R.rv[k] = *(const GAS v4u*)(proj + (size_t)(r0 + vr) * IN_DIM + C_VM + h * 128 + vc * 8); R.ro[k] = *(const GAS v4u*)(proj + (size_t)(r0 + vr) * IN_DIM + C_OM + h * 128 + vc * 8); }
    { const int t6 = tl & 63; R.gi = gates[(size_t)(r0 + t6) * 16 + 8 + h]; R.gf = gates[(size_t)(r0 + t6) * 16 + 12 + h]; }
}
__device__ __forceinline__ void mlstm_prep_item(Frame& F, int l, int grp, int h, MlIn& R, int nxt) {
    LAS unsigned char* L = F.lds + RING_OFF;
    constexpr int PQ = 72, PV_ = 136;
    LAS bf16* QB = (LAS bf16*)L;
    LAS bf16* KB = (LAS bf16*)(L + 9216);
    LAS bf16* VB = (LAS bf16*)(L + 18432);
    LAS bf16* OB = (LAS bf16*)(L + 18432 + 17408);
    LAS bf16* PS = (LAS bf16*)(L + 18432 + 2 * 17408);
    LAS float* SC = (LAS float*)(L + 18432 + 2 * 17408 + 8192);
    bf16* proj = (bf16*)(F.ws + WS_PROJ);
    const float* gates = (const float*)(F.ws + WS_GATES);
    const int r0 = grp * 64, item = grp * 4 + h;
    bf16* Pg = (bf16*)(F.ws + WS_XN + XN_PBUF) + (size_t)item * 4096;
    float* msc = (float*)(F.ws + WS_MSCAL) + (size_t)item * 256;
    LBAR();
    int tl = F.tid; asm volatile("" : "+v"(tl));
    {
        const int row = tl >> 3, ch = tl & 7;
        *(LAS v4u*)(QB + row * PQ + ch * 8) = R.rq; *(LAS v4u*)(KB + row * PQ + ch * 8) = R.rk;
#pragma unroll
        for (int k = 0; k < 2; ++k) { const int q = tl + 512 * k, vr = q >> 4, vc = q & 15; *(LAS v4u*)(VB + vr * PV_ + vc * 8) = R.rv[k]; *(LAS v4u*)(OB + vr * PV_ + vc * 8) = R.ro[k]; }
        if (tl < 64) { SC[tl] = R.gi + F.a->in[I_IB][l * MH + h]; SC[64 + tl] = -softplusf(-(R.gf + F.a->in[I_FB][l * MH + h])); }
    }
    asm volatile("" ::: "memory");
    if (nxt >= 0) mlstm_prep_load(F, (nxt & 1023) >> 2, nxt & 3, R);
    LBAR();
    tl = F.tid; asm volatile("" : "+v"(tl));
    if (tl < 64) {
        const int lane = tl; const float x = wave_scan_add(SC[64 + lane]);
        const float u = SC[lane] - x; const float pm = wave_scan_max(u);
        const float pml = __builtin_bit_cast(float, __builtin_amdgcn_readlane(__builtin_bit_cast(int, pm), 63));
        SC[128 + lane] = x; SC[192 + lane] = u; SC[256 + lane] = pm; SC[320 + lane] = __expf(u - pml);
        msc[lane] = x; msc[64 + lane] = x + pm;
    }
    LBAR();
    tl = F.tid; asm volatile("" : "+v"(tl));
    if (tl < 256) {
        const int lane_ = tl & 63, ti = __builtin_amdgcn_readfirstlane(tl >> 6), fr = lane_ & 15, g = lane_ >> 4;
        float rsum[4] = {0.f, 0.f, 0.f, 0.f};
        for (int tj = 0; tj < 4; ++tj) {
            f32x4 acc = (f32x4){0.f, 0.f, 0.f, 0.f};
            if (tj <= ti) {
#pragma unroll
                for (int s = 0; s < 2; ++s) { const bf16x8 a = *(const LAS bf16x8*)(QB + (16 * ti + fr) * PQ + 32 * s + 8 * g), bq = *(const LAS bf16x8*)(KB + (16 * tj + fr) * PQ + 32 * s + 8 * g);
                    acc = MFMA16(a, bq, acc); }
            }
            const int j = 16 * tj + fr; const float uj = SC[192 + j];
#pragma unroll
            for (int r = 0; r < 4; ++r) { const int i = 16 * ti + 4 * g + r;
                const float p = (j <= i) ? __expf(fminf(uj - SC[256 + i], 0.f)) * 0.125f * acc[r] : 0.f;
                rsum[r] += p; PS[i * 64 + permk(j)] = (bf16)f2bf(p); }
        }
#pragma unroll
        for (int r = 0; r < 4; ++r) { float q = rsum[r]; q += __shfl_xor(q, 1); q += __shfl_xor(q, 2); q += __shfl_xor(q, 4); q += __shfl_xor(q, 8);
            if (fr == 0) msc[128 + 16 * ti + 4 * g + r] = q; }
    } else {
        const int t2 = tl - 256;
#pragma unroll
        for (int k = 0; k < 2; ++k) { const int q = t2 + 256 * k, t = q >> 3, ch = q & 7, s = ch >> 2, g = ch & 3;
            const v2u a = *(const LAS v2u*)(QB + t * PQ + 32 * s + 4 * g), b2 = *(const LAS v2u*)(QB + t * PQ + 32 * s + 16 + 4 * g);
            v4u o; o.x = pk2(pg8::bf_lo(a.x) * 0.125f, pg8::bf_hi(a.x) * 0.125f); o.y = pk2(pg8::bf_lo(a.y) * 0.125f, pg8::bf_hi(a.y) * 0.125f);
            o.z = pk2(pg8::bf_lo(b2.x) * 0.125f, pg8::bf_hi(b2.x) * 0.125f); o.w = pk2(pg8::bf_lo(b2.y) * 0.125f, pg8::bf_hi(b2.y) * 0.125f);
            *(GAS v4u*)(proj + (size_t)(r0 + t) * IN_DIM + C_QM + h * 64 + ch * 8) = o; }
#pragma unroll
        for (int k = 0; k < 2; ++k) { const int q = t2 + 256 * k, dk = q >> 3, ch = q & 7, s = ch >> 2, g = ch & 3; float v[8];
#pragma unroll
            for (int e = 0; e < 8; ++e) { const int tok = 32 * s + lperm(g, e); v[e] = bf2f(KB[tok * PQ + dk]) * SC[320 + tok]; }
            v4u o; o.x = pk2(v[0], v[1]); o.y = pk2(v[2], v[3]); o.z = pk2(v[4], v[5]); o.w = pk2(v[6], v[7]);
            *(GAS v4u*)(proj + (size_t)(r0 + dk) * IN_DIM + C_KM + h * 64 + ch * 8) = o; }
        if (t2 < 64) { float a = 0.f;
            for (int tok = 0; tok < 64; ++tok) a += bf2f(KB[tok * PQ + t2]) * SC[320 + tok];
            msc[192 + t2] = a; }
#pragma unroll
        for (int k = 0; k < 4; ++k) { const int q = t2 + 256 * k, cc = q & 15, g = (q >> 4) & 3, s = (q >> 6) & 1, w = q >> 7; float v[8];
#pragma unroll
            for (int e = 0; e < 8; ++e) v[e] = bf2f(VB[(32 * s + lperm(g, e)) * PV_ + 16 * w + cc]);
            v4u o; o.x = pk2(v[0], v[1]); o.y = pk2(v[2], v[3]); o.z = pk2(v[4], v[5]); o.w = pk2(v[6], v[7]);
            *(GAS v4u*)(proj + (size_t)(r0 + (w * 2 + s) * 4 + g) * IN_DIM + C_VM + h * 128 + cc * 8) = o; }
#pragma unroll
        for (int k = 0; k < 4; ++k) {
            const int q = t2 + 256 * k, cp2 = q & 7, g = (q >> 3) & 3, mm = (q >> 5) & 3, w = q >> 7; unsigned short zv[8];
#pragma unroll
            for (int e = 0; e < 8; ++e) zv[e] = OB[(16 * mm + 4 * g + (e & 3)) * PV_ + 16 * w + 2 * cp2 + (e >> 2)];
            v4u o; o.x = zv[0] | ((unsigned)zv[1] << 16); o.y = zv[2] | ((unsigned)zv[3] << 16); o.z = zv[4] | ((unsigned)zv[5] << 16); o.w = zv[6] | ((unsigned)zv[7] << 16);
            *(GAS v4u*)(proj + (size_t)(r0 + (w * 4 + mm) * 2 + (g >> 1)) * IN_DIM + C_OM + h * 128 + (g & 1) * 64 + cp2 * 8) = o; }
    }
    LBAR();
    tl = F.tid; asm volatile("" : "+v"(tl));
    *(GAS v4u*)(Pg + tl * 8) = *(const LAS v4u*)(PS + tl * 8);
}

__device__ __forceinline__ void mlstm_scan_prompt(Frame& F, int l, int b, int h) {
    LAS unsigned char* L = F.lds + RING_OFF;
    constexpr int BUFB = 24576, P_OFF = 0, QS_OFF = 8192, KGT_OFF = 16384, SCL_OFF = 2 * BUFB, RED_OFF = SCL_OFF + 2048, RSV_OFF = RED_OFF + 4096, OGW_OFF = RSV_OFF + 2048;
    bf16* proj = (bf16*)(F.ws + WS_PROJ);
    const bf16* Pb = (const bf16*)(F.ws + WS_XN + XN_PBUF);
    const float* mscal = (const float*)(F.ws + WS_MSCAL);
    int tl_ = F.tid; asm volatile("" : "+v"(tl_));
    const int tid = tl_, lane = tid & 63, w = __builtin_amdgcn_readfirstlane(tid >> 6), c = lane & 15, g = lane >> 4;
    const float mn = F.a->in[I_MNORM][(size_t)l * 512 + h * 128 + 16 * w + c];
    f32x4 C[4]; float nv[16]; float m = 0.f;
#pragma unroll
    for (int n = 0; n < 4; ++n) C[n] = (f32x4){0.f, 0.f, 0.f, 0.f};
#pragma unroll
    for (int i = 0; i < 16; ++i) nv[i] = 0.f;
    const int krow = tid >> 3, kch = tid & 7;
    const unsigned dP = krow * 128 + ((kch ^ ((krow >> 1) & 7)) << 4);
    v4u st[3]; f32x4 stsc; bf16x8 vfn[2]; v2u ogn[4];
#define MS_LOAD(chunk) do { const int grp_ = b * 32 + (chunk), item_ = grp_ * 4 + h; const size_t r0_ = (size_t)grp_ * 64; \
        st[0] = *(const GAS v4u*)(Pb + (size_t)item_ * 4096 + krow * 64 + kch * 8); \
        st[1] = *(const GAS v4u*)(proj + (r0_ + krow) * IN_DIM + C_QM + h * 64 + kch * 8); \
        st[2] = *(const GAS v4u*)(proj + (r0_ + krow) * IN_DIM + C_KM + h * 64 + kch * 8); \
        stsc = *(const GAS f32x4*)(mscal + (size_t)item_ * 256 + 4 * (tid & 63)); \
        _Pragma("unroll") for (int s_ = 0; s_ < 2; ++s_) vfn[s_] = *(const GAS bf16x8*)(proj + (r0_ + (w * 2 + s_) * 4 + g) * IN_DIM + C_VM + h * 128 + c * 8); \
        _Pragma("unroll") for (int m_ = 0; m_ < 4; ++m_) ogn[m_] = *(const GAS v2u*)(proj + (r0_ + (w * 4 + m_) * 2 + (g >> 1)) * IN_DIM + C_OM + h * 128 + (g & 1) * 64 + c * 4); } while (0)
#define MS_WRITE(buf) do { LAS unsigned char* B_ = L + (buf) * BUFB; \
        *(LAS v4u*)(B_ + P_OFF + dP) = st[0]; *(LAS v4u*)(B_ + QS_OFF + dP) = st[1]; *(LAS v4u*)(B_ + KGT_OFF + dP) = st[2]; \
        if (tid < 64) *(LAS f32x4*)(L + SCL_OFF + (buf) * 1024 + 16 * tid) = stsc; } while (0)
    unsigned fK[2];
#pragma unroll
    for (int s = 0; s < 2; ++s) fK[s] = c * 128 + (((4 * s + g) ^ ((c >> 1) & 7)) << 4);
    __syncthreads();
    MS_LOAD(0); MS_WRITE(0);
    bf16x8 Vf[2]; v2u ogw[4];
    Vf[0] = vfn[0]; Vf[1] = vfn[1];
#pragma unroll
    for (int mm = 0; mm < 4; ++mm) ogw[mm] = ogn[mm];
    __syncthreads();
#pragma unroll 1
    for (int chunk = 0; chunk < 32; ++chunk) {
        const int cur = chunk & 1; const LAS unsigned char* B = L + cur * BUFB; const LAS float* SCL = (const LAS float*)(L + SCL_OFF + cur * 1024);
        const size_t r0 = (size_t)(b * 32 + chunk) * 64;
        if (((chunk + 1) & 7) == 0 && chunk + 1 < 32) wait_count((unsigned*)(F.ws + WS_CTL) + CW_SOFT + 64 * l + 48 + ((chunk + 1) >> 3), 192u, w);
        if (chunk + 1 < 32) MS_LOAD(chunk + 1);
        bf16x8 Cb[2], nb[2];
#pragma unroll
        for (int s = 0; s < 2; ++s) { Cb[s] = pack_acc2(C[2 * s], C[2 * s + 1]);
            nb[s] = pack_acc2((f32x4){nv[8 * s], nv[8 * s + 1], nv[8 * s + 2], nv[8 * s + 3]}, (f32x4){nv[8 * s + 4], nv[8 * s + 5], nv[8 * s + 6], nv[8 * s + 7]}); }
        const float Fl = SCL[63], Gmax = SCL[127];
        f32x4 H[4];
#define LD8_K(dst, off) do { _Pragma("unroll") for (int nn_ = 0; nn_ < 4; ++nn_) _Pragma("unroll") for (int s_ = 0; s_ < 2; ++s_) dst[nn_ * 2 + s_] = *(const LAS bf16x8*)(B + (off) + nn_ * 2048 + fK[s_]); } while (0)
        bf16x8 fa[8], fb[8];
        LD8_K(fa, QS_OFF); LD8_K(fb, P_OFF); SBAR();
#pragma unroll
        for (int mm = 0; mm < 4; ++mm) {
            f32x4 qc = (f32x4){0.f, 0.f, 0.f, 0.f}, qn = qc, pv = qc;
#pragma unroll
            for (int s = 0; s < 2; ++s) { qc = MFMA16(fa[mm * 2 + s], Cb[s], qc); qn = MFMA16(fa[mm * 2 + s], nb[s], qn); pv = MFMA16(fb[mm * 2 + s], Vf[s], pv); }
            const f32x4 Fi = *(const LAS f32x4*)(SCL + 16 * mm + 4 * g), Dm = *(const LAS f32x4*)(SCL + 64 + 16 * mm + 4 * g), rsm = *(const LAS f32x4*)(SCL + 128 + 16 * mm + 4 * g);
#pragma unroll
            for (int r = 0; r < 4; ++r) { const float mrow = fmaxf(Dm[r], m + Fi[r]), a = __expf(m + Fi[r] - mrow), e = __expf(Dm[r] - mrow);
                const float num = a * qc[r] + e * pv[r], den = a * qn[r] + e * rsm[r];
                H[mm][r] = num * frcp(fmaxf(fabsf(den), __expf(-mrow))); }
        }
        SBAR();
        LD8_K(fa, KGT_OFF); SBAR();
        const float mnew = fmaxf(m + Fl, Gmax), dec = __expf(m + Fl - mnew), eGs = __expf(Gmax - mnew);
#pragma unroll
        for (int n = 0; n < 4; ++n) { f32x4 t = (f32x4){0.f, 0.f, 0.f, 0.f};
#pragma unroll
            for (int s = 0; s < 2; ++s) t = MFMA16(fa[n * 2 + s], Vf[s], t);
            C[n] = C[n] * dec + t * eGs; }
#undef LD8_K
#pragma unroll
        for (int s = 0; s < 2; ++s) { const f32x4 k0 = *(const LAS f32x4*)(SCL + 192 + 32 * s + 4 * g), k1 = *(const LAS f32x4*)(SCL + 192 + 32 * s + 16 + 4 * g);
#pragma unroll
            for (int j = 0; j < 4; ++j) { nv[8 * s + j] = dec * nv[8 * s + j] + eGs * k0[j]; nv[8 * s + 4 + j] = dec * nv[8 * s + 4 + j] + eGs * k1[j]; } }
        m = mnew;
        LAS float* RED = (LAS float*)(L + RED_OFF) + cur * 512;
#pragma unroll
        for (int mm = 0; mm < 4; ++mm)
#pragma unroll
            for (int r = 0; r < 4; ++r) { const float q = row16_sum(H[mm][r] * H[mm][r]); if (c == 0) RED[(16 * mm + 4 * g + r) * 8 + w] = q; }
        if (chunk + 1 < 32) MS_WRITE(cur ^ 1);
        LBAR();
        LAS float* RSV = (LAS float*)(L + RSV_OFF) + w * 64;
        { const f32x4 a = *(const LAS f32x4*)(RED + lane * 8), b2 = *(const LAS f32x4*)(RED + lane * 8 + 4);
          RSV[lane] = frsq(((a[0] + a[1]) + (a[2] + a[3]) + (b2[0] + b2[1]) + (b2[2] + b2[3])) * (1.f / MDV) + EPS); }
        LAS bf16* OGW = (LAS bf16*)(L + OGW_OFF) + w * 1024;
#pragma unroll
        for (int mm = 0; mm < 4; ++mm) { const f32x4 rs = *(const LAS f32x4*)(RSV + 16 * mm + 4 * g);
            const float z0 = pg8::bf_lo(ogw[mm].x), z1 = pg8::bf_hi(ogw[mm].x), z2 = pg8::bf_lo(ogw[mm].y), z3 = pg8::bf_hi(ogw[mm].y);
            OGW[(16 * mm + 4 * g + 0) * 16 + c] = (bf16)f2bf(H[mm][0] * rs[0] * mn * sigm(z0));
            OGW[(16 * mm + 4 * g + 1) * 16 + c] = (bf16)f2bf(H[mm][1] * rs[1] * mn * sigm(z1));
            OGW[(16 * mm + 4 * g + 2) * 16 + c] = (bf16)f2bf(H[mm][2] * rs[2] * mn * sigm(z2));
            OGW[(16 * mm + 4 * g + 3) * 16 + c] = (bf16)f2bf(H[mm][3] * rs[3] * mn * sigm(z3)); }
        { const v4u o0 = *(const LAS v4u*)(OGW + lane * 16), o1 = *(const LAS v4u*)(OGW + lane * 16 + 8);
          bf16* op = proj + (r0 + lane) * IN_DIM + C_OM + h * 128 + 16 * w;
          *(GAS v4u*)op = o0; *(GAS v4u*)(op + 8) = o1; }
        Vf[0] = vfn[0]; Vf[1] = vfn[1];
#pragma unroll
        for (int mm = 0; mm < 4; ++mm) ogw[mm] = ogn[mm];
    }
#undef MS_LOAD
#undef MS_WRITE
    const size_t sidx = ((size_t)l * PB + b) * MH + h;
    int tz_ = threadIdx.x; asm volatile("" : "+v"(tz_));
    const int c2_ = tz_ & 15, g2_ = (tz_ >> 4) & 3, w2_ = __builtin_amdgcn_readfirstlane(tz_ >> 6);
    float* Co = F.out + O_CP + sidx * MDK * MDV + (size_t)(4 * g2_) * MDV + 16 * w2_ + c2_;
#pragma unroll
    for (int n = 0; n < 4; ++n) { asm volatile("" : "+v"(Co));
#pragma unroll
        for (int r = 0; r < 4; ++r) Co[r * MDV] = C[n][r];
        Co += 16 * MDV; }
    if (w2_ == 0 && c2_ == 0) { float* no = F.out + O_NP + sidx * MDK;
#pragma unroll
        for (int s = 0; s < 2; ++s)
#pragma unroll
            for (int j = 0; j < 8; ++j) no[32 * s + lperm(g2_, j)] = nv[8 * s + j]; }
    if (tz_ == 0) F.out[O_MP + sidx] = m;
}
__device__ __forceinline__ void prep_group(Frame& F, int l, int g, int gw, int gnw, int mw, int mnw) {
    const float* cw = F.a->in[I_CONVW] + (size_t)l * 4 * CONVC;
#define PG_B(j) (((((j) >> 6) & 3) << 1) | (((j) >> 2) & 1))
#define PG_ITEM(j) ((((PG_B(j) * 32) + 8 * g + (((j) >> 3) & 7)) << 2) | ((j) & 3))
    if (gw >= 0) {
        GdnIn R; GdnConst K;
        { int tl = F.tid; asm volatile("" : "+v"(tl)); const int hh = gw & 3, s = tl >> 7, e = tl & 127; const int col = (tl < 384) ? s * 512 + hh * 128 + e : 0;
          K.w0 = cw[col]; K.w1 = cw[CONVC + col]; K.w2 = cw[2 * CONVC + col]; K.w3 = cw[3 * CONVC + col];
          K.aexp = __expf(F.a->in[I_ALOG][l * GH + hh]); K.dtb = F.a->in[I_DTB][l * GH + hh]; }
        if (gw < 256) { const int id = PG_ITEM(gw); gdn_prep_load(F, id >> 2, id & 3, R); }
        for (int j = gw; j < 256; j += gnw) { const int id = PG_ITEM(j), nj = j + gnw; gdn_prep_item(F, l, id >> 2, id & 3, R, K, nj < 256 ? PG_ITEM(nj) : -1); }
    }
    if (mw >= 0) {
        MlIn R;
        if (mw < 256) { const int id = PG_ITEM(mw); mlstm_prep_load(F, id >> 2, id & 3, R); }
        for (int j = mw; j < 256; j += mnw) { const int id = PG_ITEM(j), nj = j + mnw; mlstm_prep_item(F, l, id >> 2, id & 3, R, nj < 256 ? PG_ITEM(nj) : -1); }
    }
#undef PG_ITEM
#undef PG_B
}
__device__ __forceinline__ void fe_sample_items(Frame& F, int l) {
    int tq_ = threadIdx.x; asm volatile("" : "+v"(tq_)); const int lane_ = tq_ & 63, wave_ = __builtin_amdgcn_readfirstlane(tq_ >> 6);
    LAS float* XP = (LAS float*)(F.lds + RING_OFF);
    bf16* proj = (bf16*)(F.ws + WS_PROJ);
    const float* cw = F.a->in[I_CONVW] + (size_t)l * 4 * CONVC;
    constexpr int NP_ITEMS = 256 * GH, NS_ITEMS = 16 * GH;
    for (int it = 2 * NP_ITEMS + F.bid; it < 2 * NP_ITEMS + NS_ITEMS; it += F.G) {
        const bool prompt = false;
        const int h = it & 3, grp = (it - 2 * NP_ITEMS) >> 2;
        __syncthreads();
        {
            const int b0 = grp * 8;
            const float* st = F.a->in[I_SCONV] + (size_t)l * SB * 3 * CONVC;
            for (int q = tq_; q < 8 * 7 * 48; q += NWAVES * 64) {
                const int sq = q / (7 * 48), rem = q % (7 * 48), j = rem / 48, s = (rem % 48) >> 4, ch = rem & 15;
                LAS float* d = XP + (sq * 7 + j) * 384 + s * 128 + ch * 8;
                if (j >= 3) { const v4u w = *(const GAS v4u*)(proj + (size_t)(MP + (b0 + sq) * 4 + j - 3) * IN_DIM + s * 512 + h * 128 + ch * 8);
                    d[0] = pg8::bf_lo(w.x); d[1] = pg8::bf_hi(w.x); d[2] = pg8::bf_lo(w.y); d[3] = pg8::bf_hi(w.y); d[4] = pg8::bf_lo(w.z); d[5] = pg8::bf_hi(w.z); d[6] = pg8::bf_lo(w.w); d[7] = pg8::bf_hi(w.w);
                } else { const float* sp = st + ((size_t)(b0 + sq) * 3 + j) * CONVC + s * 512 + h * 128 + ch * 8;
#pragma unroll
                    for (int e = 0; e < 8; ++e) d[e] = sp[e]; }
            }
        }
        __syncthreads();
        float w4[3][2][4];
#pragma unroll
        for (int s = 0; s < 3; ++s)
#pragma unroll
            for (int e = 0; e < 2; ++e)
#pragma unroll
                for (int j = 0; j < 4; ++j) w4[s][e][j] = cw[(size_t)j * CONVC + s * 512 + h * 128 + lane_ + 64 * e];
        const int ntok = prompt ? 8 : 4;
        for (int tt = 0; tt < ntok; ++tt) {
            const LAS float* base; size_t row;
            if (prompt) { const int t = wave_ * 8 + tt; base = XP + t * 384; row = (size_t)grp * 64 + t; }
            else { base = XP + (wave_ * 7 + tt) * 384; row = (size_t)MP + (size_t)(grp * 8 + wave_) * 4 + tt; }
            float y[3][2];
#pragma unroll
            for (int s = 0; s < 3; ++s)
#pragma unroll
                for (int e = 0; e < 2; ++e) { float a = 0.f;
#pragma unroll
                    for (int j = 0; j < 4; ++j) a += base[j * 384 + s * 128 + lane_ + 64 * e] * w4[s][e][j];
                    y[s][e] = siluf(a); }
            const float sq = wave_sum(y[0][0] * y[0][0] + y[0][1] * y[0][1]), sk = wave_sum(y[1][0] * y[1][0] + y[1][1] * y[1][1]);
            const float rq = (frsq(sq + EPS)) * 0.08838834764831845f, rk = frsq(sk + EPS);
            bf16* pr = proj + row * IN_DIM + h * 128 + lane_;
            pr[C_QG] = (bf16)f2bf(y[0][0] * rq); pr[C_QG + 64] = (bf16)f2bf(y[0][1] * rq);
            pr[C_KG] = (bf16)f2bf(y[1][0] * rk); pr[C_KG + 64] = (bf16)f2bf(y[1][1] * rk);
            pr[C_VG] = (bf16)f2bf(y[2][0]);      pr[C_VG + 64] = (bf16)f2bf(y[2][1]);
        }
        if (prompt) {
            if ((grp & 31) == 31) { float* cp = F.out + O_CONVP + ((size_t)l * PB + (grp >> 5)) * 3 * CONVC;
                for (int q = tq_; q < 3 * 384; q += NWAVES * 64) { const int j = q / 384, x = q % 384; cp[(size_t)j * CONVC + (x >> 7) * 512 + h * 128 + (x & 127)] = XP[(64 + j) * 384 + x]; } }
        } else {
            float* cs = F.out + O_CONVS + ((size_t)l * SB + grp * 8) * 3 * CONVC;
            for (int q = tq_; q < 8 * 3 * 384; q += NWAVES * 64) { const int sq = q / (3 * 384), rem = q % (3 * 384), j = rem / 384, x = rem % 384;
                cs[((size_t)sq * 3 + j) * CONVC + (x >> 7) * 512 + h * 128 + (x & 127)] = XP[(sq * 7 + 4 + j) * 384 + x]; }
        }
    }
}

__device__ __forceinline__ void gdn_seq(Frame& F, int l, int h, int row0, int T, const float* S0, float* Sout) {
    LAS float* L = (LAS float*)(F.lds + RING_OFF);
    LAS float* QKVZ = L;
    LAS float* SC = L + 2048;
    LAS float* RED = L + 2048 + 8;
    LAS float* RED2 = RED + 512;
    LAS float* OB = RED2 + 512;
    bf16* proj = (bf16*)(F.ws + WS_PROJ);
    const float* gates = (const float*)(F.ws + WS_GATES);
    int tl_ = F.tid; asm volatile("" : "+v"(tl_)); const int tid_ = tl_, lane_ = tid_ & 63, wave_ = __builtin_amdgcn_readfirstlane(tid_ >> 6);
    const int dv = 16 * wave_ + (lane_ & 15), kq = lane_ >> 4;
    const float Aexp = __expf(F.a->in[I_ALOG][l * GH + h]), dtb = F.a->in[I_DTB][l * GH + h];
    const float gn0 = F.a->in[I_GNORM][l * GDV + lane_], gn1 = F.a->in[I_GNORM][l * GDV + lane_ + 64];
    float S[32];
    if (S0) {
#pragma unroll
        for (int i0 = 0; i0 < 32; i0 += 8) { const float* sp = S0 + (size_t)(32 * kq + i0) * GDV + dv; asm volatile("" : "+v"(sp));
#pragma unroll
            for (int i = 0; i < 8; ++i) S[i0 + i] = sp[i * GDV]; }
    } else {
#pragma unroll
        for (int i = 0; i < 32; ++i) S[i] = 0.f;
    }
    for (int t0 = 0; t0 < T; t0 += 4) {
        __syncthreads();
        { const int tok = tid_ >> 7, e = tid_ & 127; const size_t row = (size_t)row0 + t0 + tok; const bf16* pr = proj + row * IN_DIM + h * 128 + e;
          QKVZ[(tok * 4 + 0) * 128 + e] = bf2f(pr[C_QG]); QKVZ[(tok * 4 + 1) * 128 + e] = bf2f(pr[C_KG]); QKVZ[(tok * 4 + 2) * 128 + e] = bf2f(pr[C_VG]); QKVZ[(tok * 4 + 3) * 128 + e] = bf2f(pr[C_ZG]);
          if (e == 0) { SC[tok * 2] = sigm(gates[row * 16 + h]); SC[tok * 2 + 1] = __expf(-Aexp * softplusf(gates[row * 16 + 4 + h] + dtb)); } }
        __syncthreads();
#pragma unroll 1
        for (int tok = 0; tok < 4; ++tok) {
            const LAS float* q = QKVZ + (tok * 4 + 0) * 128 + 32 * kq; const LAS float* k = QKVZ + (tok * 4 + 1) * 128 + 32 * kq;
            const float v = QKVZ[(tok * 4 + 2) * 128 + dv], beta = SC[tok * 2], eg = SC[tok * 2 + 1];
            float kk[32]; float rp = 0.f;
#pragma unroll
            for (int i = 0; i < 32; ++i) { kk[i] = k[i]; rp += kk[i] * S[i]; }
            rp += __shfl_xor(rp, 16); rp += __shfl_xor(rp, 32);
            const float coef = beta * (v - eg * rp);
            float op = 0.f;
#pragma unroll
            for (int i = 0; i < 32; ++i) { S[i] = eg * S[i] + kk[i] * coef; op += q[i] * S[i]; }
            op += __shfl_xor(op, 16); op += __shfl_xor(op, 32);
            if (kq == 0) OB[tok * 128 + dv] = op;
        }
        __syncthreads();
        if (wave_ < 4) { const int tok = wave_; const size_t row = (size_t)row0 + t0 + tok;
            const float o0 = OB[tok * 128 + lane_], o1 = OB[tok * 128 + lane_ + 64];
            const float rs = frsq(wave_sum(o0 * o0 + o1 * o1) * (1.f / GDV) + EPS);
            const float z0 = QKVZ[(tok * 4 + 3) * 128 + lane_], z1 = QKVZ[(tok * 4 + 3) * 128 + lane_ + 64];
            bf16* pr = proj + row * IN_DIM + C_ZG + h * 128 + lane_;
            pr[0] = (bf16)f2bf(o0 * rs * gn0 * siluf(z0)); pr[64] = (bf16)f2bf(o1 * rs * gn1 * siluf(z1)); }
    }
#pragma unroll
    for (int i0 = 0; i0 < 32; i0 += 8) { float* sp = Sout + (size_t)(32 * kq + i0) * GDV + dv; asm volatile("" : "+v"(sp));
#pragma unroll
        for (int i = 0; i < 8; ++i) sp[i * GDV] = S[i0 + i]; }
}
__device__ __forceinline__ void mlstm_seq(Frame& F, int l, int h, int row0, int T, const float* C0, const float* n0, const float* m0, float* Cout, float* nout, float* mout) {
    LAS float* L = (LAS float*)(F.lds + RING_OFF);
    LAS float* QK = L;
    LAS float* VO = L + 512;
    LAS float* SC = VO + 1024;
    LAS float* RED = SC + 8;
    LAS float* REDD = RED + 512;
    LAS float* OB = REDD + 4;
    bf16* proj = (bf16*)(F.ws + WS_PROJ);
    const float* gates = (const float*)(F.ws + WS_GATES);
    int tl_ = F.tid; asm volatile("" : "+v"(tl_)); const int tid_ = tl_, lane_ = tid_ & 63, wave_ = __builtin_amdgcn_readfirstlane(tid_ >> 6);
    const int dv = 16 * wave_ + (lane_ & 15), kq = lane_ >> 4;
    const float ib = F.a->in[I_IB][l * MH + h], fb = F.a->in[I_FB][l * MH + h];
    const float mn0 = F.a->in[I_MNORM][(size_t)l * 512 + h * 128 + lane_], mn1 = F.a->in[I_MNORM][(size_t)l * 512 + h * 128 + lane_ + 64];
    float C[16], n[16]; float m = m0 ? m0[0] : 0.f;
    if (C0) {
#pragma unroll
        for (int i0 = 0; i0 < 16; i0 += 8) { const float* sp = C0 + (size_t)(16 * kq + i0) * MDV + dv; asm volatile("" : "+v"(sp));
#pragma unroll
            for (int i = 0; i < 8; ++i) C[i0 + i] = sp[i * MDV]; }
#pragma unroll
        for (int i = 0; i < 16; ++i) n[i] = n0[16 * kq + i];
    } else {
#pragma unroll
        for (int i = 0; i < 16; ++i) { C[i] = 0.f; n[i] = 0.f; }
    }
    for (int t0 = 0; t0 < T; t0 += 4) {
        __syncthreads();
        { const int tok = tid_ >> 7, e = tid_ & 127; const size_t row = (size_t)row0 + t0 + tok; const bf16* pr = proj + row * IN_DIM;
          if (e < 64) QK[(tok * 2 + 0) * 64 + e] = bf2f(pr[C_QM + h * 64 + e]) * 0.125f; else QK[(tok * 2 + 1) * 64 + (e - 64)] = bf2f(pr[C_KM + h * 64 + (e - 64)]);
          VO[(tok * 2 + 0) * 128 + e] = bf2f(pr[C_VM + h * 128 + e]); VO[(tok * 2 + 1) * 128 + e] = bf2f(pr[C_OM + h * 128 + e]);
          if (e == 0) { SC[tok * 2] = gates[row * 16 + 8 + h] + ib; SC[tok * 2 + 1] = -softplusf(-(gates[row * 16 + 12 + h] + fb)); } }
        __syncthreads();
#pragma unroll 1
        for (int tok = 0; tok < 4; ++tok) {
            const LAS float* q = QK + (tok * 2 + 0) * 64 + 16 * kq; const LAS float* k = QK + (tok * 2 + 1) * 64 + 16 * kq;
            const float v = VO[(tok * 2 + 0) * 128 + dv], li = SC[tok * 2], lf = SC[tok * 2 + 1];
            const float mnew = fmaxf(lf + m, li), fd = __expf(lf + m - mnew), iw = __expf(li - mnew); m = mnew;
            float np = 0.f, dp = 0.f; const float iv = iw * v;
#pragma unroll
            for (int i = 0; i < 16; ++i) { const float ki = k[i], qi = q[i]; C[i] = fd * C[i] + ki * iv; n[i] = fd * n[i] + iw * ki; np += qi * C[i]; dp += qi * n[i]; }
            np += __shfl_xor(np, 16); np += __shfl_xor(np, 32); dp += __shfl_xor(dp, 16); dp += __shfl_xor(dp, 32);
            if (kq == 0) OB[tok * 128 + dv] = np * frcp(fmaxf(fabsf(dp), __expf(-m)));
        }
        __syncthreads();
        if (wave_ < 4) { const int tok = wave_; const size_t row = (size_t)row0 + t0 + tok;
            const float o0 = OB[tok * 128 + lane_], o1 = OB[tok * 128 + lane_ + 64];
            const float rs = frsq(wave_sum(o0 * o0 + o1 * o1) * (1.f / MDV) + EPS);
            const float g0 = VO[(tok * 2 + 1) * 128 + lane_], g1 = VO[(tok * 2 + 1) * 128 + lane_ + 64];
            bf16* pr = proj + row * IN_DIM + C_OM + h * 128 + lane_;
            pr[0] = (bf16)f2bf(o0 * rs * mn0 * sigm(g0)); pr[64] = (bf16)f2bf(o1 * rs * mn1 * sigm(g1)); }
    }
#pragma unroll
    for (int i0 = 0; i0 < 16; i0 += 8) { float* sp = Cout + (size_t)(16 * kq + i0) * MDV + dv; asm volatile("" : "+v"(sp));
#pragma unroll
        for (int i = 0; i < 8; ++i) sp[i * MDV] = C[i0 + i]; }
    if (dv == 0) {
#pragma unroll
        for (int i = 0; i < 16; ++i) nout[16 * kq + i] = n[i]; }
    if (tid_ == 0) mout[0] = m;
}
__device__ __forceinline__ void scan_item(Frame& F, int l, int it) {
    if (it < 32) { const int b = it >> 2, h = it & 3; gdn_scan_prompt(F, l, b, h); }
    else if (it < 64) { const int j = it - 32, b = j >> 2, h = j & 3; mlstm_scan_prompt(F, l, b, h); }
    else if (it < 576) { const int j = it - 64, b = j >> 2, h = j & 3; const size_t sidx = ((size_t)l * SB + b) * GH + h;
        gdn_seq(F, l, h, MP + b * ST, ST, F.a->in[I_SS] + sidx * GDK * GDV, F.out + O_SS + sidx * GDK * GDV); }
    else { const int j = it - 576, b = j >> 2, h = j & 3; const size_t sidx = ((size_t)l * SB + b) * MH + h;
        mlstm_seq(F, l, h, MP + b * ST, ST, F.a->in[I_SC] + sidx * MDK * MDV, F.a->in[I_SN] + sidx * MDK, F.a->in[I_SM] + sidx,
                  F.out + O_CS + sidx * MDK * MDV, F.out + O_NS + sidx * MDK, F.out + O_MS + sidx); }
}
__device__ __forceinline__ void mixer_phase(Frame& F, int l) {
#define MX_CNT(g) ((unsigned*)(F.ws + WS_CTL) + CW_SOFT + 64 * l + 48 + (g))
#pragma unroll 1
    for (int g = 0; g < 4; ++g) {
        int gw, gnw, mw, mnw;
        if (g == 0) { gw = F.bid; gnw = 256; mw = F.bid; mnw = 256; }
        else { if (F.bid < 64) break; const int w = F.bid - 64; if (w < 128) { gw = w; gnw = 128; mw = -1; mnw = 1; } else { gw = -1; gnw = 1; mw = w - 128; mnw = 64; } }
        prep_group(F, l, g, gw, gnw, mw, mnw);
        if (g == 0) fe_sample_items(F, l);
        pg8::soft_arrive(MX_CNT(g));
    }
    wait_count(MX_CNT(0), 256u, F.wave);
    if (F.bid < 64) scan_item(F, l, F.bid);
    else {
        for (int it = F.bid; it < 1088; it += 192) scan_item(F, l, it);
    }
#undef MX_CNT
}

__device__ __forceinline__ void sample_merge(Frame& F, int wk, int nwk) {
    int tq_ = threadIdx.x; asm volatile("" : "+v"(tq_)); const int lane_ = tq_ & 63, wave_ = __builtin_amdgcn_readfirstlane(tq_ >> 6);
    const float* slab = (const float*)(F.ws + WS_GATES); const bf16* proj = (const bf16*)(F.ws + WS_PROJ); bf16* xn = (bf16*)(F.ws + WS_XN);
    for (int sr = wave_ * nwk + wk; sr < MS; sr += NWAVES * nwk) {
        const int pmr = sr >> 8, r = sr & 255; const size_t row = (size_t)MP + sr;
#pragma unroll
        for (int pn = 0; pn < 4; ++pn) { const int t = pmr * 4 + pn;
            const f32x4 p1 = *(const GAS f32x4*)(slab + (size_t)(2 * t) * 65536 + r * 256 + 4 * lane_), p2 = *(const GAS f32x4*)(slab + (size_t)(2 * t + 1) * 65536 + r * 256 + 4 * lane_);
            const v2u gg = *(const GAS v2u*)(proj + row * IN_DIM + C_GG + pn * 256 + 4 * lane_), gm = *(const GAS v2u*)(proj + row * IN_DIM + C_GM + pn * 256 + 4 * lane_);
            v2u o; o.x = pk2(pg8::bf_lo(gg.x) * p1[0] + pg8::bf_lo(gm.x) * p2[0], pg8::bf_hi(gg.x) * p1[1] + pg8::bf_hi(gm.x) * p2[1]);
            o.y = pk2(pg8::bf_lo(gg.y) * p1[2] + pg8::bf_lo(gm.y) * p2[2], pg8::bf_hi(gg.y) * p1[3] + pg8::bf_hi(gm.y) * p2[3]);
            *(GAS v2u*)(xn + row * DM + pn * 256 + 4 * lane_) = o; }
    }
}

constexpr int PH_PER_LAYER = 9, N_PHASES = 1 + DEPTH * PH_PER_LAYER + 1;
__global__ void __launch_bounds__(NWAVES * 64, 2) trunk_fwd(Args args) {
    extern __shared__ __attribute__((aligned(16))) unsigned char lds[];
    Frame F;
    F.lds = (LAS unsigned char*)lds;
    F.tid = threadIdx.x; F.lane = F.tid & 63; F.wave = __builtin_amdgcn_readfirstlane(F.tid >> 6);
    F.G = gridDim.x; F.bid = blockIdx.x;
    { auto ap = (const __attribute__((address_space(4))) Args*)__builtin_amdgcn_kernarg_segment_ptr(); F.a = ap; F.ws = ap->ws; F.out = ap->out; }
    volatile LAS unsigned* MISC = (volatile LAS unsigned*)(F.lds + MISC_OFF);
    for (int u = F.tid; u < (LDS_BYTES - LDSCTL_OFF) / 4; u += NWAVES * 64) ((LAS unsigned*)(F.lds + LDSCTL_OFF))[u] = 0u;
    __syncthreads();
    gu32* ctl = (gu32*)(F.ws + WS_CTL);
    XcdBarrier bar; bar.bar = (unsigned*)(ctl + CW_BAR); bar.x = 0; bar.st = nullptr;
    const int lo = args.ph_lo, hi = args.ph_hi;
    if (hi - lo > 1) bar = xcd_barrier_post((unsigned*)(ctl + CW_BAR), MISC + 8);
#pragma unroll 1
    for (int p = lo; p < hi; ++p) {
        { auto ap = (const __attribute__((address_space(4))) Args*)__builtin_amdgcn_kernarg_segment_ptr(); asm volatile("" : "+s"(ap)); F.a = ap; F.ws = ap->ws; F.out = ap->out;
          int t_ = threadIdx.x; asm volatile("" : "+v"(t_)); F.tid = t_; F.lane = t_ & 63; F.wave = __builtin_amdgcn_readfirstlane(t_ >> 6);
          int g_ = gridDim.x, b_ = blockIdx.x; asm volatile("" : "+s"(g_), "+s"(b_)); F.G = g_; F.bid = b_; }
        bf16* xn = (bf16*)(F.ws + WS_XN); bf16* proj = (bf16*)(F.ws + WS_PROJ);
        float* xo = F.out + O_Y;
        if (p == N_PHASES - 1) final_norm_phase(F, NP_DN, dn_slab(F, DEPTH - 1), MP);
        else {
            int l = 0, k = 0;
            if (p == 0) { p0_prologue(F, 0, 0, F.G); __syncthreads(); p0_prologue(F, 1, 0, F.G); __syncthreads(); }
            else { l = (p - 1) / PH_PER_LAYER; k = (p - 1) % PH_PER_LAYER; if (k == 0 && l == 0) continue; }
            bf16* xb1 = (bf16*)(F.ws + WS_XB1);
            if (k == 0 || k == 6) { if (p == 0) norm_phase(F, 0, F.a->in[I_NMIX], xn, 0); else continue; }
            else if (k == 1) {
                unsigned* cnt = (unsigned*)(ctl + CW_SOFT + 64 * l + 16);
                if (l > 0 && F.bid >= 240) { norm_phase(F, 1, F.a->in[I_NMIX] + (size_t)l * DM, xn, NP_DN, dn_slab(F, l - 1), MP, M, F.bid - 240, 16); pg8::soft_arrive(cnt); }
                typedef pg8::Gemm<DM, DM, DM> GT; typedef pg8::StaticOrder<M, NPAD, DM> SO; GT g{xn, w_ptr(F, l, WO_WIN)}; SO S; S.init(F.G, F.bid); if (l > 0) { S.cnt = cnt; S.need = 16u; }
                pg8::EpiProj E{proj, (float*)(F.ws + WS_GATES), (bf16*)(F.ws + WS_HALO)};
                pg8::gemm_phase<GT, pg8::EpiProj, SO, true, true>(F.lds + RING_OFF, g, S, E, F.tid);
            }
            else if (k == 2) mixer_phase(F, l);
            else if (k == 3) continue;
            else if (k == 4) {
                typedef pg8::Gemm<IN_DIM, DM, DM> GT; typedef pg8::SplitSrcOrder SO; GT g{proj + C_ZG, w_ptr(F, l, WO_WBG)}; SO S; S.init(F.G, F.bid);
                pg8::EpiMerge E{proj + C_GG, proj + C_GM, xn, (float*)(F.ws + WS_GATES)};
                pg8::gemm_phase<GT, pg8::EpiMerge, SO, true, true>(F.lds + RING_OFF, g, S, E, F.tid);
            }
            else if (k == 5) {
                unsigned* cnt = (unsigned*)(ctl + CW_SOFT + 64 * l);
                { sample_merge(F, F.bid, 256); pg8::soft_arrive(cnt); }
                typedef pg8::Gemm<DM, DM, DM> GT; typedef pg8::SplitOrder<DM, NP_WO> SO; GT g{xn, w_ptr(F, l, WO_WOUT)}; SO S; S.init(F.G, F.bid); S.cnt = cnt; S.need = 256u;
                const bool first = (l == 0);
                pg8::EpiResidN<1> E{first ? F.a->in[I_XP] : xo, first ? F.a->in[I_XS] : xo + (size_t)MP * DM, xo, dn_slab(F, l), xb1, F.a->in[I_NMLP] + (size_t)l * DM,
                                    (unsigned*)(F.ws + WS_XSLOT) + (size_t)(2 * l) * 65536, (unsigned*)(ctl + CW_X + (2 * l) * 4096), F.lds + XLDS_OFF};
                pg8::gemm_phase<GT, pg8::EpiResidN<1>, SO, true, true>(F.lds + RING_OFF, g, S, E, F.tid);
            }
            else if (k == 8) {
                typedef pg8::Gemm<FF, FF, FF> GT; typedef pg8::SplitOrder<FF, NP_DN> SO; GT g{proj, w_ptr(F, l, WO_WDN)}; SO S; S.init(F.G, F.bid);
                unsigned* xs = (unsigned*)(F.ws + WS_XSLOT) + (size_t)(2 * l + 1) * 65536; unsigned* xc = (unsigned*)(ctl + CW_X + (2 * l + 1) * 4096);
                if (l + 1 < DEPTH) {
                    pg8::EpiResidN<1> E{xo, xo + (size_t)MP * DM, xo, dn_slab(F, l), xn, F.a->in[I_NMIX] + (size_t)(l + 1) * DM, xs, xc, F.lds + XLDS_OFF};
                    pg8::gemm_phase<GT, pg8::EpiResidN<1>, SO, true, true>(F.lds + RING_OFF, g, S, E, F.tid);
                } else {
                    pg8::EpiResidN<2> E{xo, xo + (size_t)MP * DM, xo, dn_slab(F, l), xn, F.a->in[I_NFIN], xs, xc, F.lds + XLDS_OFF};
                    pg8::gemm_phase<GT, pg8::EpiResidN<2>, SO, true, true>(F.lds + RING_OFF, g, S, E, F.tid);
                }
            }
            else {
                unsigned* cnt = (unsigned*)(ctl + CW_SOFT + 64 * l + 32);
                if (F.bid >= 192) { norm_phase(F, l == 0 ? 2 : 1, F.a->in[I_NMLP] + (size_t)l * DM, xb1, NP_WO, dn_slab(F, l), MP, M, F.bid - 192, 64); pg8::soft_arrive(cnt); }
                typedef pg8::Gemm<DM, DM, DM> GT; typedef pg8::StaticOrder<M, FF, DM> SO; GT g{xb1, w_ptr(F, l, WO_WUP)}; SO S; S.init(F.G, F.bid); S.cnt = cnt; S.need = 64u;
                pg8::EpiRelu2 E{proj, (float*)(F.ws + WS_SLAB)};
                pg8::gemm_phase<GT, pg8::EpiRelu2, SO, true, true>(F.lds + RING_OFF, g, S, E, F.tid);
            }
        }
        if (p + 1 < hi) xcd_barrier(bar);
    }
}

extern "C" void kernel_launch(void* const* d_in, const int* in_sizes, int n_in, void* d_out, int out_size, void* d_ws, size_t ws_size, hipStream_t stream) {
    static int grid = 0;
    if (grid == 0) {
        if (n_in != 23 || in_sizes[0] != MP * DM || (size_t)out_size != O_END || ws_size < WS_END) { fprintf(stderr, "kernel_launch: unexpected shapes (n_in %d, out %d, ws %zu); nothing launched\n", n_in, out_size, ws_size); grid = -1; return; }
        int dev = 0, cus = 0, per_cu = 0;
        if (hipGetDevice(&dev) != hipSuccess || hipDeviceGetAttribute(&cus, hipDeviceAttributeMultiprocessorCount, dev) != hipSuccess) { grid = -1; return; }
        if (hipFuncSetAttribute((const void*)trunk_fwd, hipFuncAttributeMaxDynamicSharedMemorySize, LDS_BYTES) != hipSuccess) { grid = -1; return; }
        if (hipOccupancyMaxActiveBlocksPerMultiprocessor(&per_cu, (const void*)trunk_fwd, NWAVES * 64, LDS_BYTES) != hipSuccess || per_cu < 1) { fprintf(stderr, "kernel_launch: occupancy query says %d\n", per_cu); grid = -1; (void)hipGetLastError(); return; }
        (void)hipGetLastError();
        if (cus < 128) { fprintf(stderr, "kernel_launch: built for a 256-CU device (%d CUs)\n", cus); grid = -1; return; }
        if (cus != 256) { fprintf(stderr, "kernel_launch: the mixer phase's role split is built for 256 CUs (got %d)\n", cus); grid = -1; return; }
        grid = cus & ~3;
    }
    if (grid < 0) return;
    (void)hipMemsetAsync((char*)d_ws + WS_CTL, 0, CTL_ZERO_BYTES, stream);
    Args a{};
    for (int i = 0; i < 23; ++i) a.in[i] = (const float*)d_in[i];
    a.out = (float*)d_out; a.ws = (unsigned char*)d_ws;
#if MK_ONE_LAUNCH
    a.ph_lo = 0; a.ph_hi = N_PHASES;
    hipLaunchKernelGGL(trunk_fwd, dim3(grid), dim3(NWAVES * 64), LDS_BYTES, stream, a);
#else
    for (int p = 0; p < N_PHASES; ++p) { a.ph_lo = p; a.ph_hi = p + 1; hipLaunchKernelGGL(trunk_fwd, dim3(grid), dim3(NWAVES * 64), LDS_BYTES, stream, a); }
#endif
}
```

```cpp
#include <hip/hip_runtime.h>
#include <cstdio>
#include <cstdint>

#ifndef MK_ONE_LAUNCH
#define MK_ONE_LAUNCH 1
#endif

namespace pg8 {
#define PG8_LAS __attribute__((address_space(3)))
typedef unsigned short bf16_t;
typedef short bf16x8 __attribute__((ext_vector_type(8)));
typedef float f32x4 __attribute__((ext_vector_type(4)));
typedef unsigned u32x4 __attribute__((ext_vector_type(4)));
constexpr int BM = 256, BK = 64, HALF = 128, HTB = HALF * BK * 2  , STAGE_BYTES = 8 * HTB, NXCD = 8, WGM = 2;

__host__ __device__ __forceinline__ int lds_byte(int r, int c) { const int st = (r >> 4) * 2 + (c >> 5), rr = r & 15, cc = c & 31, ob = rr * 64 + cc * 2; return st * 1024 + (ob ^ (((ob >> 9) & 1) << 5)); }
__host__ __device__ __forceinline__ void stage_rc(int b, int& R, int& C) { const int st = b / 1024, sb = b % 1024, swz = sb ^ (((sb >> 9) & 1) << 5); R = (st >> 1) * 16 + swz / 64; C = (st & 1) * 32 + (swz % 64) / 2; }
__host__ __device__ __forceinline__ int perm32(int rho) { const int n = rho >> 4, i = rho & 15; return 8 * (i >> 2) + 4 * n + (i & 3); }

struct Unit { int pm, pn, k0, nt, part; };
template <int LDA_, int LDB_, int K_> struct Gemm { static constexpr int lda = LDA_, ldb = LDB_, K = K_; const bf16_t* A; const bf16_t* Bt; };

template <int M_, int N_, int K_> struct StaticOrder {
    static constexpr int nM = M_ / BM, nN = N_ / BM, nwg = nM * nN;
    int G, c; unsigned* cnt; unsigned need;
    __host__ __device__ void init(int G_, int c_) { G = G_; c = c_; cnt = nullptr; need = 0u; }
    __host__ __device__ static void tile_of(int wgid, Unit& u) {
        { const int q = nwg / NXCD, r = nwg % NXCD, xcd = wgid % NXCD, off = wgid / NXCD; wgid = (xcd < r ? xcd * (q + 1) : r * (q + 1) + (xcd - r) * q) + off; }
        const int nig = WGM * nN, gid = wgid / nig, fm = gid * WGM, gsz = (nM - fm) < WGM ? (nM - fm) : WGM;
        u.pm = fm + ((wgid % nig) % gsz); u.pn = (wgid % nig) / gsz;
    }
    __host__ __device__ bool next(int i, Unit& u) const {
        const long L = (long)i * G + c; if (L >= nwg) return false;
        tile_of((int)L, u); u.k0 = 0; u.nt = K_ / BK; u.part = -1; return true;
    }
    __device__ __forceinline__ void a_ready(const Unit& u) const {
        if (cnt == nullptr || u.pm < 64) return;
        if (threadIdx.x < 64) { unsigned sp = 0;
            while ((unsigned)__builtin_amdgcn_readfirstlane(__hip_atomic_load(cnt, __ATOMIC_RELAXED, __HIP_MEMORY_SCOPE_AGENT)) < need) { __builtin_amdgcn_s_sleep(2); if (++sp > (1u << 22)) break; }
            __builtin_amdgcn_fence(__ATOMIC_ACQUIRE, "agent");
            asm volatile("s_waitcnt vmcnt(0)" ::: "memory"); }
        asm volatile("" ::: "memory"); __builtin_amdgcn_s_barrier(); asm volatile("" ::: "memory");
    }
    __device__ __forceinline__ void done(const Unit&) const {}
};
__device__ __forceinline__ void soft_arrive(unsigned* cnt) {
    asm volatile("s_waitcnt vmcnt(0)" ::: "memory");
    __syncthreads();
    if (threadIdx.x == 0) { __builtin_amdgcn_fence(__ATOMIC_RELEASE, "agent"); asm volatile("s_waitcnt vmcnt(0)" ::: "memory");
        (void)__hip_atomic_fetch_add(cnt, 1u, __ATOMIC_RELAXED, __HIP_MEMORY_SCOPE_AGENT); }
}
template <int K_, int NP_, int N_ = 1024> struct SplitOrder {
    typedef StaticOrder<16384, N_, K_> Base;
    static constexpr int NTS = N_ / BM, NSUB = 2 * NTS * NP_;
    int G, c; unsigned* cnt; unsigned need;
    __host__ __device__ void init(int G_, int c_) { G = G_; c = c_; cnt = nullptr; need = 0u; }
    __host__ __device__ bool next(int i, Unit& u) const {
        const long L = (long)i * G + c; if (L >= Base::nwg + NSUB) return false;
        if (L < Base::nwg) { Base::tile_of((int)L, u); u.k0 = 0; u.nt = K_ / BK; u.part = -1; return true; }
        const int s = (int)L - Base::nwg, t = s / NP_, p = s % NP_;
        u.pm = 64 + t / NTS; u.pn = t % NTS; u.k0 = p * (K_ / NP_); u.nt = K_ / NP_ / BK; u.part = s; return true;
    }
    __device__ __forceinline__ void a_ready(const Unit& u) const {
        if (cnt == nullptr || u.part < 0) return;
        if (threadIdx.x < 64) { unsigned sp = 0;
            while ((unsigned)__builtin_amdgcn_readfirstlane(__hip_atomic_load(cnt, __ATOMIC_RELAXED, __HIP_MEMORY_SCOPE_AGENT)) < need) { __builtin_amdgcn_s_sleep(2); if (++sp > (1u << 22)) break; }
            __builtin_amdgcn_fence(__ATOMIC_ACQUIRE, "agent");
            asm volatile("s_waitcnt vmcnt(0)" ::: "memory"); }
        asm volatile("" ::: "memory"); __builtin_amdgcn_s_barrier(); asm volatile("" ::: "memory");
    }
    __device__ __forceinline__ void done(const Unit&) const {}
};
struct SplitSrcOrder {
    typedef StaticOrder<16384, 1024, 1024> Base;
    int G, c;
    __host__ __device__ void init(int G_, int c_) { G = G_; c = c_; }
    __host__ __device__ bool next(int i, Unit& u) const {
        const long L = (long)i * G + c; if (L >= Base::nwg + 32) return false;
        if (L < Base::nwg) { Base::tile_of((int)L, u); u.k0 = 0; u.nt = 16; u.part = -1; return true; }
        const int s = (int)L - Base::nwg, t = s >> 2;
        u.pm = 64 + (t >> 2); u.pn = t & 3; u.k0 = 256 * (s & 3); u.nt = 4; u.part = s; return true;
    }
    __device__ __forceinline__ void a_ready(const Unit&) const {}
    __device__ __forceinline__ void done(const Unit&) const {}
};

typedef __bf16 bf16x2_hw __attribute__((ext_vector_type(2)));
__device__ __forceinline__ unsigned cvt_pk_bf16(float lo, float hi) { const bf16x2_hw v = {(__bf16)lo, (__bf16)hi}; return __builtin_bit_cast(unsigned, v); }
__device__ __forceinline__ void st16_wt(void* p, u32x4 v) { asm volatile("global_store_dwordx4 %0, %1, off sc1\n\ts_nop 1" :: "v"(p), "v"(v) : "memory"); }
__device__ __forceinline__ void st16_wt(void* p, f32x4 v) { st16_wt(p, __builtin_bit_cast(u32x4, v)); }
__device__ __forceinline__ float bf_lo(unsigned w) { return __builtin_bit_cast(float, w << 16); }
__device__ __forceinline__ float bf_hi(unsigned w) { return __builtin_bit_cast(float, w & 0xffff0000u); }
__device__ __forceinline__ float sigmoidf_(float x) { return __builtin_amdgcn_rcpf(1.0f + __expf(-x)); }

constexpr int MP_ROWS = 16384;
constexpr int LDP = 5648;

struct EpiProj {
    static constexpr bool PERM = true, AFTER_DRAIN = false, HAS_INIT = false; static constexpr int MIDT = 0;
    bf16_t* P; float* gates; bf16_t* halo;
    __device__ __forceinline__ void operator()(const f32x4 (&acc)[2][2][4][2], const Unit& u, int wr, int wc, int fr, int fq) const {
        const int row0 = u.pm * BM + wr * 64 + fr;
        if (u.pn < 22) {
            const int col0 = u.pn * BM + wc * 32 + 8 * fq;
#pragma unroll
            for (int ai = 0; ai < 2; ++ai)
#pragma unroll
                for (int m = 0; m < 4; ++m) { const int r = row0 + ai * HALF + m * 16; bf16_t* rowp = P + (size_t)r * LDP + col0;
#pragma unroll
                    for (int bj = 0; bj < 2; ++bj) { f32x4 v0 = acc[ai][bj][m][0], v1 = acc[ai][bj][m][1];
                        if (u.pn >= 14) {
#pragma unroll
                            for (int e = 0; e < 4; ++e) { v0[e] = sigmoidf_(v0[e]); v1[e] = sigmoidf_(v1[e]); } }
                        u32x4 w; w.x = cvt_pk_bf16(v0[0], v0[1]); w.y = cvt_pk_bf16(v0[2], v0[3]); w.z = cvt_pk_bf16(v1[0], v1[1]); w.w = cvt_pk_bf16(v1[2], v1[3]);
                        *(u32x4*)(rowp + bj * HALF) = w;
                        if (m == 3 && u.pn < 6 && fr >= 13 && r < MP_ROWS) *(u32x4*)(halo + ((size_t)(r >> 6) * 3 + (fr - 13)) * 1536 + col0 + bj * HALF) = w; } }
        } else if (wc == 0 && fq < 2) {
#pragma unroll
            for (int ai = 0; ai < 2; ++ai)
#pragma unroll
                for (int m = 0; m < 4; ++m) { const int r = row0 + ai * HALF + m * 16; float* gp = gates + (size_t)r * 16 + 8 * fq;
                    *(f32x4*)gp = acc[ai][0][m][0]; *(f32x4*)(gp + 4) = acc[ai][0][m][1]; }
        }
    }
};
struct EpiRelu2 {
    static constexpr bool PERM = true, AFTER_DRAIN = false, HAS_INIT = false; static constexpr int MIDT = 0;
    bf16_t* H; float* slab;
    __device__ __forceinline__ void operator()(const f32x4 (&acc)[2][2][4][2], const Unit& u, int wr, int wc, int fr, int fq) const {
        if (u.part >= 0) {
            float* sb = slab + (size_t)u.part * 65536 + (size_t)(wr * 64 + fr) * 256 + wc * 32 + 8 * fq;
#pragma unroll
            for (int ai = 0; ai < 2; ++ai)
#pragma unroll
                for (int m = 0; m < 4; ++m)
#pragma unroll
                    for (int bj = 0; bj < 2; ++bj)
#pragma unroll
                        for (int n = 0; n < 2; ++n) *(f32x4*)(sb + (ai * HALF + m * 16) * 256 + bj * HALF + 4 * n) = acc[ai][bj][m][n];
            return;
        }
        const int row0 = u.pm * BM + wr * 64 + fr, col0 = u.pn * BM + wc * 32 + 8 * fq;
#pragma unroll
        for (int ai = 0; ai < 2; ++ai)
#pragma unroll
            for (int m = 0; m < 4; ++m) { bf16_t* rowp = H + (size_t)(row0 + ai * HALF + m * 16) * 4096 + col0;
#pragma unroll
                for (int bj = 0; bj < 2; ++bj) { f32x4 v0 = acc[ai][bj][m][0], v1 = acc[ai][bj][m][1];
#pragma unroll
                    for (int e = 0; e < 4; ++e) { const float a = fmaxf(v0[e], 0.f), b = fmaxf(v1[e], 0.f); v0[e] = a * a; v1[e] = b * b; }
                    u32x4 w; w.x = cvt_pk_bf16(v0[0], v0[1]); w.y = cvt_pk_bf16(v0[2], v0[3]); w.z = cvt_pk_bf16(v1[0], v1[1]); w.w = cvt_pk_bf16(v1[2], v1[3]);
                    *(u32x4*)(rowp + bj * HALF) = w; } }
    }
};
struct EpiResid {
    static constexpr bool PERM = false, AFTER_DRAIN = false, HAS_INIT = false; static constexpr int MIDT = 0;
    const float* in_p; const float* in_s; float* out; float* slab;
    __device__ __forceinline__ void operator()(const f32x4 (&acc)[2][2][4][2], const Unit& u, int wr, int wc, int fr, int fq) const {
        if (u.part >= 0) {
            float* sb = slab + (size_t)u.part * 65536 + (size_t)(wr * 64 + fr) * 256 + wc * 32 + 4 * fq;
#pragma unroll
            for (int ai = 0; ai < 2; ++ai)
#pragma unroll
                for (int m = 0; m < 4; ++m)
#pragma unroll
                    for (int bj = 0; bj < 2; ++bj)
#pragma unroll
                        for (int n = 0; n < 2; ++n) *(f32x4*)(sb + (ai * HALF + m * 16) * 256 + bj * HALF + n * 16) = acc[ai][bj][m][n];
            return;
        }
        const int row0 = u.pm * BM + wr * 64 + fr, col0 = u.pn * BM + wc * 32 + 4 * fq;
        const float* inb = (u.pm < 64) ? in_p + (size_t)row0 * 1024 : in_s + (size_t)(row0 - MP_ROWS) * 1024;
        float* outb = out + (size_t)row0 * 1024;
#pragma unroll
        for (int ai = 0; ai < 2; ++ai)
#pragma unroll
            for (int m = 0; m < 4; ++m) { const size_t off = (size_t)(ai * HALF + m * 16) * 1024 + col0;
#pragma unroll
                for (int bj = 0; bj < 2; ++bj)
#pragma unroll
                    for (int n = 0; n < 2; ++n) { const f32x4 xi = *(const f32x4*)(inb + off + bj * HALF + n * 16); *(f32x4*)(outb + off + bj * HALF + n * 16) = xi + acc[ai][bj][m][n]; } }
    }
};
template <int FUSE> struct EpiResidN {
    static constexpr bool PERM = false, AFTER_DRAIN = false, HAS_INIT = true;  static constexpr int MIDT = 0;
    const float* in_p; const float* in_s; float* out; float* slab; bf16_t* xn; const float* w; unsigned* slots; unsigned* cnt; PG8_LAS unsigned char* lx;
    __device__ __forceinline__ void init(f32x4 (&acc)[2][2][4][2], const Unit& u, int wr, int wc, int fr, int fq) const {
        if (u.part >= 0) { float z0_ = 0.f; asm volatile("" : "+v"(z0_));
#pragma unroll
            for (int ai = 0; ai < 2; ++ai)
#pragma unroll
                for (int bj = 0; bj < 2; ++bj)
#pragma unroll
                    for (int m = 0; m < 4; ++m)
#pragma unroll
                        for (int n = 0; n < 2; ++n) acc[ai][bj][m][n] = (f32x4){z0_, z0_, z0_, z0_};
            return; }
        const int row0 = u.pm * BM + wr * 64 + fr, col0 = u.pn * BM + wc * 32 + 4 * fq;
        const float* inb = ((u.pm < 64) ? in_p + (size_t)row0 * 1024 : in_s + (size_t)(row0 - MP_ROWS) * 1024) + col0;
#pragma unroll
        for (int ai = 0; ai < 2; ++ai)
#pragma unroll
            for (int m = 0; m < 4; ++m)
#pragma unroll
                for (int bj = 0; bj < 2; ++bj)
#pragma unroll
                    for (int n = 0; n < 2; ++n) acc[ai][bj][m][n] = *(const f32x4*)(inb + (size_t)(ai * HALF + m * 16) * 1024 + bj * HALF + n * 16);
    }
    __device__ __forceinline__ void operator()(f32x4 (&acc)[2][2][4][2], const Unit& u, int wr, int wc, int fr, int fq) const {
        if (u.part >= 0) {
            float* sb = slab + (size_t)u.part * 65536 + (size_t)(wr * 64 + fr) * 256 + wc * 32 + 4 * fq;
#pragma unroll
            for (int ai = 0; ai < 2; ++ai)
#pragma unroll
                for (int m = 0; m < 4; ++m)
#pragma unroll
                    for (int bj = 0; bj < 2; ++bj)
#pragma unroll
                        for (int n = 0; n < 2; ++n) *(f32x4*)(sb + (ai * HALF + m * 16) * 256 + bj * HALF + n * 16) = acc[ai][bj][m][n];
            return;
        }
        const int row0 = u.pm * BM + wr * 64 + fr, col0 = u.pn * BM + wc * 32 + 4 * fq;
        float* outb = out + (size_t)row0 * 1024;
        PG8_LAS float* P = (PG8_LAS float*)lx;
        PG8_LAS float* S = (PG8_LAS float*)(lx + 4096);
#pragma unroll
        for (int ai = 0; ai < 2; ++ai)
#pragma unroll
            for (int m = 0; m < 4; ++m) { float q = 0.f;
#pragma unroll
                for (int bj = 0; bj < 2; ++bj)
#pragma unroll
                    for (int n = 0; n < 2; ++n) { const f32x4 xo_ = acc[ai][bj][m][n];
                        if constexpr (FUSE == 1) *(f32x4*)(outb + (size_t)(ai * HALF + m * 16) * 1024 + col0 + bj * HALF + n * 16) = xo_;
                        q += (xo_[0] * xo_[0] + xo_[1] * xo_[1]) + (xo_[2] * xo_[2] + xo_[3] * xo_[3]); }
                q += __shfl_xor(q, 16); q += __shfl_xor(q, 32); if (fq == 0) P[(ai * HALF + wr * 64 + m * 16 + fr) * 4 + wc] = q; }
        asm volatile("s_waitcnt lgkmcnt(0)" ::: "memory"); __builtin_amdgcn_s_barrier(); asm volatile("" ::: "memory");
        const int wid = wr * 4 + wc, lane = fq * 16 + fr, row = wid * 32 + (lane & 31);
        unsigned* sl = slots + ((size_t)(u.pm * BM + row) * 4);
        if (lane < 32) { const f32x4 p = *(const PG8_LAS f32x4*)(P + row * 4);
            __hip_atomic_store(sl + u.pn, __builtin_bit_cast(unsigned, (p[0] + p[1]) + (p[2] + p[3])), __ATOMIC_RELAXED, __HIP_MEMORY_SCOPE_AGENT); }
        asm volatile("s_waitcnt vmcnt(0)" ::: "memory");
        if (lane == 0) (void)__hip_atomic_fetch_add(cnt + 64 * u.pm, 1u, __ATOMIC_RELAXED, __HIP_MEMORY_SCOPE_AGENT);
        if (wid == 0) { unsigned sp = 0;
            while ((unsigned)__builtin_amdgcn_readfirstlane(__hip_atomic_load(cnt + 64 * u.pm, __ATOMIC_RELAXED, __HIP_MEMORY_SCOPE_AGENT)) < 32u) { __builtin_amdgcn_s_sleep(2); if (++sp > (1u << 22)) break; }
            __builtin_amdgcn_fence(__ATOMIC_ACQUIRE, "agent"); }
        asm volatile("s_waitcnt vmcnt(0) lgkmcnt(0)" ::: "memory"); __builtin_amdgcn_s_barrier(); asm volatile("" ::: "memory");
        if (lane < 32) { float t = 0.f;
#pragma unroll
            for (int k = 0; k < 4; ++k) t += __builtin_bit_cast(float, __hip_atomic_load(sl + k, __ATOMIC_RELAXED, __HIP_MEMORY_SCOPE_AGENT));
            S[row] = __builtin_amdgcn_rsqf(t * (1.0f / 1024.0f) + 1e-6f); }
        asm volatile("s_waitcnt lgkmcnt(0)" ::: "memory"); __builtin_amdgcn_s_barrier(); asm volatile("" ::: "memory");
        f32x4 wv[2][2];
#pragma unroll
        for (int bj = 0; bj < 2; ++bj)
#pragma unroll
            for (int n = 0; n < 2; ++n) wv[bj][n] = *(const f32x4*)(w + col0 + bj * HALF + n * 16);
        typedef unsigned u32x2_ __attribute__((ext_vector_type(2)));
        bf16_t* xb = xn + (size_t)row0 * 1024 + col0;
#pragma unroll
        for (int ai = 0; ai < 2; ++ai)
#pragma unroll
            for (int m = 0; m < 4; ++m) { const float rs = S[ai * HALF + wr * 64 + m * 16 + fr];
#pragma unroll
                for (int bj = 0; bj < 2; ++bj)
#pragma unroll
                    for (int n = 0; n < 2; ++n) { const f32x4 v = acc[ai][bj][m][n] * rs * wv[bj][n];
                        if constexpr (FUSE == 1) { u32x2_ o; o.x = cvt_pk_bf16(v[0], v[1]); o.y = cvt_pk_bf16(v[2], v[3]);
                            *(u32x2_*)(xb + (size_t)(ai * HALF + m * 16) * 1024 + bj * HALF + n * 16) = o; }
                        else *(f32x4*)(outb + (size_t)(ai * HALF + m * 16) * 1024 + col0 + bj * HALF + n * 16) = v; } }
    }
};
struct EpiMerge {
    static constexpr bool PERM = true, AFTER_DRAIN = false, HAS_INIT = false; static constexpr int MIDT = 8;
    const bf16_t* GG; const bf16_t* GM; bf16_t* O; float* slab;
    __device__ __forceinline__ void mid(f32x4 (&acc)[2][2][4][2], const Unit& u, int wr, int wc, int fr, int fq) const {
        int z_ = 0; asm volatile("" : "+v"(z_));
        const int row0 = u.pm * BM + wr * 64 + fr + z_, col0 = u.pn * BM + wc * 32 + 8 * fq;
#pragma unroll
        for (int ai = 0; ai < 2; ++ai)
#pragma unroll
            for (int m = 0; m < 4; ++m) { const size_t ro = (size_t)(row0 + ai * HALF + m * 16) * LDP + col0;
#pragma unroll
                for (int bj = 0; bj < 2; ++bj) { const u32x4 a = *(const u32x4*)(GG + ro + bj * HALF), b = *(const u32x4*)(GM + ro + bj * HALF);
                    float ga[8] = {bf_lo(a.x), bf_hi(a.x), bf_lo(a.y), bf_hi(a.y), bf_lo(a.z), bf_hi(a.z), bf_lo(a.w), bf_hi(a.w)};
                    float gb[8] = {bf_lo(b.x), bf_hi(b.x), bf_lo(b.y), bf_hi(b.y), bf_lo(b.z), bf_hi(b.z), bf_lo(b.w), bf_hi(b.w)};
#pragma unroll
                    for (int e = 0; e < 8; ++e) { const float r = ga[e] * __builtin_amdgcn_rcpf(fmaxf(gb[e], 1e-30f));
                        if (e < 4) acc[ai][bj][m][0][e] *= r; else acc[ai][bj][m][1][e - 4] *= r; } }
                if (m == 3) asm volatile("" ::: "memory"); }
    }
    __device__ __forceinline__ void operator()(const f32x4 (&acc)[2][2][4][2], const Unit& u, int wr, int wc, int fr, int fq) const {
        if (u.part >= 0) {
            float* sb = slab + (size_t)u.part * 65536 + (size_t)(wr * 64 + fr) * 256 + wc * 32 + 8 * fq;
#pragma unroll
            for (int ai = 0; ai < 2; ++ai)
#pragma unroll
                for (int m = 0; m < 4; ++m)
#pragma unroll
                    for (int bj = 0; bj < 2; ++bj)
#pragma unroll
                        for (int n = 0; n < 2; ++n) *(f32x4*)(sb + (ai * HALF + m * 16) * 256 + bj * HALF + 4 * n) = acc[ai][bj][m][n];
            return;
        }
        const int row0 = u.pm * BM + wr * 64 + fr, col0 = u.pn * BM + wc * 32 + 8 * fq;
#pragma unroll
        for (int ai = 0; ai < 2; ++ai)
#pragma unroll
            for (int m = 0; m < 4; ++m) { const int r = row0 + ai * HALF + m * 16;
#pragma unroll
                for (int bj = 0; bj < 2; ++bj) { const u32x4 b = *(const u32x4*)(GM + (size_t)r * LDP + col0 + bj * HALF); const f32x4 v0 = acc[ai][bj][m][0], v1 = acc[ai][bj][m][1];
                    const float gb[8] = {bf_lo(b.x), bf_hi(b.x), bf_lo(b.y), bf_hi(b.y), bf_lo(b.z), bf_hi(b.z), bf_lo(b.w), bf_hi(b.w)};
                    float o[8];
#pragma unroll
                    for (int e = 0; e < 8; ++e) o[e] = (e < 4 ? v0[e] : v1[e - 4]) * fmaxf(gb[e], 1e-30f);
                    u32x4 w; w.x = cvt_pk_bf16(o[0], o[1]); w.y = cvt_pk_bf16(o[2], o[3]); w.z = cvt_pk_bf16(o[4], o[5]); w.w = cvt_pk_bf16(o[6], o[7]);
                    *(u32x4*)(O + (size_t)r * 1024 + col0 + bj * HALF) = w; } }
    }
};

struct NoPre { __device__ __forceinline__ void operator()() const {} };
template <class GemmT, class Epi, class Sched, bool ALIGN_EPI = false, bool SP2 = false, class Pre = NoPre>
__device__ __forceinline__ void gemm_phase(PG8_LAS unsigned char* lds, const GemmT g, const Sched& S, const Epi& E, const int tid, const Pre pre = Pre()) {
    const int wid = __builtin_amdgcn_readfirstlane(tid >> 6), lane = tid & 63, wr = wid >> 2, wc = wid & 3, fr = lane & 15, fq = lane >> 4;
    constexpr int K = GemmT::K;
    unsigned voffA[2], voffB[2];
#pragma unroll
    for (int i = 0; i < 2; ++i) { int R, C; stage_rc(tid * 16 + i * 8192, R, C); const int Rb = Epi::PERM ? ((R & ~31) + perm32(R & 31)) : R;
        voffA[i] = (unsigned)(R * GemmT::lda + C) * 2u; voffB[i] = (unsigned)(Rb * GemmT::ldb + C) * 2u; }
    constexpr size_t kstep = (size_t)(BK * 2);
    constexpr size_t hstepA = (size_t)HALF * GemmT::lda * 2, hstepB = (size_t)HALF * GemmT::ldb * 2;
    constexpr size_t tstepA = 2 * hstepA, tstepB = 2 * hstepB;
    const unsigned ldsw = (unsigned)wid * 1024u;
    const int aoff = lds_byte(wr * 64 + fr, fq * 8), boff = lds_byte(wc * 32 + fr, fq * 8);
#define PG8_SA(b, h) (((b) * 2 + (h)) * HTB)
#define PG8_SB(b, h) ((4 + (b) * 2 + (h)) * HTB)
#define PG8_STAGE(bufoff, gbase, voff) do { _Pragma("unroll") for (int _i = 0; _i < 2; ++_i) \
        __builtin_amdgcn_global_load_lds((const unsigned*)((const char*)(gbase) + (voff)[_i]), (PG8_LAS unsigned*)(lds + (bufoff) + ldsw + _i * 8192), 16, 0, 0); } while (0)
#define PG8_LDA(dst, b, h) do { _Pragma("unroll") for (int m = 0; m < 4; ++m) _Pragma("unroll") for (int k = 0; k < 2; ++k) dst[m][k] = *(const PG8_LAS bf16x8*)(lds + PG8_SA(b, h) + aoff + m * 2048 + k * 1024); } while (0)
#define PG8_LDB(dst, b, h) do { _Pragma("unroll") for (int n = 0; n < 2; ++n) _Pragma("unroll") for (int k = 0; k < 2; ++k) dst[n][k] = *(const PG8_LAS bf16x8*)(lds + PG8_SB(b, h) + boff + n * 2048 + k * 1024); } while (0)
#define PG8_MMA(ai, bj, At, Bt) do { __builtin_amdgcn_s_setprio(1); _Pragma("unroll") for (int m = 0; m < 4; ++m) _Pragma("unroll") for (int n = 0; n < 2; ++n) _Pragma("unroll") for (int k = 0; k < 2; ++k) \
        acc[ai][bj][m][n] = __builtin_amdgcn_mfma_f32_16x16x32_bf16(Bt[n][k], At[m][k], acc[ai][bj][m][n], 0, 0, 0); __builtin_amdgcn_s_setprio(0); } while (0)
#define PG8_WAIT_V(n) asm volatile("s_waitcnt vmcnt(" #n ")" ::: "memory")
#define PG8_WAIT_L(n) asm volatile("s_waitcnt lgkmcnt(" #n ")" ::: "memory")
#define PG8_BAR __builtin_amdgcn_s_barrier()
#define PG8_SCHED __builtin_amdgcn_sched_barrier(0)
    Unit cur, nxt; int ui = 0;
    if (!S.next(0, cur)) return;
    f32x4 acc[2][2][4][2];
    if constexpr (Epi::HAS_INIT) E.init(acc, cur, wr, wc, fr, fq);
    else {
#pragma unroll
    for (int a = 0; a < 2; ++a)
#pragma unroll
        for (int b = 0; b < 2; ++b)
#pragma unroll
            for (int m = 0; m < 4; ++m)
#pragma unroll
                for (int n = 0; n < 2; ++n) acc[a][b][m][n] = (f32x4){0.f, 0.f, 0.f, 0.f};
    }
    bf16x8 At[4][2], B0[2][2], B1[2][2];
    const char* cA = (const char*)g.A + (size_t)cur.pm * tstepA + (size_t)cur.k0 * 2; const char* cB = (const char*)g.Bt + (size_t)cur.pn * tstepB + (size_t)cur.k0 * 2;
    pre();
    S.a_ready(cur);
    if constexpr (SP2) {
        PG8_STAGE(PG8_SB(0, 0), cB, voffB); PG8_STAGE(PG8_SB(0, 1), cB + hstepB, voffB); PG8_STAGE(PG8_SA(0, 0), cA, voffA); PG8_STAGE(PG8_SA(0, 1), cA + hstepA, voffA);
        if (wr == 1) PG8_BAR;
        PG8_WAIT_V(2); PG8_BAR;
        PG8_STAGE(PG8_SB(1, 0), cB + kstep, voffB); PG8_STAGE(PG8_SA(1, 0), cA + kstep, voffA); PG8_STAGE(PG8_SB(1, 1), cB + hstepB + kstep, voffB);
        PG8_WAIT_V(6); PG8_BAR;
    } else {
        PG8_STAGE(PG8_SB(0, 0), cB, voffB); PG8_STAGE(PG8_SA(0, 0), cA, voffA); PG8_STAGE(PG8_SB(0, 1), cB + hstepB, voffB); PG8_STAGE(PG8_SA(0, 1), cA + hstepA, voffA);
        if (wr == 1) PG8_BAR;
        PG8_WAIT_V(4); PG8_BAR;
        PG8_STAGE(PG8_SB(1, 0), cB + kstep, voffB); PG8_STAGE(PG8_SA(1, 0), cA + kstep, voffA); PG8_STAGE(PG8_SB(1, 1), cB + hstepB + kstep, voffB);
        PG8_WAIT_V(6); PG8_BAR;
    }
    for (;;) {
        const bool has_next = S.next(ui + 1, nxt);
        const char* nA = has_next ? (const char*)g.A + (size_t)nxt.pm * tstepA + (size_t)nxt.k0 * 2 : cA; const char* nB = has_next ? (const char*)g.Bt + (size_t)nxt.pn * tstepB + (size_t)nxt.k0 * 2 : cB;
        const int nt = cur.nt;
#pragma unroll 1
        for (int t = 0; t < nt; t += 2) {
            if constexpr (Epi::MIDT > 0) { if (t == Epi::MIDT) E.mid(acc, cur, wr, wc, fr, fq); }
            const bool last = (t == nt - 2);
            const char* a1 = cA + (size_t)(t + 1) * kstep;
            const char* a2 = last ? nA : cA + (size_t)(t + 2) * kstep; const char* b2 = last ? nB : cB + (size_t)(t + 2) * kstep;
            const char* a3 = a2 + kstep; const char* b3 = b2 + kstep;
            if (last && has_next) S.a_ready(nxt);
            if constexpr (SP2) {
            PG8_LDB(B0, 0, 0); PG8_LDB(B1, 0, 1); PG8_SCHED; PG8_LDA(At, 0, 0); PG8_STAGE(PG8_SA(1, 1), a1 + hstepA, voffA);
            PG8_WAIT_V(8); PG8_WAIT_L(0); PG8_BAR; PG8_MMA(0, 0, At, B0); PG8_MMA(0, 1, At, B1); PG8_BAR; PG8_SCHED;
            PG8_LDA(At, 0, 1); PG8_STAGE(PG8_SB(0, 0), b2, voffB); PG8_STAGE(PG8_SB(0, 1), b2 + hstepB, voffB); PG8_STAGE(PG8_SA(0, 0), a2, voffA);
            PG8_WAIT_V(8); PG8_WAIT_L(0); PG8_BAR; PG8_MMA(1, 0, At, B0); PG8_MMA(1, 1, At, B1); PG8_BAR; PG8_SCHED;
            PG8_LDB(B0, 1, 0); PG8_LDB(B1, 1, 1); PG8_SCHED; PG8_LDA(At, 1, 0); PG8_STAGE(PG8_SA(0, 1), a2 + hstepA, voffA);
            PG8_WAIT_V(8); PG8_WAIT_L(0); PG8_BAR; PG8_MMA(0, 0, At, B0); PG8_MMA(0, 1, At, B1); PG8_BAR; PG8_SCHED;
            PG8_LDA(At, 1, 1); PG8_STAGE(PG8_SB(1, 0), b3, voffB); PG8_STAGE(PG8_SB(1, 1), b3 + hstepB, voffB); PG8_STAGE(PG8_SA(1, 0), a3, voffA);
            PG8_WAIT_V(8); PG8_WAIT_L(0); PG8_BAR; PG8_MMA(1, 0, At, B0); PG8_MMA(1, 1, At, B1); PG8_BAR; PG8_SCHED;
            } else {
            PG8_LDB(B0, 0, 0); PG8_SCHED; PG8_LDA(At, 0, 0); PG8_STAGE(PG8_SA(1, 1), a1 + hstepA, voffA);
            PG8_WAIT_L(8); PG8_BAR; PG8_WAIT_L(0); PG8_MMA(0, 0, At, B0); PG8_BAR; PG8_SCHED;
            PG8_LDB(B1, 0, 1); PG8_STAGE(PG8_SB(0, 0), b2, voffB);
            PG8_BAR; PG8_WAIT_L(0); PG8_MMA(0, 1, At, B1); PG8_BAR;
            PG8_LDA(At, 0, 1); PG8_STAGE(PG8_SA(0, 0), a2, voffA);
            PG8_BAR; PG8_WAIT_L(0); PG8_MMA(1, 0, At, B0); PG8_BAR; PG8_SCHED;
            PG8_STAGE(PG8_SB(0, 1), b2 + hstepB, voffB);
            PG8_WAIT_V(6); PG8_BAR; PG8_MMA(1, 1, At, B1); PG8_BAR;
            PG8_LDB(B0, 1, 0); PG8_SCHED; PG8_LDA(At, 1, 0); PG8_STAGE(PG8_SA(0, 1), a2 + hstepA, voffA);
            PG8_WAIT_L(8); PG8_BAR; PG8_WAIT_L(0); PG8_MMA(0, 0, At, B0); PG8_BAR; PG8_SCHED;
            PG8_LDB(B1, 1, 1); PG8_STAGE(PG8_SB(1, 0), b3, voffB);
            PG8_BAR; PG8_WAIT_L(0); PG8_MMA(0, 1, At, B1); PG8_BAR;
            PG8_LDA(At, 1, 1); PG8_STAGE(PG8_SA(1, 0), a3, voffA);
            PG8_BAR; PG8_WAIT_L(0); PG8_MMA(1, 0, At, B0); PG8_BAR; PG8_SCHED;
            PG8_STAGE(PG8_SB(1, 1), b3 + hstepB, voffB);
            PG8_WAIT_V(6); PG8_BAR; PG8_MMA(1, 1, At, B1); PG8_BAR;
            }
        }
        if constexpr (ALIGN_EPI) { if (wr == 0) PG8_BAR; }
        if constexpr (!Epi::AFTER_DRAIN) { E(acc, cur, wr, wc, fr, fq); S.done(cur); }
        if (!has_next) break;
        if constexpr (Epi::HAS_INIT) E.init(acc, nxt, wr, wc, fr, fq);
        else {
#pragma unroll
        for (int a = 0; a < 2; ++a)
#pragma unroll
            for (int b = 0; b < 2; ++b)
#pragma unroll
                for (int m = 0; m < 4; ++m)
#pragma unroll
                    for (int n = 0; n < 2; ++n) acc[a][b][m][n] = (f32x4){0.f, 0.f, 0.f, 0.f};
        }
        cur = nxt; cA = nA; cB = nB; ++ui;
        if constexpr (ALIGN_EPI) { if (wr == 1) PG8_BAR; }
    }
    PG8_WAIT_V(0);
    if constexpr (!ALIGN_EPI) { if (wr == 0) PG8_BAR; }
    PG8_BAR;
    if constexpr (Epi::AFTER_DRAIN) { E.fused(acc, cur, wr, wc, fr, fq, lds, wid, lane); S.done(cur); }
#undef PG8_SA
#undef PG8_SB
#undef PG8_STAGE
#undef PG8_LDA
#undef PG8_LDB
#undef PG8_MMA
#undef PG8_WAIT_V
#undef PG8_WAIT_L
#undef PG8_BAR
#undef PG8_SCHED
}
}

constexpr int NWAVES = 8;
constexpr int DM = 1024, DEPTH = 2, FF = 4096;
constexpr int PB = 8, PT = 2048, SB = 128, ST = 4;
constexpr int MP = PB * PT, MS = SB * ST, M = MP + MS;
constexpr int IN_DIM = 5648, NPAD = 5888;
constexpr int GH = 4, GDK = 128, GDV = 128, MH = 4, MDK = 64, MDV = 128, CONVC = 1536;
constexpr int C_QG = 0, C_KG = 512, C_VG = 1024, C_QM = 1536, C_KM = 1792, C_VM = 2048, C_ZG = 2560, C_OM = 3072, C_GG = 3584, C_GM = 4608, C_SMALL = 5632;
constexpr float EPS = 1e-6f;
constexpr int NP_WO = 4, NP_DN = 8, NP_UP = 4;
static_assert(pg8::LDP == IN_DIM && pg8::MP_ROWS == MP, "shape constants");

constexpr size_t WS_CTL = 0, CTL_ZERO_BYTES = 1u << 20;
constexpr size_t SZ_WIN = (size_t)NPAD * DM * 2, SZ_WB = (size_t)DM * 512 * 2, SZ_WOUT = (size_t)DM * DM * 2, SZ_WUP = (size_t)FF * DM * 2, SZ_WDN = (size_t)DM * FF * 2;
constexpr size_t SZ_WLAYER = SZ_WIN + 2 * SZ_WB + SZ_WOUT + SZ_WUP + SZ_WDN;
constexpr size_t WS_W = CTL_ZERO_BYTES;
constexpr size_t WO_WIN = 0, WO_WBG = SZ_WIN, WO_WBM = WO_WBG + SZ_WB, WO_WOUT = WO_WBM + SZ_WB, WO_WUP = WO_WOUT + SZ_WOUT, WO_WDN = WO_WUP + SZ_WUP;
constexpr size_t WS_XN = WS_W + DEPTH * SZ_WLAYER;
constexpr size_t WS_PROJ = WS_XN + (size_t)M * DM * 2;
constexpr size_t WS_SLAB = WS_PROJ + (size_t)140 * 1024 * 1024;
static_assert((size_t)M * FF * 2 <= (size_t)140 * 1024 * 1024 && WS_SLAB + (size_t)128 * 65536 * 4 <= WS_PROJ + (size_t)M * IN_DIM * 2, "slab region");
constexpr size_t WS_GATES = WS_PROJ + (size_t)M * IN_DIM * 2;
constexpr size_t WS_HALO = WS_GATES + (size_t)M * 16 * 4;
constexpr size_t WS_GSCAL = WS_HALO + (size_t)256 * 3 * CONVC * 2;
constexpr size_t WS_MSCAL = WS_GSCAL + 4096;
constexpr size_t WS_XSLOT = WS_MSCAL + (size_t)1024 * 256 * 4;
constexpr size_t WS_END = WS_XSLOT + (size_t)4 * 16384 * 4 * 4;
constexpr size_t WS_XB1 = WS_PROJ + (size_t)140 * 1024 * 1024;
static_assert((size_t)16896 * 4096 * 2 <= (size_t)140 * 1024 * 1024 && WS_XB1 + (size_t)16896 * 1024 * 2 <= WS_PROJ + (size_t)16384 * 5648 * 2, "XB1 placement: after hidden, before the sample rows of proj (whose gate columns the w_out phase still reads)");
constexpr int XLDS_OFF = 131072;
static_assert(WS_XN % 256 == 0 && WS_PROJ % 256 == 0 && WS_GATES % 256 == 0 && WS_HALO % 256 == 0, "alignment");
static_assert(WS_END <= 305083472ull, "workspace budget (sum of inputs)");
constexpr size_t O_Y = 0, O_CONVP = (size_t)M * DM, O_SP = O_CONVP + (size_t)DEPTH * PB * 3 * CONVC, O_CP = O_SP + (size_t)DEPTH * PB * GH * GDK * GDV,
                 O_NP = O_CP + (size_t)DEPTH * PB * MH * MDK * MDV, O_MP = O_NP + (size_t)DEPTH * PB * MH * MDK, O_CONVS = O_MP + (size_t)DEPTH * PB * MH,
                 O_SS = O_CONVS + (size_t)DEPTH * SB * 3 * CONVC, O_CS = O_SS + (size_t)DEPTH * SB * GH * GDK * GDV, O_NS = O_CS + (size_t)DEPTH * SB * MH * MDK * MDV,
                 O_MS = O_NS + (size_t)DEPTH * SB * MH * MDK, O_END = O_MS + (size_t)DEPTH * SB * MH;
static_assert(O_END == 45364288ull, "output size");
constexpr int CW_BAR = 4096, CW_SOFT = 8192, CW_X = 16384;

constexpr int RING_OFF = 0, RING_BYTES = 143360;
constexpr int LDSCTL_OFF = RING_BYTES, MISC_OFF = LDSCTL_OFF + 320;
constexpr int LDS_BYTES = 147456;

#define GAS __attribute__((address_space(1)))
#define LAS __attribute__((address_space(3)))
typedef unsigned short bf16;
typedef unsigned v4u __attribute__((ext_vector_type(4)));
typedef unsigned v2u __attribute__((ext_vector_type(2)));
typedef float f32x4 __attribute__((ext_vector_type(4)));
typedef GAS unsigned gu32;
#define RLX_AGENT __ATOMIC_RELAXED, __HIP_MEMORY_SCOPE_AGENT
#define LDS_WAIT() asm volatile("s_waitcnt lgkmcnt(0)" ::: "memory")
__device__ __forceinline__ unsigned f2bf(float f) { return (unsigned)__builtin_bit_cast(unsigned short, (__bf16)f); }
__device__ __forceinline__ unsigned pk2(float lo, float hi) { return pg8::cvt_pk_bf16(lo, hi); }
__device__ __forceinline__ float bf2f(bf16 h) { return __builtin_bit_cast(float, (unsigned)h << 16); }
__device__ __forceinline__ float wave_sum(float v) {
#pragma unroll
    for (int o = 1; o < 64; o <<= 1) v += __shfl_xor(v, o);
    return v;
}
template <int CTRL> __device__ __forceinline__ float dpp_mov(float x) { return __builtin_bit_cast(float, __builtin_amdgcn_update_dpp(0, __builtin_bit_cast(int, x), CTRL, 0xf, 0xf, true)); }
__device__ __forceinline__ float row16_sum(float x) {
    x += dpp_mov<0x128>(x); x += dpp_mov<0x124>(x); x += dpp_mov<0x122>(x); x += dpp_mov<0x121>(x); return x;
}
template <int CTRL, int RMASK> __device__ __forceinline__ float dpp_src(float ident, float x) { return __builtin_bit_cast(float, __builtin_amdgcn_update_dpp(__builtin_bit_cast(int, ident), __builtin_bit_cast(int, x), CTRL, RMASK, 0xf, false)); }
__device__ __forceinline__ float wave_scan_add(float x) {
    x += dpp_src<0x111, 0xf>(0.f, x); x += dpp_src<0x112, 0xf>(0.f, x); x += dpp_src<0x114, 0xf>(0.f, x); x += dpp_src<0x118, 0xf>(0.f, x);
    x += dpp_src<0x142, 0xa>(0.f, x); x += dpp_src<0x143, 0xc>(0.f, x); return x;
}
__device__ __forceinline__ float wave_scan_max(float x) {
    const float ni = -__builtin_inff();
    x = fmaxf(x, dpp_src<0x111, 0xf>(ni, x)); x = fmaxf(x, dpp_src<0x112, 0xf>(ni, x)); x = fmaxf(x, dpp_src<0x114, 0xf>(ni, x)); x = fmaxf(x, dpp_src<0x118, 0xf>(ni, x));
    x = fmaxf(x, dpp_src<0x142, 0xa>(ni, x)); x = fmaxf(x, dpp_src<0x143, 0xc>(ni, x)); return x;
}
__device__ __forceinline__ float wave_sum_fast(float x) {
    x = row16_sum(x);
    const int xi = __builtin_bit_cast(int, x);
    return (__builtin_bit_cast(float, __builtin_amdgcn_readlane(xi, 0)) + __builtin_bit_cast(float, __builtin_amdgcn_readlane(xi, 16))) +
           (__builtin_bit_cast(float, __builtin_amdgcn_readlane(xi, 32)) + __builtin_bit_cast(float, __builtin_amdgcn_readlane(xi, 48)));
}
__device__ __forceinline__ float frcp(float x) { return __builtin_amdgcn_rcpf(x); }
__device__ __forceinline__ float frsq(float x) { return __builtin_amdgcn_rsqf(x); }
__device__ __forceinline__ float sigm(float x) { return frcp(1.0f + __expf(-x)); }
__device__ __forceinline__ float siluf(float x) { return x * frcp(1.0f + __expf(-x)); }
__device__ __forceinline__ float softplusf(float x) { return x > 20.f ? x : log1pf(__expf(x)); }

#define XB_TMO      128
#define XB_XCNT(j)  (256  + 64 * (j))
#define XB_XSUB(j)  (1280 + 64 * (j))
#define XB_XGEN(j)  (2304 + 64 * (j))
#define XB_TOP      3328
#define XB_TOPGEN   3392
#define XCD_BAR_WORDS 3456
#define XB_SPIN_CAP (1u << 18)
__device__ __forceinline__ unsigned xb_ld(unsigned* p)              { return __hip_atomic_load(p, __ATOMIC_RELAXED, __HIP_MEMORY_SCOPE_AGENT); }
__device__ __forceinline__ unsigned xb_add(unsigned* p, unsigned v) { return __hip_atomic_fetch_add(p, v, __ATOMIC_RELAXED, __HIP_MEMORY_SCOPE_AGENT); }
__device__ __forceinline__ unsigned xb_xcc_id() { return (unsigned)__builtin_amdgcn_s_getreg((3 << 11) | 20) & 0xFu; }
#define XB_SPIN(cond, bar) do { unsigned _sp = 0; while (cond) { __builtin_amdgcn_s_sleep(1); \
    if ((++_sp & 255u) == 0u) { if (xb_ld(&(bar)[XB_TMO])) break; if (_sp > XB_SPIN_CAP) { atomicAdd(&(bar)[XB_TMO], 1u); break; } } } } while (0)
struct XcdBarrier { unsigned* bar; unsigned x; volatile LAS unsigned* st; };
__device__ __forceinline__ XcdBarrier xcd_barrier_post(unsigned* bar, volatile LAS unsigned* st) {
    XcdBarrier b; b.bar = bar; b.x = xb_xcc_id(); b.st = st;
    if (threadIdx.x == 0) (void)xb_add(&bar[XB_XCNT(b.x)], 1u);
    return b;
}
__device__ __forceinline__ void xcd_barrier_complete(unsigned* bar, unsigned x, unsigned& nloc, unsigned& nx) {
    const unsigned G = gridDim.x * gridDim.y * gridDim.z;
    unsigned sum, cnt, mine, sp = 0u;
    for (;;) {
        sum = 0u; cnt = 0u; mine = 0u;
#pragma unroll
        for (unsigned j = 0; j < 16; ++j) { const unsigned c = xb_ld(&bar[XB_XCNT(j)]); sum += c; cnt += (c > 0u) ? 1u : 0u; mine = (j == x) ? c : mine; }
        if (sum == G) break;
        __builtin_amdgcn_s_sleep(1);
        if ((++sp & 255u) == 0u) { if (xb_ld(&bar[XB_TMO])) break; if (sp > XB_SPIN_CAP) { atomicAdd(&bar[XB_TMO], 1u); break; } }
    }
    nloc = mine > 0u ? mine : 1u; nx = cnt > 0u ? cnt : 1u;
}
template <bool CENSUS = true> __device__ __forceinline__ void xcd_barrier(const XcdBarrier& b) {
    asm volatile("s_waitcnt vmcnt(0)" ::: "memory");
    __syncthreads();
    if (threadIdx.x == 0) {
        unsigned* bar = b.bar; asm volatile("" : "+s"(bar));
        __builtin_amdgcn_s_waitcnt(0);
        unsigned nloc = b.st[0], nx = b.st[1]; unsigned bx = b.x; asm volatile("" : "+s"(bx));
        if (CENSUS) { if (nloc == 0u) { xcd_barrier_complete(bar, bx, nloc, nx); b.st[0] = nloc; b.st[1] = nx; } }
        const unsigned old = xb_add(&bar[XB_XSUB(bx)], 1u);
        const unsigned gen = old / nloc;
        if (old + 1u == (gen + 1u) * nloc) {
            __builtin_amdgcn_fence(__ATOMIC_RELEASE, "agent");
            asm volatile("s_waitcnt vmcnt(0)" ::: "memory");
            const unsigned og = xb_add(&bar[XB_TOP], 1u);
            const unsigned tg = og / nx;
            if (og + 1u == (tg + 1u) * nx) xb_add(&bar[XB_TOPGEN], 1u);
            else XB_SPIN(xb_ld(&bar[XB_TOPGEN]) == tg, bar);
            __builtin_amdgcn_fence(__ATOMIC_ACQUIRE, "agent");
            xb_add(&bar[XB_XGEN(bx)], 1u);
            asm volatile("s_waitcnt vmcnt(0)" ::: "memory");
        } else {
            XB_SPIN(xb_ld(&bar[XB_XGEN(bx)]) == gen, bar);
            __builtin_amdgcn_fence(__ATOMIC_ACQUIRE, "agent");
            asm volatile("s_waitcnt vmcnt(0)" ::: "memory");
        }
    }
    __syncthreads();
}

struct Args { const float* in[23]; float* out; unsigned char* ws; int ph_lo, ph_hi; };
static_assert(sizeof(Args) == 23 * 8 + 8 + 8 + 8, "Args has no padding");
enum { I_XP = 0, I_XS, I_SCONV, I_SS, I_SC, I_SN, I_SM, I_NMIX, I_WIN, I_CONVW, I_ALOG, I_DTB, I_GNORM, I_IB, I_FB, I_MNORM, I_WBG, I_WBM, I_WOUT, I_NMLP, I_WUP, I_WDN, I_NFIN };

struct Frame {
    LAS unsigned char* lds;
    int tid, lane, wave, G, bid;
    const __attribute__((address_space(4))) Args* a;
    unsigned char* ws; float* out;
};
__device__ __forceinline__ bf16* w_ptr(const Frame& F, int l, size_t off) { return (bf16*)(F.ws + WS_W + (size_t)l * SZ_WLAYER + off); }
__device__ __forceinline__ float* dn_slab(const Frame& F, int l) { return (float*)(F.ws + WS_W + (size_t)l * SZ_WLAYER); }
static_assert((size_t)2 * 4 * NP_DN * 65536 * 4 <= WO_WDN, "down slabs fit before w_down");
static_assert((size_t)2 * 4 * NP_WO * 65536 * 4 <= WO_WOUT, "w_out slabs (same place, earlier in the layer) fit before w_out");

__device__ __forceinline__ void p0_transpose_item(const float* W, int ldw, int K, bf16* WT, int nblk, LAS float* scr, int item, int lane) {
    const int kb = item / nblk, nb = item % nblk, k0 = 64 * kb, n0 = 32 * nb;
#pragma unroll 8
    for (int i = 0; i < 32; ++i) { const int kk = 2 * i + (lane >> 5); scr[kk * 33 + (lane & 31)] = W[(size_t)(k0 + kk) * ldw + n0 + (lane & 31)]; }
    LDS_WAIT(); asm volatile("" ::: "memory");
    const int c = lane & 7;
#pragma unroll
    for (int j = 0; j < 4; ++j) { const int n = (lane >> 3) + 8 * j; const LAS float* s = scr + (8 * c) * 33 + n;
        v4u o; o.x = pk2(s[0 * 33], s[1 * 33]); o.y = pk2(s[2 * 33], s[3 * 33]); o.z = pk2(s[4 * 33], s[5 * 33]); o.w = pk2(s[6 * 33], s[7 * 33]);
        *(GAS v4u*)(WT + (size_t)(n0 + n) * K + k0 + 8 * c) = o; }
    LDS_WAIT(); asm volatile("" ::: "memory");
}
__device__ __forceinline__ void p0_prologue(Frame& F, int l, int b0, int nb) {
    int tq_ = threadIdx.x; asm volatile("" : "+v"(tq_)); const int lane_ = tq_ & 63, wave_ = __builtin_amdgcn_readfirstlane(tq_ >> 6);
    LAS float* scr = (LAS float*)(F.lds + RING_OFF + wave_ * 16384);
    const int gw = (F.bid - b0) * NWAVES + wave_, NGW = nb * NWAVES;
    constexpr int I_A = 16 * 48, I_Z = 16 * 16, I_B = 16 * 32, I_OM = 16 * 16, I_C = 16 * 64, I_BG = 8 * 32, I_BM = 8 * 32, I_O = 16 * 32, I_U = 16 * 128, I_D = 64 * 32;
    constexpr int PER_LAYER = I_A + I_Z + I_B + I_OM + I_C + I_BG + I_BM + I_O + I_U + I_D;
    for (int it = gw; it < PER_LAYER; it += NGW) {
        int r = it;
        const float* win = F.a->in[I_WIN] + (size_t)l * DM * IN_DIM;
        bf16* wint = w_ptr(F, l, WO_WIN);
        if (r < I_A) { p0_transpose_item(win + 0, IN_DIM, DM, wint + (size_t)C_QG * DM, 48, scr, r, lane_); continue; } r -= I_A;
        if (r < I_Z) { p0_transpose_item(win + 1536, IN_DIM, DM, wint + (size_t)C_ZG * DM, 16, scr, r, lane_); continue; } r -= I_Z;
        if (r < I_B) { p0_transpose_item(win + 2056, IN_DIM, DM, wint + (size_t)C_QM * DM, 32, scr, r, lane_); continue; } r -= I_B;
        if (r < I_OM) { p0_transpose_item(win + 3080, IN_DIM, DM, wint + (size_t)C_OM * DM, 16, scr, r, lane_); continue; } r -= I_OM;
        if (r < I_C) { p0_transpose_item(win + 3600, IN_DIM, DM, wint + (size_t)C_GG * DM, 64, scr, r, lane_); continue; } r -= I_C;
        if (r < I_BG) { p0_transpose_item(F.a->in[I_WBG] + (size_t)l * 512 * DM, DM, 1024, w_ptr(F, l, WO_WBG), 32, scr, r, lane_); continue; } r -= I_BG;
        if (r < I_BM) { p0_transpose_item(F.a->in[I_WBM] + (size_t)l * 512 * DM, DM, 1024, w_ptr(F, l, WO_WBG) + 512, 32, scr, r, lane_); continue; } r -= I_BM;
        if (r < I_O) { p0_transpose_item(F.a->in[I_WOUT] + (size_t)l * DM * DM, DM, DM, w_ptr(F, l, WO_WOUT), 32, scr, r, lane_); continue; } r -= I_O;
        if (r < I_U) { p0_transpose_item(F.a->in[I_WUP] + (size_t)l * DM * FF, FF, DM, w_ptr(F, l, WO_WUP), 128, scr, r, lane_); continue; } r -= I_U;
        p0_transpose_item(F.a->in[I_WDN] + (size_t)l * FF * DM, DM, FF, w_ptr(F, l, WO_WDN), 32, scr, r, lane_);
    }
    const int gt = (F.bid - b0) * (NWAVES * 64) + tq_, NGT = nb * NWAVES * 64;
    for (int i = gt; i < 16 * DM; i += NGT) {
        const int n = i / DM, k = i % DM;
        const int src = (n < 8) ? 2048 + n : 3592 + (n - 8);
        w_ptr(F, l, WO_WIN)[(size_t)(C_SMALL + n) * DM + k] = (bf16)f2bf(F.a->in[I_WIN][(size_t)l * DM * IN_DIM + (size_t)k * IN_DIM + src]);
    }
    { unsigned zz = 0u; asm volatile("" : "+v"(zz));
      for (int i = gt; i < (NPAD - IN_DIM) * DM / 8; i += NGT) ((GAS v4u*)(w_ptr(F, l, WO_WIN) + (size_t)IN_DIM * DM))[i] = (v4u){zz, zz, zz, zz}; }
}

__device__ __forceinline__ const float* x_row(const Frame& F, int src, int m) {
    if (src == 0 || (src == 2 && m >= MP)) return (m < MP) ? F.a->in[I_XP] + (size_t)m * DM : F.a->in[I_XS] + (size_t)(m - MP) * DM;
    return F.out + O_Y + (size_t)m * DM;
}
__device__ __forceinline__ void st_wt(GAS v4u* p, v4u v) { asm volatile("global_store_dwordx4 %0, %1, off sc1\n\ts_nop 1" :: "v"(p), "v"(v) : "memory"); }
__device__ __forceinline__ void st_wt(GAS v2u* p, v2u v) { asm volatile("global_store_dwordx2 %0, %1, off sc1" :: "v"(p), "v"(v) : "memory"); }
__device__ __forceinline__ void st_wt(float* p, float v) { asm volatile("global_store_dword %0, %1, off sc1" :: "v"(p), "v"(v) : "memory"); }
__device__ __forceinline__ void light_arrive(unsigned* cnt) {
    asm volatile("s_waitcnt vmcnt(0)" ::: "memory");
    __syncthreads();
    if (threadIdx.x == 0) (void)__hip_atomic_fetch_add(cnt, 1u, __ATOMIC_RELAXED, __HIP_MEMORY_SCOPE_AGENT);
}
__device__ __forceinline__ void wait_count(unsigned* cnt, unsigned need, int wave) {
    if (wave == 0) { unsigned sp = 0;
        while ((unsigned)__builtin_amdgcn_readfirstlane(__hip_atomic_load(cnt, __ATOMIC_RELAXED, __HIP_MEMORY_SCOPE_AGENT)) < need) { __builtin_amdgcn_s_sleep(2); if (++sp > (1u << 22)) break; }
        __builtin_amdgcn_fence(__ATOMIC_ACQUIRE, "agent");
        asm volatile("s_waitcnt vmcnt(0)" ::: "memory"); }
    __syncthreads();
}
__device__ __forceinline__ f32x4 slab_sum(const float* slab, int sr, int j, int lane, int np) {
    const float* p = slab + ((size_t)((sr >> 8) * 4 + j) * np * 256 + (sr & 255)) * 256 + 4 * lane;
    f32x4 s = (f32x4){0.f, 0.f, 0.f, 0.f};
    for (int q = 0; q < np; ++q) s += *(const GAS f32x4*)(p + (size_t)q * 65536);
    return s;
}
__device__ __forceinline__ void norm_phase(Frame& F, int src_layer, const float* w, bf16* xn, int np, const float* slab = nullptr, int m0 = 0, int m1 = M, int wk = 0, int nwk = 0) {
    int tq_ = threadIdx.x; asm volatile("" : "+v"(tq_)); const int lane_ = tq_ & 63, wave_ = __builtin_amdgcn_readfirstlane(tq_ >> 6);
    const int NGW = (nwk > 0 ? nwk : F.G) * NWAVES, gw = nwk == 0 ? F.bid * NWAVES + wave_ : NGW - 1 - (wave_ * nwk + wk);
    f32x4 wv[4];
#pragma unroll
    for (int j = 0; j < 4; ++j) wv[j] = ((const f32x4*)w)[lane_ + 64 * j];
    for (int m = m0 + NGW - 1 - gw; m < m1; m += NGW) {
        const GAS f32x4* xr = (const GAS f32x4*)x_row(F, src_layer, m) + lane_;
        f32x4 v[4]; float s = 0.f;
#pragma unroll
        for (int j = 0; j < 4; ++j) v[j] = xr[64 * j];
        if (np > 0 && m >= MP) { GAS f32x4* xo = (GAS f32x4*)(F.out + O_Y + (size_t)m * DM) + lane_;
#pragma unroll
            for (int j = 0; j < 4; ++j) { v[j] += slab_sum(slab, m - MP, j, lane_, np); xo[64 * j] = v[j]; } }
#pragma unroll
        for (int j = 0; j < 4; ++j) s += (v[j].x * v[j].x + v[j].y * v[j].y) + (v[j].z * v[j].z + v[j].w * v[j].w);
        const float r = frsq(wave_sum(s) * (1.f / DM) + EPS);
        GAS v2u* o8 = (GAS v2u*)(xn + (size_t)m * DM) + lane_;
#pragma unroll
        for (int j = 0; j < 4; ++j) { v2u o; o.x = pk2(v[j].x * r * wv[j].x, v[j].y * r * wv[j].y); o.y = pk2(v[j].z * r * wv[j].z, v[j].w * r * wv[j].w); if (nwk > 0) st_wt(o8 + 64 * j, o); else o8[64 * j] = o; }
    }
}
__device__ __forceinline__ void final_norm_phase(Frame& F, int np, const float* slab, int m0 = 0) {
    int tq_ = threadIdx.x; asm volatile("" : "+v"(tq_)); const int lane_ = tq_ & 63, wave_ = __builtin_amdgcn_readfirstlane(tq_ >> 6);
    const int NGW = F.G * NWAVES, gw = m0 == 0 ? F.bid * NWAVES + wave_ : NGW - 1 - (wave_ * F.G + F.bid);
    const float* w = F.a->in[I_NFIN];
    f32x4 wv[4];
#pragma unroll
    for (int j = 0; j < 4; ++j) wv[j] = ((const f32x4*)w)[lane_ + 64 * j];
    for (int m = m0 + NGW - 1 - gw; m < M; m += NGW) {
        GAS f32x4* xr = (GAS f32x4*)(F.out + O_Y + (size_t)m * DM) + lane_;
        f32x4 v[4]; float s = 0.f;
#pragma unroll
        for (int j = 0; j < 4; ++j) v[j] = xr[64 * j];
        if (np > 0 && m >= MP) {
#pragma unroll
            for (int j = 0; j < 4; ++j) v[j] += slab_sum(slab, m - MP, j, lane_, np); }
#pragma unroll
        for (int j = 0; j < 4; ++j) s += (v[j].x * v[j].x + v[j].y * v[j].y) + (v[j].z * v[j].z + v[j].w * v[j].w);
        const float r = frsq(wave_sum(s) * (1.f / DM) + EPS);
#pragma unroll
        for (int j = 0; j < 4; ++j) xr[64 * j] = v[j] * r * wv[j];
    }
}


typedef short bf16x8 __attribute__((ext_vector_type(8)));
__device__ __forceinline__ int pos32(int kk) { return 8 * ((kk & 15) >> 2) + 4 * (kk >> 4) + (kk & 3); }
__device__ __forceinline__ int permk(int k) { return (k & ~31) + pos32(k & 31); }
__device__ __forceinline__ int lperm(int g, int j) { return j < 4 ? 4 * g + j : 16 + 4 * g + (j - 4); }
__device__ __forceinline__ bf16x8 pack_acc2(const f32x4 a, const f32x4 b) {
    v4u w; w.x = pg8::cvt_pk_bf16(a[0], a[1]); w.y = pg8::cvt_pk_bf16(a[2], a[3]); w.z = pg8::cvt_pk_bf16(b[0], b[1]); w.w = pg8::cvt_pk_bf16(b[2], b[3]);
    return __builtin_bit_cast(bf16x8, w);
}
#define MFMA16(a, b, c) __builtin_amdgcn_mfma_f32_16x16x32_bf16((a), (b), (c), 0, 0, 0)
#define SBAR() __builtin_amdgcn_sched_barrier(0)
#define LBAR() do { asm volatile("s_waitcnt lgkmcnt(0)" ::: "memory"); __builtin_amdgcn_s_barrier(); asm volatile("" ::: "memory"); } while (0)
constexpr size_t XN_WBUF = 0, XN_QKBUF = (size_t)1024 * 64 * 128 * 2, XN_PBUF = XN_QKBUF + (size_t)1024 * 64 * 64 * 2;
static_assert(XN_PBUF + (size_t)1024 * 64 * 64 * 2 <= (size_t)M * DM * 2, "prep buffers fit the XN region");

struct GdnIn { v4u rw[6], rz[2], rh; float gb, ga; };
struct GdnConst { float w0, w1, w2, w3, aexp, dtb; };
__device__ __forceinline__ void gdn_prep_load(Frame& F, int grp, int h, GdnIn& R) {
    const bf16* proj = (const bf16*)(F.ws + WS_PROJ); const bf16* halo = (const bf16*)(F.ws + WS_HALO); const float* gates = (const float*)(F.ws + WS_GATES);
    int tl = F.tid; asm volatile("" : "+v"(tl));
    const int r0 = grp * 64, c = grp & 31;
#pragma unroll
    for (int k = 0; k < 6; ++k) { const int q = tl + 512 * k, j = q / 48, rem = q - 48 * j; R.rw[k] = *(const GAS v4u*)(proj + (size_t)(r0 + j) * IN_DIM + (rem >> 4) * 512 + h * 128 + (rem & 15) * 8); }
#pragma unroll
    for (int k = 0; k < 2; ++k) { const int q = tl + 512 * k; R.rz[k] = *(const GAS v4u*)(proj + (size_t)(r0 + (q >> 4)) * IN_DIM + C_ZG + h * 128 + (q & 15) * 8); }
    { const int th = tl < 144 ? tl : 0, j = th / 48, rem = th - 48 * j, gp = grp > 0 ? grp - 1 : 0;
      R.rh = *(const GAS v4u*)(halo + ((size_t)gp * 3 + j) * CONVC + (rem >> 4) * 512 + h * 128 + (rem & 15) * 8);
      if (c == 0) { unsigned zz = 0u; asm volatile("" : "+v"(zz)); R.rh = (v4u){zz, zz, zz, zz}; } }
    { const int t6 = tl & 63; R.gb = gates[(size_t)(r0 + t6) * 16 + h]; R.ga = gates[(size_t)(r0 + t6) * 16 + 4 + h]; }
}
__device__ __forceinline__ void gdn_prep_item(Frame& F, int l, int grp, int h, GdnIn& R, const GdnConst& K, int nxt) {
    LAS unsigned char* L = F.lds + RING_OFF;
    LAS bf16* XPB = (LAS bf16*)L;
    LAS float* AM = (LAS float*)L;
    LAS bf16* WST = (LAS bf16*)(L + 16384);
    LAS bf16* QKS = (LAS bf16*)(L + 32768);
    constexpr int PIT = 136;
    LAS bf16* KB = (LAS bf16*)(L + 51456);
    LAS bf16* QB = (LAS bf16*)(L + 51456 + 17408);
    LAS bf16* VB = (LAS bf16*)(L + 51456 + 2 * 17408);
    LAS bf16* ZB = (LAS bf16*)(L + 51456 + 3 * 17408);
    LAS float* SC = (LAS float*)(L + 51456 + 4 * 17408);
    bf16* proj = (bf16*)(F.ws + WS_PROJ);
    const bf16* halo = (const bf16*)(F.ws + WS_HALO);
    const float* gates = (const float*)(F.ws + WS_GATES);
    const float* cw = F.a->in[I_CONVW] + (size_t)l * 4 * CONVC;
    const int r0 = grp * 64, c = grp & 31, item = grp * 4 + h;
    bf16* Wg = (bf16*)(F.ws + WS_XN + XN_WBUF) + (size_t)item * 8192;
    bf16* QKg = (bf16*)(F.ws + WS_XN + XN_QKBUF) + (size_t)item * 4096;
    LBAR();
    int tl = F.tid; asm volatile("" : "+v"(tl));
    {
#pragma unroll
        for (int k = 0; k < 6; ++k) { const int q = tl + 512 * k, j = q / 48, rem = q - 48 * j; *(LAS v4u*)(XPB + (j + 3) * 384 + (rem >> 4) * 128 + (rem & 15) * 8) = R.rw[k]; }
#pragma unroll
        for (int k = 0; k < 2; ++k) { const int q = tl + 512 * k; *(LAS v4u*)(ZB + (q >> 4) * PIT + (q & 15) * 8) = R.rz[k]; }
        if (tl < 144) { const int j = tl / 48, rem = tl - 48 * j; *(LAS v4u*)(XPB + j * 384 + (rem >> 4) * 128 + (rem & 15) * 8) = R.rh; }
        if (tl < 64) { SC[tl] = sigm(R.gb); SC[64 + tl] = -K.aexp * softplusf(R.ga + K.dtb); }
    }
    asm volatile("" ::: "memory");
    if (nxt >= 0) gdn_prep_load(F, nxt >> 2, nxt & 3, R);
    LBAR();
    {    {
        tl = F.tid; asm volatile("" : "+v"(tl));
        if (tl < 384) {
            const int s = tl >> 7, e = tl & 127;
            const float w0 = K.w0, w1 = K.w1, w2 = K.w2, w3 = K.w3;
            LAS bf16* dst = (s == 0 ? QB : s == 1 ? KB : VB) + e;
            const LAS bf16* src = XPB + tl;
            float x0 = bf2f(src[0]), x1 = bf2f(src[384]), x2 = bf2f(src[768]);
#pragma unroll 16
            for (int t = 0; t < 64; ++t) { const float x3 = bf2f(src[(t + 3) * 384]);
                const float a = ((x0 * w0 + x1 * w1) + (x2 * w2 + x3 * w3));
                dst[t * PIT] = (bf16)f2bf(siluf(a)); x0 = x1; x1 = x2; x2 = x3; }
        }
        if (c == 31) { float* cp = F.out + O_CONVP + ((size_t)l * PB + (grp >> 5)) * 3 * CONVC;
            for (int q = tl; q < 3 * 384; q += NWAVES * 64) { const int j = q / 384, x = q % 384; cp[(size_t)j * CONVC + (x >> 7) * 512 + h * 128 + (x & 127)] = bf2f(XPB[(64 + j) * 384 + x]); } }
        if (tl >= 448) {
            const int lane_ = tl & 63; const float x = wave_scan_add(SC[64 + lane_]);
            SC[128 + lane_] = x; SC[192 + lane_] = __expf(x);
        }
    }
    LBAR();
    {
        tl = F.tid; asm volatile("" : "+v"(tl));
        if (tl < 128) { const int t = tl & 63, wh = tl >> 6; const LAS bf16* row = (wh ? KB : QB) + t * PIT; float ss = 0.f;
#pragma unroll
            for (int k8 = 0; k8 < 16; ++k8) { const v4u w = *(const LAS v4u*)(row + 8 * k8);
                ss += (pg8::bf_lo(w.x) * pg8::bf_lo(w.x) + pg8::bf_hi(w.x) * pg8::bf_hi(w.x)) + (pg8::bf_lo(w.y) * pg8::bf_lo(w.y) + pg8::bf_hi(w.y) * pg8::bf_hi(w.y))
                    + (pg8::bf_lo(w.z) * pg8::bf_lo(w.z) + pg8::bf_hi(w.z) * pg8::bf_hi(w.z)) + (pg8::bf_lo(w.w) * pg8::bf_lo(w.w) + pg8::bf_hi(w.w) * pg8::bf_hi(w.w)); }
            SC[256 + tl] = frsq(ss + EPS) * (wh ? 1.0f : 0.08838834764831845f); }
    }
    LBAR();
    }
    {    {
        tl = F.tid; asm volatile("" : "+v"(tl)); const int lane_ = tl & 63, wave_ = __builtin_amdgcn_readfirstlane(tl >> 6);
        const int sel = wave_ >> 2, ti = wave_ & 3, fr = lane_ & 15, g = lane_ >> 4;
        const LAS bf16* X = sel ? QB : KB;
        for (int tj = 0; tj < 4; ++tj) {
            f32x4 acc = (f32x4){0.f, 0.f, 0.f, 0.f};
            if (tj <= ti) {
#pragma unroll
                for (int s = 0; s < 4; ++s) { const bf16x8 a = *(const LAS bf16x8*)(X + (16 * ti + fr) * PIT + 32 * s + 8 * g), bq = *(const LAS bf16x8*)(KB + (16 * tj + fr) * PIT + 32 * s + 8 * g);
                    acc = MFMA16(a, bq, acc); }
            }
            const int j = 16 * tj + fr; const float gcj = SC[128 + j], rkj = SC[320 + j];
#pragma unroll
            for (int r = 0; r < 4; ++r) { const int i = 16 * ti + 4 * g + r; const float dec = __expf(fminf(SC[128 + i] - gcj, 0.f)) * rkj;
                if (sel == 0) AM[i * 64 + j] = (j < i) ? SC[i] * SC[320 + i] * acc[r] * dec : 0.f;
                else QKS[i * 64 + permk(j)] = (bf16)f2bf((j <= i) ? SC[256 + i] * acc[r] * dec : 0.f); }
        }
    }
    LBAR();
    }
    const float gcL = SC[128 + 63];
    tl = F.tid; asm volatile("" : "+v"(tl));
    st_wt((GAS v4u*)(QKg + tl * 8), *(const LAS v4u*)(QKS + tl * 8));
    LAS float* DINV = (LAS float*)(L + 40960);
    if (tl < 64) {
        const int bb = tl >> 4, j = tl & 15; const LAS float* Ab = AM + (16 * bb) * 64 + 16 * bb; float t[16];
#pragma unroll
        for (int i = 0; i < 16; ++i) { float a0 = (i == j) ? 1.f : 0.f, a1 = 0.f;
#pragma unroll
            for (int k4 = 0; k4 < (i + 3) / 4; ++k4) { const f32x4 av = *(const LAS f32x4*)(Ab + i * 64 + 4 * k4);
#pragma unroll
                for (int e = 0; e < 4; ++e) if (4 * k4 + e < i) { if (e & 1) a1 -= av[e] * t[4 * k4 + e]; else a0 -= av[e] * t[4 * k4 + e]; } }
            t[i] = a0 + a1; DINV[(bb * 16 + i) * 16 + j] = t[i]; }
    } else {
        const int t2 = tl - 64;
#pragma unroll 1
        for (int q0 = t2; q0 < 3072; q0 += 448) { const int ty = q0 >> 10, q = q0 & 1023;
            if (ty == 0) { const int t = q >> 4, ch = q & 15, s = ch >> 2, gq = ch & 3; const float e = SC[192 + t] * SC[256 + t];
                const v2u a = *(const LAS v2u*)(QB + t * PIT + 32 * s + 4 * gq), b2 = *(const LAS v2u*)(QB + t * PIT + 32 * s + 16 + 4 * gq);
                v4u o; o.x = pk2(pg8::bf_lo(a.x) * e, pg8::bf_hi(a.x) * e); o.y = pk2(pg8::bf_lo(a.y) * e, pg8::bf_hi(a.y) * e); o.z = pk2(pg8::bf_lo(b2.x) * e, pg8::bf_hi(b2.x) * e); o.w = pk2(pg8::bf_lo(b2.y) * e, pg8::bf_hi(b2.y) * e);
                st_wt((GAS v4u*)(proj + (size_t)(r0 + t) * IN_DIM + C_QG + h * 128 + ch * 8), o);
            } else if (ty == 1) { const int dk = q >> 3, ch = q & 7, s = ch >> 2, gq = ch & 3; float v[8];
#pragma unroll
                for (int e = 0; e < 8; ++e) { const int tok = 32 * s + lperm(gq, e); v[e] = bf2f(KB[tok * PIT + dk]) * __expf(fminf(gcL - SC[128 + tok], 0.f)) * SC[320 + tok]; }
                v4u o; o.x = pk2(v[0], v[1]); o.y = pk2(v[2], v[3]); o.z = pk2(v[4], v[5]); o.w = pk2(v[6], v[7]);
                st_wt((GAS v4u*)(proj + (size_t)(r0 + (dk >> 1)) * IN_DIM + C_KG + h * 128 + (dk & 1) * 64 + ch * 8), o);
            } else { const int cp2 = q & 7, gq = (q >> 3) & 3, m = (q >> 5) & 3, w = q >> 7; unsigned short zv[8];
#pragma unroll
                for (int e = 0; e < 8; ++e) zv[e] = ZB[(16 * m + 4 * gq + (e & 3)) * PIT + 16 * w + 2 * cp2 + (e >> 2)];
                v4u o; o.x = zv[0] | ((unsigned)zv[1] << 16); o.y = zv[2] | ((unsigned)zv[3] << 16); o.z = zv[4] | ((unsigned)zv[5] << 16); o.w = zv[6] | ((unsigned)zv[7] << 16);
                st_wt((GAS v4u*)(proj + (size_t)(r0 + (w * 4 + m) * 2 + (gq >> 1)) * IN_DIM + C_ZG + h * 128 + (gq & 1) * 64 + cp2 * 8), o); }
        }
        if (t2 == 0) st_wt((float*)(F.ws + WS_GSCAL) + item, __expf(gcL));
    }
    LBAR();
    {
        tl = F.tid; asm volatile("" : "+v"(tl));
        const int lane_ = tl & 63, wave_ = __builtin_amdgcn_readfirstlane(tl >> 6), ci = lane_ & 15, gq = lane_ >> 4;
#pragma unroll
        for (int nn = 0; nn < 2; ++nn) {
            const int nt = 2 * wave_ + nn, col = 16 * nt + ci; f32x4 X[4];
#pragma unroll
            for (int b = 0; b < 4; ++b) {
                f32x4 y; const f32x4 be = *(const LAS f32x4*)(SC + 16 * b + 4 * gq);
                if (nt < 8) { const f32x4 eg = *(const LAS f32x4*)(SC + 192 + 16 * b + 4 * gq), rk = *(const LAS f32x4*)(SC + 320 + 16 * b + 4 * gq);
#pragma unroll
                    for (int r = 0; r < 4; ++r) y[r] = be[r] * eg[r] * rk[r] * bf2f(KB[(16 * b + 4 * gq + r) * PIT + col]);
                } else {
#pragma unroll
                    for (int r = 0; r < 4; ++r) y[r] = be[r] * bf2f(VB[(16 * b + 4 * gq + r) * PIT + col - 128]); }
#pragma unroll
                for (int bp = 0; bp < b; ++bp) { const f32x4 a = *(const LAS f32x4*)(AM + (16 * b + ci) * 64 + 16 * bp + 4 * gq);
#pragma unroll
                    for (int r = 0; r < 4; ++r) y = __builtin_amdgcn_mfma_f32_16x16x4f32(-a[r], X[bp][r], y, 0, 0, 0); }
                const f32x4 d = *(const LAS f32x4*)(DINV + (b * 16 + ci) * 16 + 4 * gq);
                f32x4 x = (f32x4){0.f, 0.f, 0.f, 0.f};
#pragma unroll
                for (int r = 0; r < 4; ++r) x = __builtin_amdgcn_mfma_f32_16x16x4f32(d[r], y[r], x, 0, 0, 0);
                X[b] = x;
                if (nt < 8) {
#pragma unroll
                    for (int r = 0; r < 4; ++r) WST[(16 * b + 4 * gq + r) * 128 + permk(col)] = (bf16)f2bf(x[r]);
                } else { v2u o; o.x = pk2(x[0], x[1]); o.y = pk2(x[2], x[3]);
                    st_wt((GAS v2u*)(proj + (size_t)(r0 + ((nt - 8) * 4 + b) * 2 + (gq >> 1)) * IN_DIM + C_VG + h * 128 + (gq & 1) * 64 + ci * 4), o); }
            }
        }
    }
    LBAR();
    tl = F.tid; asm volatile("" : "+v"(tl));
#pragma unroll
    for (int k = 0; k < 2; ++k) st_wt((GAS v4u*)(Wg + (tl + 512 * k) * 8), *(const LAS v4u*)(WST + (tl + 512 * k) * 8));
}

__device__ __forceinline__ void gdn_scan_prompt(Frame& F, int l, int b, int h) {
    LAS unsigned char* L = F.lds + RING_OFF;
    constexpr int BUFB = 57344, W_OFF = 0, QD_OFF = 16384, KDT_OFF = 32768, QK_OFF = 49152, RED_OFF = 2 * BUFB, RSV_OFF = RED_OFF + 4096, OGW_OFF = RSV_OFF + 2048;
    static_assert(OGW_OFF + 8 * 2048 <= RING_BYTES, "scan LDS map");
    bf16* proj = (bf16*)(F.ws + WS_PROJ);
    const bf16* Wb = (const bf16*)(F.ws + WS_XN + XN_WBUF);
    const bf16* QKb = (const bf16*)(F.ws + WS_XN + XN_QKBUF);
    const float* gscal = (const float*)(F.ws + WS_GSCAL);
    int tl_ = F.tid; asm volatile("" : "+v"(tl_));
    const int tid = tl_, lane = tid & 63, w = __builtin_amdgcn_readfirstlane(tid >> 6), c = lane & 15, g = lane >> 4;
    const float gn = F.a->in[I_GNORM][l * GDV + 16 * w + c];
    f32x4 S[8];
#pragma unroll
    for (int n = 0; n < 8; ++n) S[n] = (f32x4){0.f, 0.f, 0.f, 0.f};
    const int prow = tid >> 4, pch = tid & 15;
    const int krow = tid >> 3, kch = tid & 7;
    const unsigned dW0 = W_OFF + prow * 256 + ((pch ^ (prow & 15)) << 4), dW1 = dW0 + 32 * 256;
    const unsigned dK0 = KDT_OFF + krow * 128 + ((kch ^ ((krow >> 1) & 7)) << 4), dK1 = dK0 + 64 * 128;
    const unsigned dQ = QK_OFF + krow * 128 + ((kch ^ ((krow >> 1) & 7)) << 4);
    v4u st[7]; v2u un[4], zn[4]; float dln;
#define GS_LOAD(chunk) do { const int grp_ = b * 32 + (chunk), item_ = grp_ * 4 + h; const size_t r0_ = (size_t)grp_ * 64; \
        st[0] = *(const GAS v4u*)(Wb + (size_t)item_ * 8192 + prow * 128 + pch * 8); st[1] = *(const GAS v4u*)(Wb + (size_t)item_ * 8192 + (prow + 32) * 128 + pch * 8); \
        st[2] = *(const GAS v4u*)(proj + (r0_ + prow) * IN_DIM + C_QG + h * 128 + pch * 8); st[3] = *(const GAS v4u*)(proj + (r0_ + prow + 32) * IN_DIM + C_QG + h * 128 + pch * 8); \
        st[4] = *(const GAS v4u*)(proj + (r0_ + (krow >> 1)) * IN_DIM + C_KG + h * 128 + (krow & 1) * 64 + kch * 8); \
        st[5] = *(const GAS v4u*)(proj + (r0_ + 32 + (krow >> 1)) * IN_DIM + C_KG + h * 128 + (krow & 1) * 64 + kch * 8); \
        st[6] = *(const GAS v4u*)(QKb + (size_t)item_ * 4096 + krow * 64 + kch * 8); \
        _Pragma("unroll") for (int m_ = 0; m_ < 4; ++m_) { const bf16* p_ = proj + (r0_ + (w * 4 + m_) * 2 + (g >> 1)) * IN_DIM + h * 128 + (g & 1) * 64 + c * 4; \
            un[m_] = *(const GAS v2u*)(p_ + C_VG); zn[m_] = *(const GAS v2u*)(p_ + C_ZG); } \
        dln = gscal[item_]; } while (0)
#define GS_WRITE(buf) do { LAS unsigned char* B_ = L + (buf) * BUFB; \
        *(LAS v4u*)(B_ + dW0) = st[0]; *(LAS v4u*)(B_ + dW1) = st[1]; *(LAS v4u*)(B_ + QD_OFF + dW0) = st[2]; *(LAS v4u*)(B_ + QD_OFF + dW1) = st[3]; \
        *(LAS v4u*)(B_ + dK0) = st[4]; *(LAS v4u*)(B_ + dK1) = st[5]; *(LAS v4u*)(B_ + dQ) = st[6]; } while (0)
    unsigned fW[4], fK[2];
#pragma unroll
    for (int s = 0; s < 4; ++s) fW[s] = c * 256 + (((4 * s + g) ^ c) << 4);
#pragma unroll
    for (int s = 0; s < 2; ++s) fK[s] = c * 128 + (((4 * s + g) ^ ((c >> 1) & 7)) << 4);
    __syncthreads();
    GS_LOAD(0); GS_WRITE(0);
    v2u uw[4], zw[4]; float dl = dln;
#pragma unroll
    for (int m = 0; m < 4; ++m) { uw[m] = un[m]; zw[m] = zn[m]; }
    __syncthreads();
#pragma unroll 1
    for (int chunk = 0; chunk < 32; ++chunk) {
        const int cur = chunk & 1; const LAS unsigned char* B = L + cur * BUFB;
        const size_t r0 = (size_t)(b * 32 + chunk) * 64;
        if (((chunk + 1) & 7) == 0 && chunk + 1 < 32) wait_count((unsigned*)(F.ws + WS_CTL) + CW_SOFT + 64 * l + 48 + ((chunk + 1) >> 3), 192u, w);
        if (chunk + 1 < 32) GS_LOAD(chunk + 1);
        bf16x8 Sb[4];
#pragma unroll
        for (int s = 0; s < 4; ++s) Sb[s] = pack_acc2(S[2 * s], S[2 * s + 1]);
#define LD8_W(dst, off, m0) do { _Pragma("unroll") for (int mm_ = 0; mm_ < 2; ++mm_) _Pragma("unroll") for (int s_ = 0; s_ < 4; ++s_) dst[mm_ * 4 + s_] = *(const LAS bf16x8*)(B + (off) + ((m0) + mm_) * 4096 + fW[s_]); } while (0)
#define LD8_K(dst, off, n0) do { _Pragma("unroll") for (int nn_ = 0; nn_ < 4; ++nn_) _Pragma("unroll") for (int s_ = 0; s_ < 2; ++s_) dst[nn_ * 2 + s_] = *(const LAS bf16x8*)(B + (off) + ((n0) + nn_) * 2048 + fK[s_]); } while (0)
        bf16x8 fa[8], fb[8], fc[8];
        f32x4 Vn[4], O[4];
        LD8_W(fa, W_OFF, 0); LD8_W(fb, W_OFF, 2); SBAR();
#pragma unroll
        for (int mm = 0; mm < 2; ++mm) { f32x4 p = (f32x4){0.f, 0.f, 0.f, 0.f};
#pragma unroll
            for (int s = 0; s < 4; ++s) p = MFMA16(fa[mm * 4 + s], Sb[s], p);
            Vn[mm] = (f32x4){pg8::bf_lo(uw[mm].x), pg8::bf_hi(uw[mm].x), pg8::bf_lo(uw[mm].y), pg8::bf_hi(uw[mm].y)} - p; }
        LD8_W(fa, QD_OFF, 0); SBAR();
#pragma unroll
        for (int mm = 0; mm < 2; ++mm) { f32x4 p = (f32x4){0.f, 0.f, 0.f, 0.f};
#pragma unroll
            for (int s = 0; s < 4; ++s) p = MFMA16(fb[mm * 4 + s], Sb[s], p);
            Vn[2 + mm] = (f32x4){pg8::bf_lo(uw[2 + mm].x), pg8::bf_hi(uw[2 + mm].x), pg8::bf_lo(uw[2 + mm].y), pg8::bf_hi(uw[2 + mm].y)} - p; }
        LD8_W(fb, QD_OFF, 2); SBAR();
        bf16x8 Vb[2];
        Vb[0] = pack_acc2(Vn[0], Vn[1]); Vb[1] = pack_acc2(Vn[2], Vn[3]);
#pragma unroll
        for (int mm = 0; mm < 2; ++mm) { f32x4 o = (f32x4){0.f, 0.f, 0.f, 0.f};
#pragma unroll
            for (int s = 0; s < 4; ++s) o = MFMA16(fa[mm * 4 + s], Sb[s], o);
            O[mm] = o; }
        LD8_K(fc, QK_OFF, 0); SBAR();
#pragma unroll
        for (int mm = 0; mm < 2; ++mm) { f32x4 o = (f32x4){0.f, 0.f, 0.f, 0.f};
#pragma unroll
            for (int s = 0; s < 4; ++s) o = MFMA16(fb[mm * 4 + s], Sb[s], o);
            O[2 + mm] = o; }
        LD8_K(fa, KDT_OFF, 0); SBAR();
#pragma unroll
        for (int mm = 0; mm < 4; ++mm)
#pragma unroll
            for (int s = 0; s < 2; ++s) O[mm] = MFMA16(fc[mm * 2 + s], Vb[s], O[mm]);
        LD8_K(fb, KDT_OFF, 4); SBAR();
#pragma unroll
        for (int n = 0; n < 4; ++n) { f32x4 a = S[n] * dl;
#pragma unroll
            for (int s = 0; s < 2; ++s) a = MFMA16(fa[n * 2 + s], Vb[s], a);
            S[n] = a; }
        SBAR();
#pragma unroll
        for (int n = 0; n < 4; ++n) { f32x4 a = S[4 + n] * dl;
#pragma unroll
            for (int s = 0; s < 2; ++s) a = MFMA16(fb[n * 2 + s], Vb[s], a);
            S[4 + n] = a; }
#undef LD8_W
#undef LD8_K
        LAS float* RED = (LAS float*)(L + RED_OFF) + cur * 512;
#pragma unroll
        for (int m = 0; m < 4; ++m)
#pragma unroll
            for (int r = 0; r < 4; ++r) { const float q = row16_sum(O[m][r] * O[m][r]); if (c == 0) RED[(16 * m + 4 * g + r) * 8 + w] = q; }
               if (chunk + 1 < 32) GS_WRITE(cur ^ 1);
               LBAR();
                LAS float* RSV = (LAS float*)(L + RSV_OFF) + w * 64;
        { const f32x4 a = *(const LAS f32x4*)(RED + lane * 8), b2 = *(const LAS f32x4*)(RED + lane * 8 + 4);
          RSV[lane] = frsq(((a[0] + a[1]) + (a[2] + a[3]) + (b2[0] + b2[1]) + (b2[2] + b2[3])) * (1.f / GDV) + EPS); }
        LAS bf16* OGW = (LAS bf16*)(L + OGW_OFF) + w * 1024;
#pragma unroll
        for (int m = 0; m < 4; ++m) { const f32x4 rs = *(const LAS f32x4*)(RSV + 16 * m + 4 * g);
            const float z0 = pg8::bf_lo(zw[m].x), z1 = pg8::bf_hi(zw[m].x), z2 = pg8::bf_lo(zw[m].y), z3 = pg8::bf_hi(zw[m].y);
            OGW[(16 * m + 4 * g + 0) * 16 + c] = (bf16)f2bf(O[m][0] * rs[0] * gn * siluf(z0));
            OGW[(16 * m + 4 * g + 1) * 16 + c] = (bf16)f2bf(O[m][1] * rs[1] * gn * siluf(z1));
            OGW[(16 * m + 4 * g + 2) * 16 + c] = (bf16)f2bf(O[m][2] * rs[2] * gn * siluf(z2));
            OGW[(16 * m + 4 * g + 3) * 16 + c] = (bf16)f2bf(O[m][3] * rs[3] * gn * siluf(z3)); }
        { const v4u o0 = *(const LAS v4u*)(OGW + lane * 16), o1 = *(const LAS v4u*)(OGW + lane * 16 + 8);
          bf16* zp = proj + (r0 + lane) * IN_DIM + C_ZG + h * 128 + 16 * w;
          *(GAS v4u*)zp = o0; *(GAS v4u*)(zp + 8) = o1; }
#pragma unroll
        for (int m = 0; m < 4; ++m) { uw[m] = un[m]; zw[m] = zn[m]; }
        dl = dln;
    }
#undef GS_LOAD
#undef GS_WRITE
    int tz_ = threadIdx.x; asm volatile("" : "+v"(tz_));
    const int c2_ = tz_ & 15, g2_ = (tz_ >> 4) & 3, w2_ = __builtin_amdgcn_readfirstlane(tz_ >> 6);
    float* So = F.out + O_SP + (((size_t)l * PB + b) * GH + h) * GDK * GDV + (size_t)(4 * g2_) * GDV + 16 * w2_ + c2_;
#pragma unroll
    for (int n = 0; n < 8; ++n) { asm volatile("" : "+v"(So));
#pragma unroll
        for (int r = 0; r < 4; ++r) So[r * GDV] = S[n][r];
        So += 16 * GDV; }
}

struct MlIn { v4u rq, rk, rv[2], ro[2]; float gi, gf; };
__device__ __forceinline__ void mlstm_prep_load(Frame& F, int grp, int h, MlIn& R) {
    const bf16* proj = (const bf16*)(F.ws + WS_PROJ); const float* gates = (const float*)(F.ws + WS_GATES);
    int tl = F.tid; asm volatile("" : "+v"(tl));
    const int r0 = grp * 64, row = tl >> 3, ch = tl & 7;
    R.rq = *(const GAS v4u*)(proj + (size_t)(r0 + row) * IN_DIM + C_QM + h * 64 + ch * 8);
    R.rk = *(const GAS v4u*)(proj + (size_t)(r0 + row) * IN_DIM + C_KM + h * 64 + ch * 8);
#pragma unroll
    for (int k = 0; k < 2; ++k) { const int q = tl + 512 * k, vr = q >> 4, vc = q & 15;
        R.rv[k] = *(const GAS v4u*)(proj + (size_t)(r0 + vr) * IN_DIM + C_VM + h * 128 + vc * 8); R.ro[k] = *(const GAS v4u*)(proj + (size_t)(r0 + vr) * IN_DIM + C_OM + h * 128 + vc * 8); }
    { const int t6 = tl & 63; R.gi = gates[(size_t)(r0 + t6) * 16 + 8 + h]; R.gf = gates[(size_t)(r0 + t6) * 16 + 12 + h]; }
}
__device__ __forceinline__ void mlstm_prep_item(Frame& F, int l, int grp, int h, MlIn& R, int nxt) {
    LAS unsigned char* L = F.lds + RING_OFF;
    constexpr int PQ = 72, PV_ = 136;
    LAS bf16* QB = (LAS bf16*)L;
    LAS bf16* KB = (LAS bf16*)(L + 9216);
    LAS bf16* VB = (LAS bf16*)(L + 18432);
    LAS bf16* OB = (LAS bf16*)(L + 18432 + 17408);
    LAS bf16* PS = (LAS bf16*)(L + 18432 + 2 * 17408);
    LAS float* SC = (LAS float*)(L + 18432 + 2 * 17408 + 8192);
    bf16* proj = (bf16*)(F.ws + WS_PROJ);
    const float* gates = (const float*)(F.ws + WS_GATES);
    const int r0 = grp * 64, item = grp * 4 + h;
    bf16* Pg = (bf16*)(F.ws + WS_XN + XN_PBUF) + (size_t)item * 4096;
    float* msc = (float*)(F.ws + WS_MSCAL) + (size_t)item * 256;
    LBAR();
    int tl = F.tid; asm volatile("" : "+v"(tl));
    {
        const int row = tl >> 3, ch = tl & 7;
        *(LAS v4u*)(QB + row * PQ + ch * 8) = R.rq; *(LAS v4u*)(KB + row * PQ + ch * 8) = R.rk;
#pragma unroll
        for (int k = 0; k < 2; ++k) { const int q = tl + 512 * k, vr = q >> 4, vc = q & 15; *(LAS v4u*)(VB + vr * PV_ + vc * 8) = R.rv[k]; *(LAS v4u*)(OB + vr * PV_ + vc * 8) = R.ro[k]; }
        if (tl < 64) { SC[tl] = R.gi + F.a->in[I_IB][l * MH + h]; SC[64 + tl] = -softplusf(-(R.gf + F.a->in[I_FB][l * MH + h])); }
    }
    asm volatile("" ::: "memory");
    if (nxt >= 0) mlstm_prep_load(F, (nxt & 1023) >> 2, nxt & 3, R);
    LBAR();
    tl = F.tid; asm volatile("" : "+v"(tl));
    if (tl < 64) {
        const int lane = tl; const float x = wave_scan_add(SC[64 + lane]);
        const float u = SC[lane] - x; const float pm = wave_scan_max(u);
        const float pml = __builtin_bit_cast(float, __builtin_amdgcn_readlane(__builtin_bit_cast(int, pm), 63));
        SC[128 + lane] = x; SC[192 + lane] = u; SC[256 + lane] = pm; SC[320 + lane] = __expf(u - pml);
        st_wt(msc + lane, x); st_wt(msc + 64 + lane, x + pm);
    }
    LBAR();
    tl = F.tid; asm volatile("" : "+v"(tl));
    if (tl < 256) {
        const int lane_ = tl & 63, ti = __builtin_amdgcn_readfirstlane(tl >> 6), fr = lane_ & 15, g = lane_ >> 4;
        float rsum[4] = {0.f, 0.f, 0.f, 0.f};
        for (int tj = 0; tj < 4; ++tj) {
            f32x4 acc = (f32x4){0.f, 0.f, 0.f, 0.f};
            if (tj <= ti) {
#pragma unroll
                for (int s = 0; s < 2; ++s) { const bf16x8 a = *(const LAS bf16x8*)(QB + (16 * ti + fr) * PQ + 32 * s + 8 * g), bq = *(const LAS bf16x8*)(KB + (16 * tj + fr) * PQ + 32 * s + 8 * g);
                    acc = MFMA16(a, bq, acc); }
            }
            const int j = 16 * tj + fr; const float uj = SC[192 + j];
#pragma unroll
            for (int r = 0; r < 4; ++r) { const int i = 16 * ti + 4 * g + r;
                const float p = (j <= i) ? __expf(fminf(uj - SC[256 + i], 0.f)) * 0.125f * acc[r] : 0.f;
                rsum[r] += p; PS[i * 64 + permk(j)] = (bf16)f2bf(p); }
        }
#pragma unroll
        for (int r = 0; r < 4; ++r) { float q = rsum[r]; q += __shfl_xor(q, 1); q += __shfl_xor(q, 2); q += __shfl_xor(q, 4); q += __shfl_xor(q, 8);
            if (fr == 0) st_wt(msc + 128 + 16 * ti + 4 * g + r, q); }
    } else {
        const int t2 = tl - 256;
#pragma unroll
        for (int k = 0; k < 2; ++k) { const int q = t2 + 256 * k, t = q >> 3, ch = q & 7, s = ch >> 2, g = ch & 3;
            const v2u a = *(const LAS v2u*)(QB + t * PQ + 32 * s + 4 * g), b2 = *(const LAS v2u*)(QB + t * PQ + 32 * s + 16 + 4 * g);
            v4u o; o.x = pk2(pg8::bf_lo(a.x) * 0.125f, pg8::bf_hi(a.x) * 0.125f); o.y = pk2(pg8::bf_lo(a.y) * 0.125f, pg8::bf_hi(a.y) * 0.125f);
            o.z = pk2(pg8::bf_lo(b2.x) * 0.125f, pg8::bf_hi(b2.x) * 0.125f); o.w = pk2(pg8::bf_lo(b2.y) * 0.125f, pg8::bf_hi(b2.y) * 0.125f);
            st_wt((GAS v4u*)(proj + (size_t)(r0 + t) * IN_DIM + C_QM + h * 64 + ch * 8), o); }
#pragma unroll
        for (int k = 0; k < 2; ++k) { const int q = t2 + 256 * k, dk = q >> 3, ch = q & 7, s = ch >> 2, g = ch & 3; float v[8];
#pragma unroll
            for (int e = 0; e < 8; ++e) { const int tok = 32 * s + lperm(g, e); v[e] = bf2f(KB[tok * PQ + dk]) * SC[320 + tok]; }
            v4u o; o.x = pk2(v[0], v[1]); o.y = pk2(v[2], v[3]); o.z = pk2(v[4], v[5]); o.w = pk2(v[6], v[7]);
            st_wt((GAS v4u*)(proj + (size_t)(r0 + dk) * IN_DIM + C_KM + h * 64 + ch * 8), o); }
        if (t2 < 64) { float a = 0.f;
            for (int tok = 0; tok < 64; ++tok) a += bf2f(KB[tok * PQ + t2]) * SC[320 + tok];
            st_wt(msc + 192 + t2, a); }
#pragma unroll
        for (int k = 0; k < 4; ++k) { const int q = t2 + 256 * k, cc = q & 15, g = (q >> 4) & 3, s = (q >> 6) & 1, w = q >> 7; float v[8];
#pragma unroll
            for (int e = 0; e < 8; ++e) v[e] = bf2f(VB[(32 * s + lperm(g, e)) * PV_ + 16 * w + cc]);
            v4u o; o.x = pk2(v[0], v[1]); o.y = pk2(v[2], v[3]); o.z = pk2(v[4], v[5]); o.w = pk2(v[6], v[7]);
            st_wt((GAS v4u*)(proj + (size_t)(r0 + (w * 2 + s) * 4 + g) * IN_DIM + C_VM + h * 128 + cc * 8), o); }
#pragma unroll
        for (int k = 0; k < 4; ++k) {
            const int q = t2 + 256 * k, cp2 = q & 7, g = (q >> 3) & 3, mm = (q >> 5) & 3, w = q >> 7; unsigned short zv[8];
#pragma unroll
            for (int e = 0; e < 8; ++e) zv[e] = OB[(16 * mm + 4 * g + (e & 3)) * PV_ + 16 * w + 2 * cp2 + (e >> 2)];
            v4u o; o.x = zv[0] | ((unsigned)zv[1] << 16); o.y = zv[2] | ((unsigned)zv[3] << 16); o.z = zv[4] | ((unsigned)zv[5] << 16); o.w = zv[6] | ((unsigned)zv[7] << 16);
            st_wt((GAS v4u*)(proj + (size_t)(r0 + (w * 4 + mm) * 2 + (g >> 1)) * IN_DIM + C_OM + h * 128 + (g & 1) * 64 + cp2 * 8), o); }
    }
    LBAR();
    tl = F.tid; asm volatile("" : "+v"(tl));
    st_wt((GAS v4u*)(Pg + tl * 8), *(const LAS v4u*)(PS + tl * 8));
}

__device__ __forceinline__ void mlstm_scan_prompt(Frame& F, int l, int b, int h) {
    LAS unsigned char* L = F.lds + RING_OFF;
    constexpr int BUFB = 24576, P_OFF = 0, QS_OFF = 8192, KGT_OFF = 16384, SCL_OFF = 2 * BUFB, RED_OFF = SCL_OFF + 2048, RSV_OFF = RED_OFF + 4096, OGW_OFF = RSV_OFF + 2048;
    bf16* proj = (bf16*)(F.ws + WS_PROJ);
    const bf16* Pb = (const bf16*)(F.ws + WS_XN + XN_PBUF);
    const float* mscal = (const float*)(F.ws + WS_MSCAL);
    int tl_ = F.tid; asm volatile("" : "+v"(tl_));
    const int tid = tl_, lane = tid & 63, w = __builtin_amdgcn_readfirstlane(tid >> 6), c = lane & 15, g = lane >> 4;
    const float mn = F.a->in[I_MNORM][(size_t)l * 512 + h * 128 + 16 * w + c];
    f32x4 C[4]; float nv[16]; float m = 0.f;
#pragma unroll
    for (int n = 0; n < 4; ++n) C[n] = (f32x4){0.f, 0.f, 0.f, 0.f};
#pragma unroll
    for (int i = 0; i < 16; ++i) nv[i] = 0.f;
    const int krow = tid >> 3, kch = tid & 7;
    const unsigned dP = krow * 128 + ((kch ^ ((krow >> 1) & 7)) << 4);
    v4u st[3]; f32x4 stsc; bf16x8 vfn[2]; v2u ogn[4];
#define MS_LOAD(chunk) do { const int grp_ = b * 32 + (chunk), item_ = grp_ * 4 + h; const size_t r0_ = (size_t)grp_ * 64; \
        st[0] = *(const GAS v4u*)(Pb + (size_t)item_ * 4096 + krow * 64 + kch * 8); \
        st[1] = *(const GAS v4u*)(proj + (r0_ + krow) * IN_DIM + C_QM + h * 64 + kch * 8); \
        st[2] = *(const GAS v4u*)(proj + (r0_ + krow) * IN_DIM + C_KM + h * 64 + kch * 8); \
        stsc = *(const GAS f32x4*)(mscal + (size_t)item_ * 256 + 4 * (tid & 63)); \
        _Pragma("unroll") for (int s_ = 0; s_ < 2; ++s_) vfn[s_] = *(const GAS bf16x8*)(proj + (r0_ + (w * 2 + s_) * 4 + g) * IN_DIM + C_VM + h * 128 + c * 8); \
        _Pragma("unroll") for (int m_ = 0; m_ < 4; ++m_) ogn[m_] = *(const GAS v2u*)(proj + (r0_ + (w * 4 + m_) * 2 + (g >> 1)) * IN_DIM + C_OM + h * 128 + (g & 1) * 64 + c * 4); } while (0)
#define MS_WRITE(buf) do { LAS unsigned char* B_ = L + (buf) * BUFB; \
        *(LAS v4u*)(B_ + P_OFF + dP) = st[0]; *(LAS v4u*)(B_ + QS_OFF + dP) = st[1]; *(LAS v4u*)(B_ + KGT_OFF + dP) = st[2]; \
        if (tid < 64) *(LAS f32x4*)(L + SCL_OFF + (buf) * 1024 + 16 * tid) = stsc; } while (0)
    unsigned fK[2];
#pragma unroll
    for (int s = 0; s < 2; ++s) fK[s] = c * 128 + (((4 * s + g) ^ ((c >> 1) & 7)) << 4);
    __syncthreads();
    MS_LOAD(0); MS_WRITE(0);
    bf16x8 Vf[2]; v2u ogw[4];
    Vf[0] = vfn[0]; Vf[1] = vfn[1];
#pragma unroll
    for (int mm = 0; mm < 4; ++mm) ogw[mm] = ogn[mm];
    __syncthreads();
#pragma unroll 1
    for (int chunk = 0; chunk < 32; ++chunk) {
        const int cur = chunk & 1; const LAS unsigned char* B = L + cur * BUFB; const LAS float* SCL = (const LAS float*)(L + SCL_OFF + cur * 1024);
        const size_t r0 = (size_t)(b * 32 + chunk) * 64;
        if (((chunk + 1) & 7) == 0 && chunk + 1 < 32) wait_count((unsigned*)(F.ws + WS_CTL) + CW_SOFT + 64 * l + 48 + ((chunk + 1) >> 3), 192u, w);
        if (chunk + 1 < 32) MS_LOAD(chunk + 1);
        bf16x8 Cb[2], nb[2];
#pragma unroll
        for (int s = 0; s < 2; ++s) { Cb[s] = pack_acc2(C[2 * s], C[2 * s + 1]);
            nb[s] = pack_acc2((f32x4){nv[8 * s], nv[8 * s + 1], nv[8 * s + 2], nv[8 * s + 3]}, (f32x4){nv[8 * s + 4], nv[8 * s + 5], nv[8 * s + 6], nv[8 * s + 7]}); }
        const float Fl = SCL[63], Gmax = SCL[127];
        f32x4 H[4];
#define LD8_K(dst, off) do { _Pragma("unroll") for (int nn_ = 0; nn_ < 4; ++nn_) _Pragma("unroll") for (int s_ = 0; s_ < 2; ++s_) dst[nn_ * 2 + s_] = *(const LAS bf16x8*)(B + (off) + nn_ * 2048 + fK[s_]); } while (0)
        bf16x8 fa[8], fb[8];
        LD8_K(fa, QS_OFF); LD8_K(fb, P_OFF); SBAR();
#pragma unroll
        for (int mm = 0; mm < 4; ++mm) {
            f32x4 qc = (f32x4){0.f, 0.f, 0.f, 0.f}, qn = qc, pv = qc;
#pragma unroll
            for (int s = 0; s < 2; ++s) { qc = MFMA16(fa[mm * 2 + s], Cb[s], qc); qn = MFMA16(fa[mm * 2 + s], nb[s], qn); pv = MFMA16(fb[mm * 2 + s], Vf[s], pv); }
            const f32x4 Fi = *(const LAS f32x4*)(SCL + 16 * mm + 4 * g), Dm = *(const LAS f32x4*)(SCL + 64 + 16 * mm + 4 * g), rsm = *(const LAS f32x4*)(SCL + 128 + 16 * mm + 4 * g);
#pragma unroll
            for (int r = 0; r < 4; ++r) { const float mrow = fmaxf(Dm[r], m + Fi[r]), a = __expf(m + Fi[r] - mrow), e = __expf(Dm[r] - mrow);
                const float num = a * qc[r] + e * pv[r], den = a * qn[r] + e * rsm[r];
                H[mm][r] = num * frcp(fmaxf(fabsf(den), __expf(-mrow))); }
        }
        SBAR();
        LD8_K(fa, KGT_OFF); SBAR();
        const float mnew = fmaxf(m + Fl, Gmax), dec = __expf(m + Fl - mnew), eGs = __expf(Gmax - mnew);
#pragma unroll
        for (int n = 0; n < 4; ++n) { f32x4 t = (f32x4){0.f, 0.f, 0.f, 0.f};
#pragma unroll
            for (int s = 0; s < 2; ++s) t = MFMA16(fa[n * 2 + s], Vf[s], t);
            C[n] = C[n] * dec + t * eGs; }
#undef LD8_K
#pragma unroll
        for (int s = 0; s < 2; ++s) { const f32x4 k0 = *(const LAS f32x4*)(SCL + 192 + 32 * s + 4 * g), k1 = *(const LAS f32x4*)(SCL + 192 + 32 * s + 16 + 4 * g);
#pragma unroll
            for (int j = 0; j < 4; ++j) { nv[8 * s + j] = dec * nv[8 * s + j] + eGs * k0[j]; nv[8 * s + 4 + j] = dec * nv[8 * s + 4 + j] + eGs * k1[j]; } }
        m = mnew;
        LAS float* RED = (LAS float*)(L + RED_OFF) + cur * 512;
#pragma unroll
        for (int mm = 0; mm < 4; ++mm)
#pragma unroll
            for (int r = 0; r < 4; ++r) { const float q = row16_sum(H[mm][r] * H[mm][r]); if (c == 0) RED[(16 * mm + 4 * g + r) * 8 + w] = q; }
        if (chunk + 1 < 32) MS_WRITE(cur ^ 1);
        LBAR();
        LAS float* RSV = (LAS float*)(L + RSV_OFF) + w * 64;
        { const f32x4 a = *(const LAS f32x4*)(RED + lane * 8), b2 = *(const LAS f32x4*)(RED + lane * 8 + 4);
          RSV[lane] = frsq(((a[0] + a[1]) + (a[2] + a[3]) + (b2[0] + b2[1]) + (b2[2] + b2[3])) * (1.f / MDV) + EPS); }
        LAS bf16* OGW = (LAS bf16*)(L + OGW_OFF) + w * 1024;
#pragma unroll
        for (int mm = 0; mm < 4; ++mm) { const f32x4 rs = *(const LAS f32x4*)(RSV + 16 * mm + 4 * g);
            const float z0 = pg8::bf_lo(ogw[mm].x), z1 = pg8::bf_hi(ogw[mm].x), z2 = pg8::bf_lo(ogw[mm].y), z3 = pg8::bf_hi(ogw[mm].y);
            OGW[(16 * mm + 4 * g + 0) * 16 + c] = (bf16)f2bf(H[mm][0] * rs[0] * mn * sigm(z0));
            OGW[(16 * mm + 4 * g + 1) * 16 + c] = (bf16)f2bf(H[mm][1] * rs[1] * mn * sigm(z1));
            OGW[(16 * mm + 4 * g + 2) * 16 + c] = (bf16)f2bf(H[mm][2] * rs[2] * mn * sigm(z2));
            OGW[(16 * mm + 4 * g + 3) * 16 + c] = (bf16)f2bf(H[mm][3] * rs[3] * mn * sigm(z3)); }
        { const v4u o0 = *(const LAS v4u*)(OGW + lane * 16), o1 = *(const LAS v4u*)(OGW + lane * 16 + 8);
          bf16* op = proj + (r0 + lane) * IN_DIM + C_OM + h * 128 + 16 * w;
          *(GAS v4u*)op = o0; *(GAS v4u*)(op + 8) = o1; }
        Vf[0] = vfn[0]; Vf[1] = vfn[1];
#pragma unroll
        for (int mm = 0; mm < 4; ++mm) ogw[mm] = ogn[mm];
    }
#undef MS_LOAD
#undef MS_WRITE
    const size_t sidx = ((size_t)l * PB + b) * MH + h;
    int tz_ = threadIdx.x; asm volatile("" : "+v"(tz_));
    const int c2_ = tz_ & 15, g2_ = (tz_ >> 4) & 3, w2_ = __builtin_amdgcn_readfirstlane(tz_ >> 6);
    float* Co = F.out + O_CP + sidx * MDK * MDV + (size_t)(4 * g2_) * MDV + 16 * w2_ + c2_;
#pragma unroll
    for (int n = 0; n < 4; ++n) { asm volatile("" : "+v"(Co));
#pragma unroll
        for (int r = 0; r < 4; ++r) Co[r * MDV] = C[n][r];
        Co += 16 * MDV; }
    if (w2_ == 0 && c2_ == 0) { float* no = F.out + O_NP + sidx * MDK;
#pragma unroll
        for (int s = 0; s < 2; ++s)
#pragma unroll
            for (int j = 0; j < 8; ++j) no[32 * s + lperm(g2_, j)] = nv[8 * s + j]; }
    if (tz_ == 0) F.out[O_MP + sidx] = m;
}
__device__ __forceinline__ void prep_group(Frame& F, int l, int g, int gw, int gnw, int mw, int mnw) {
    const float* cw = F.a->in[I_CONVW] + (size_t)l * 4 * CONVC;
#define PG_B(j) (((((j) >> 6) & 3) << 1) | (((j) >> 2) & 1))
#define PG_ITEM(j) ((((PG_B(j) * 32) + 8 * g + (((j) >> 3) & 7)) << 2) | ((j) & 3))
    if (gw >= 0) {
        GdnIn R; GdnConst K;
        { int tl = F.tid; asm volatile("" : "+v"(tl)); const int hh = gw & 3, s = tl >> 7, e = tl & 127; const int col = (tl < 384) ? s * 512 + hh * 128 + e : 0;
          K.w0 = cw[col]; K.w1 = cw[CONVC + col]; K.w2 = cw[2 * CONVC + col]; K.w3 = cw[3 * CONVC + col];
          K.aexp = __expf(F.a->in[I_ALOG][l * GH + hh]); K.dtb = F.a->in[I_DTB][l * GH + hh]; }
        if (gw < 256) { const int id = PG_ITEM(gw); gdn_prep_load(F, id >> 2, id & 3, R); }
        for (int j = gw; j < 256; j += gnw) { const int id = PG_ITEM(j), nj = j + gnw; gdn_prep_item(F, l, id >> 2, id & 3, R, K, nj < 256 ? PG_ITEM(nj) : -1); }
    }
    if (mw >= 0) {
        MlIn R;
        if (mw < 256) { const int id = PG_ITEM(mw); mlstm_prep_load(F, id >> 2, id & 3, R); }
        for (int j = mw; j < 256; j += mnw) { const int id = PG_ITEM(j), nj = j + mnw; mlstm_prep_item(F, l, id >> 2, id & 3, R, nj < 256 ? PG_ITEM(nj) : -1); }
    }
#undef PG_ITEM
#undef PG_B
}
__device__ __forceinline__ void fe_sample_items(Frame& F, int l, int wk) {
    int tq_ = threadIdx.x; asm volatile("" : "+v"(tq_)); const int lane_ = tq_ & 63, wave_ = __builtin_amdgcn_readfirstlane(tq_ >> 6);
    LAS float* XP = (LAS float*)(F.lds + RING_OFF);
    bf16* proj = (bf16*)(F.ws + WS_PROJ);
    const float* cw = F.a->in[I_CONVW] + (size_t)l * 4 * CONVC;
    constexpr int NP_ITEMS = 256 * GH, NS_ITEMS = 16 * GH;
    for (int it = 2 * NP_ITEMS + (wk < 0 ? NS_ITEMS : wk); it < 2 * NP_ITEMS + NS_ITEMS; it += F.G) {
        const bool prompt = false;
        const int h = it & 3, grp = (it - 2 * NP_ITEMS) >> 2;
        __syncthreads();
        {
            const int b0 = grp * 8;
            const float* st = F.a->in[I_SCONV] + (size_t)l * SB * 3 * CONVC;
            for (int q = tq_; q < 8 * 7 * 48; q += NWAVES * 64) {
                const int sq = q / (7 * 48), rem = q % (7 * 48), j = rem / 48, s = (rem % 48) >> 4, ch = rem & 15;
                LAS float* d = XP + (sq * 7 + j) * 384 + s * 128 + ch * 8;
                if (j >= 3) { const v4u w = *(const GAS v4u*)(proj + (size_t)(MP + (b0 + sq) * 4 + j - 3) * IN_DIM + s * 512 + h * 128 + ch * 8);
                    d[0] = pg8::bf_lo(w.x); d[1] = pg8::bf_hi(w.x); d[2] = pg8::bf_lo(w.y); d[3] = pg8::bf_hi(w.y); d[4] = pg8::bf_lo(w.z); d[5] = pg8::bf_hi(w.z); d[6] = pg8::bf_lo(w.w); d[7] = pg8::bf_hi(w.w);
                } else { const float* sp = st + ((size_t)(b0 + sq) * 3 + j) * CONVC + s * 512 + h * 128 + ch * 8;
#pragma unroll
                    for (int e = 0; e < 8; ++e) d[e] = sp[e]; }
            }
        }
        __syncthreads();
        float w4[3][2][4];
#pragma unroll
        for (int s = 0; s < 3; ++s)
#pragma unroll
            for (int e = 0; e < 2; ++e)
#pragma unroll
                for (int j = 0; j < 4; ++j) w4[s][e][j] = cw[(size_t)j * CONVC + s * 512 + h * 128 + lane_ + 64 * e];
        const int ntok = prompt ? 8 : 4;
        for (int tt = 0; tt < ntok; ++tt) {
            const LAS float* base; size_t row;
            if (prompt) { const int t = wave_ * 8 + tt; base = XP + t * 384; row = (size_t)grp * 64 + t; }
            else { base = XP + (wave_ * 7 + tt) * 384; row = (size_t)MP + (size_t)(grp * 8 + wave_) * 4 + tt; }
            float y[3][2];
#pragma unroll
            for (int s = 0; s < 3; ++s)
#pragma unroll
                for (int e = 0; e < 2; ++e) { float a = 0.f;
#pragma unroll
                    for (int j = 0; j < 4; ++j) a += base[j * 384 + s * 128 + lane_ + 64 * e] * w4[s][e][j];
                    y[s][e] = siluf(a); }
            const float sq = wave_sum(y[0][0] * y[0][0] + y[0][1] * y[0][1]), sk = wave_sum(y[1][0] * y[1][0] + y[1][1] * y[1][1]);
            const float rq = (frsq(sq + EPS)) * 0.08838834764831845f, rk = frsq(sk + EPS);
            bf16* pr = proj + row * IN_DIM + h * 128 + lane_;
            pr[C_QG] = (bf16)f2bf(y[0][0] * rq); pr[C_QG + 64] = (bf16)f2bf(y[0][1] * rq);
            pr[C_KG] = (bf16)f2bf(y[1][0] * rk); pr[C_KG + 64] = (bf16)f2bf(y[1][1] * rk);
            pr[C_VG] = (bf16)f2bf(y[2][0]);      pr[C_VG + 64] = (bf16)f2bf(y[2][1]);
        }
        if (prompt) {
            if ((grp & 31) == 31) { float* cp = F.out + O_CONVP + ((size_t)l * PB + (grp >> 5)) * 3 * CONVC;
                for (int q = tq_; q < 3 * 384; q += NWAVES * 64) { const int j = q / 384, x = q % 384; cp[(size_t)j * CONVC + (x >> 7) * 512 + h * 128 + (x & 127)] = XP[(64 + j) * 384 + x]; } }
        } else {
            float* cs = F.out + O_CONVS + ((size_t)l * SB + grp * 8) * 3 * CONVC;
            for (int q = tq_; q < 8 * 3 * 384; q += NWAVES * 64) { const int sq = q / (3 * 384), rem = q % (3 * 384), j = rem / 384, x = rem % 384;
                cs[((size_t)sq * 3 + j) * CONVC + (x >> 7) * 512 + h * 128 + (x & 127)] = XP[(sq * 7 + 4 + j) * 384 + x]; }
        }
    }
}

__device__ __forceinline__ void gdn_seq(Frame& F, int l, int h, int row0, int T, const float* S0, float* Sout) {
    LAS float* L = (LAS float*)(F.lds + RING_OFF);
    LAS float* QKVZ = L;
    LAS float* SC = L + 2048;
    LAS float* RED = L + 2048 + 8;
    LAS float* RED2 = RED + 512;
    LAS float* OB = RED2 + 512;
    bf16* proj = (bf16*)(F.ws + WS_PROJ);
    const float* gates = (const float*)(F.ws + WS_GATES);
    int tl_ = F.tid; asm volatile("" : "+v"(tl_)); const int tid_ = tl_, lane_ = tid_ & 63, wave_ = __builtin_amdgcn_readfirstlane(tid_ >> 6);
    const int dv = 16 * wave_ + (lane_ & 15), kq = lane_ >> 4;
    const float Aexp = __expf(F.a->in[I_ALOG][l * GH + h]), dtb = F.a->in[I_DTB][l * GH + h];
    const float gn0 = F.a->in[I_GNORM][l * GDV + lane_], gn1 = F.a->in[I_GNORM][l * GDV + lane_ + 64];
    float S[32];
    if (S0) {
#pragma unroll
        for (int i0 = 0; i0 < 32; i0 += 8) { const float* sp = S0 + (size_t)(32 * kq + i0) * GDV + dv; asm volatile("" : "+v"(sp));
#pragma unroll
            for (int i = 0; i < 8; ++i) S[i0 + i] = sp[i * GDV]; }
    } else {
#pragma unroll
        for (int i = 0; i < 32; ++i) S[i] = 0.f;
    }
    for (int t0 = 0; t0 < T; t0 += 4) {
        __syncthreads();
        { const int tok = tid_ >> 7, e = tid_ & 127; const size_t row = (size_t)row0 + t0 + tok; const bf16* pr = proj + row * IN_DIM + h * 128 + e;
          QKVZ[(tok * 4 + 0) * 128 + e] = bf2f(pr[C_QG]); QKVZ[(tok * 4 + 1) * 128 + e] = bf2f(pr[C_KG]); QKVZ[(tok * 4 + 2) * 128 + e] = bf2f(pr[C_VG]); QKVZ[(tok * 4 + 3) * 128 + e] = bf2f(pr[C_ZG]);
          if (e == 0) { SC[tok * 2] = sigm(gates[row * 16 + h]); SC[tok * 2 + 1] = __expf(-Aexp * softplusf(gates[row * 16 + 4 + h] + dtb)); } }
        __syncthreads();
#pragma unroll 1
        for (int tok = 0; tok < 4; ++tok) {
            const LAS float* q = QKVZ + (tok * 4 + 0) * 128 + 32 * kq; const LAS float* k = QKVZ + (tok * 4 + 1) * 128 + 32 * kq;
            const float v = QKVZ[(tok * 4 + 2) * 128 + dv], beta = SC[tok * 2], eg = SC[tok * 2 + 1];
            float kk[32]; float rp = 0.f;
#pragma unroll
            for (int i = 0; i < 32; ++i) { kk[i] = k[i]; rp += kk[i] * S[i]; }
            rp += __shfl_xor(rp, 16); rp += __shfl_xor(rp, 32);
            const float coef = beta * (v - eg * rp);
            float op = 0.f;
#pragma unroll
            for (int i = 0; i < 32; ++i) { S[i] = eg * S[i] + kk[i] * coef; op += q[i] * S[i]; }
            op += __shfl_xor(op, 16); op += __shfl_xor(op, 32);
            if (kq == 0) OB[tok * 128 + dv] = op;
        }
        __syncthreads();
        if (wave_ < 4) { const int tok = wave_; const size_t row = (size_t)row0 + t0 + tok;
            const float o0 = OB[tok * 128 + lane_], o1 = OB[tok * 128 + lane_ + 64];
            const float rs = frsq(wave_sum(o0 * o0 + o1 * o1) * (1.f / GDV) + EPS);
            const float z0 = QKVZ[(tok * 4 + 3) * 128 + lane_], z1 = QKVZ[(tok * 4 + 3) * 128 + lane_ + 64];
            bf16* pr = proj + row * IN_DIM + C_ZG + h * 128 + lane_;
            pr[0] = (bf16)f2bf(o0 * rs * gn0 * siluf(z0)); pr[64] = (bf16)f2bf(o1 * rs * gn1 * siluf(z1)); }
    }
#pragma unroll
    for (int i0 = 0; i0 < 32; i0 += 8) { float* sp = Sout + (size_t)(32 * kq + i0) * GDV + dv; asm volatile("" : "+v"(sp));
#pragma unroll
        for (int i = 0; i < 8; ++i) sp[i * GDV] = S[i0 + i]; }
}
__device__ __forceinline__ void mlstm_seq(Frame& F, int l, int h, int row0, int T, const float* C0, const float* n0, const float* m0, float* Cout, float* nout, float* mout) {
    LAS float* L = (LAS float*)(F.lds + RING_OFF);
    LAS float* QK = L;
    LAS float* VO = L + 512;
    LAS float* SC = VO + 1024;
    LAS float* RED = SC + 8;
    LAS float* REDD = RED + 512;
    LAS float* OB = REDD + 4;
    bf16* proj = (bf16*)(F.ws + WS_PROJ);
    const float* gates = (const float*)(F.ws + WS_GATES);
    int tl_ = F.tid; asm volatile("" : "+v"(tl_)); const int tid_ = tl_, lane_ = tid_ & 63, wave_ = __builtin_amdgcn_readfirstlane(tid_ >> 6);
    const int dv = 16 * wave_ + (lane_ & 15), kq = lane_ >> 4;
    const float ib = F.a->in[I_IB][l * MH + h], fb = F.a->in[I_FB][l * MH + h];
    const float mn0 = F.a->in[I_MNORM][(size_t)l * 512 + h * 128 + lane_], mn1 = F.a->in[I_MNORM][(size_t)l * 512 + h * 128 + lane_ + 64];
    float C[16], n[16]; float m = m0 ? m0[0] : 0.f;
    if (C0) {
#pragma unroll
        for (int i0 = 0; i0 < 16; i0 += 8) { const float* sp = C0 + (size_t)(16 * kq + i0) * MDV + dv; asm volatile("" : "+v"(sp));
#pragma unroll
            for (int i = 0; i < 8; ++i) C[i0 + i] = sp[i * MDV]; }
#pragma unroll
        for (int i = 0; i < 16; ++i) n[i] = n0[16 * kq + i];
    } else {
#pragma unroll
        for (int i = 0; i < 16; ++i) { C[i] = 0.f; n[i] = 0.f; }
    }
    for (int t0 = 0; t0 < T; t0 += 4) {
        __syncthreads();
        { const int tok = tid_ >> 7, e = tid_ & 127; const size_t row = (size_t)row0 + t0 + tok; const bf16* pr = proj + row * IN_DIM;
          if (e < 64) QK[(tok * 2 + 0) * 64 + e] = bf2f(pr[C_QM + h * 64 + e]) * 0.125f; else QK[(tok * 2 + 1) * 64 + (e - 64)] = bf2f(pr[C_KM + h * 64 + (e - 64)]);
          VO[(tok * 2 + 0) * 128 + e] = bf2f(pr[C_VM + h * 128 + e]); VO[(tok * 2 + 1) * 128 + e] = bf2f(pr[C_OM + h * 128 + e]);
          if (e == 0) { SC[tok * 2] = gates[row * 16 + 8 + h] + ib; SC[tok * 2 + 1] = -softplusf(-(gates[row * 16 + 12 + h] + fb)); } }
        __syncthreads();
#pragma unroll 1
        for (int tok = 0; tok < 4; ++tok) {
            const LAS float* q = QK + (tok * 2 + 0) * 64 + 16 * kq; const LAS float* k = QK + (tok * 2 + 1) * 64 + 16 * kq;
            const float v = VO[(tok * 2 + 0) * 128 + dv], li = SC[tok * 2], lf = SC[tok * 2 + 1];
            const float mnew = fmaxf(lf + m, li), fd = __expf(lf + m - mnew), iw = __expf(li - mnew); m = mnew;
            float np = 0.f, dp = 0.f; const float iv = iw * v;
#pragma unroll
            for (int i = 0; i < 16; ++i) { const float ki = k[i], qi = q[i]; C[i] = fd * C[i] + ki * iv; n[i] = fd * n[i] + iw * ki; np += qi * C[i]; dp += qi * n[i]; }
            np += __shfl_xor(np, 16); np += __shfl_xor(np, 32); dp += __shfl_xor(dp, 16); dp += __shfl_xor(dp, 32);
            if (kq == 0) OB[tok * 128 + dv] = np * frcp(fmaxf(fabsf(dp), __expf(-m)));
        }
        __syncthreads();
        if (wave_ < 4) { const int tok = wave_; const size_t row = (size_t)row0 + t0 + tok;
            const float o0 = OB[tok * 128 + lane_], o1 = OB[tok * 128 + lane_ + 64];
            const float rs = frsq(wave_sum(o0 * o0 + o1 * o1) * (1.f / MDV) + EPS);
            const float g0 = VO[(tok * 2 + 1) * 128 + lane_], g1 = VO[(tok * 2 + 1) * 128 + lane_ + 64];
            bf16* pr = proj + row * IN_DIM + C_OM + h * 128 + lane_;
            pr[0] = (bf16)f2bf(o0 * rs * mn0 * sigm(g0)); pr[64] = (bf16)f2bf(o1 * rs * mn1 * sigm(g1)); }
    }
#pragma unroll
    for (int i0 = 0; i0 < 16; i0 += 8) { float* sp = Cout + (size_t)(16 * kq + i0) * MDV + dv; asm volatile("" : "+v"(sp));
#pragma unroll
        for (int i = 0; i < 8; ++i) sp[i * MDV] = C[i0 + i]; }
    if (dv == 0) {
#pragma unroll
        for (int i = 0; i < 16; ++i) nout[16 * kq + i] = n[i]; }
    if (tid_ == 0) mout[0] = m;
}
__device__ __forceinline__ void scan_item(Frame& F, int l, int it) {
    if (it < 32) { const int b = it >> 2, h = it & 3; gdn_scan_prompt(F, l, b, h); }
    else if (it < 64) { const int j = it - 32, b = j >> 2, h = j & 3; mlstm_scan_prompt(F, l, b, h); }
    else if (it < 576) { const int j = it - 64, b = j >> 2, h = j & 3; const size_t sidx = ((size_t)l * SB + b) * GH + h;
        gdn_seq(F, l, h, MP + b * ST, ST, F.a->in[I_SS] + sidx * GDK * GDV, F.out + O_SS + sidx * GDK * GDV); }
    else { const int j = it - 576, b = j >> 2, h = j & 3; const size_t sidx = ((size_t)l * SB + b) * MH + h;
        mlstm_seq(F, l, h, MP + b * ST, ST, F.a->in[I_SC] + sidx * MDK * MDV, F.a->in[I_SN] + sidx * MDK, F.a->in[I_SM] + sidx,
                  F.out + O_CS + sidx * MDK * MDV, F.out + O_NS + sidx * MDK, F.out + O_MS + sidx); }
}
__device__ __forceinline__ void mixer_phase(Frame& F, int l) {
#define MX_CNT(g) ((unsigned*)(F.ws + WS_CTL) + CW_SOFT + 64 * l + 48 + (g))
#pragma unroll 1
    for (int g = 0; g < 4; ++g) {
        int gw, gnw, mw, mnw;
        if (g == 0) { gw = F.bid; gnw = 256; mw = F.bid; mnw = 256; }
        else { if (F.bid < 64) break; const int w = F.bid - 64; if (w < 128) { gw = w; gnw = 128; mw = -1; mnw = 1; } else { gw = -1; gnw = 1; mw = w - 128; mnw = 64; } }
        prep_group(F, l, g, gw, gnw, mw, mnw);
        light_arrive(MX_CNT(g));
        if (g == 0 && F.bid >= 192) { fe_sample_items(F, l, F.bid - 192); pg8::soft_arrive(MX_CNT(4)); }
    }
    wait_count(MX_CNT(0), 256u, F.wave);
    if (F.bid < 64) scan_item(F, l, F.bid);
    else {
        wait_count(MX_CNT(4), 64u, F.wave);
        for (int it = F.bid; it < 1088; it += 192) scan_item(F, l, it);
    }
#undef MX_CNT
}

__device__ __forceinline__ void sample_merge(Frame& F, const float* slab, int wk, int nwk) {
    int tq_ = threadIdx.x; asm volatile("" : "+v"(tq_)); const int lane_ = tq_ & 63, wave_ = __builtin_amdgcn_readfirstlane(tq_ >> 6);
    const bf16* proj = (const bf16*)(F.ws + WS_PROJ); bf16* xn = (bf16*)(F.ws + WS_XN);
    for (int sr = wave_ * nwk + wk; sr < MS; sr += NWAVES * nwk) {
        const int pmr = sr >> 8, r = sr & 255; const size_t row = (size_t)MP + sr;
#pragma unroll
        for (int pn = 0; pn < 4; ++pn) { const int t = pmr * 4 + pn;
            const float* sp = slab + (size_t)(4 * t) * 65536 + r * 256 + 4 * lane_;
            const f32x4 p1 = *(const GAS f32x4*)sp + *(const GAS f32x4*)(sp + 65536), p2 = *(const GAS f32x4*)(sp + 2 * 65536) + *(const GAS f32x4*)(sp + 3 * 65536);
            const v2u gg = *(const GAS v2u*)(proj + row * IN_DIM + C_GG + pn * 256 + 4 * lane_), gm = *(const GAS v2u*)(proj + row * IN_DIM + C_GM + pn * 256 + 4 * lane_);
            v2u o; o.x = pk2(pg8::bf_lo(gg.x) * p1[0] + pg8::bf_lo(gm.x) * p2[0], pg8::bf_hi(gg.x) * p1[1] + pg8::bf_hi(gm.x) * p2[1]);
            o.y = pk2(pg8::bf_lo(gg.y) * p1[2] + pg8::bf_lo(gm.y) * p2[2], pg8::bf_hi(gg.y) * p1[3] + pg8::bf_hi(gm.y) * p2[3]);
            st_wt((GAS v2u*)(xn + row * DM + pn * 256 + 4 * lane_), o); }
    }
}

constexpr int PH_PER_LAYER = 9, N_PHASES = 1 + DEPTH * PH_PER_LAYER + 1;
__global__ void __launch_bounds__(NWAVES * 64, 2) trunk_fwd(Args args) {
    extern __shared__ __attribute__((aligned(16))) unsigned char lds[];
    Frame F;
    F.lds = (LAS unsigned char*)lds;
    F.tid = threadIdx.x; F.lane = F.tid & 63; F.wave = __builtin_amdgcn_readfirstlane(F.tid >> 6);
    F.G = gridDim.x; F.bid = blockIdx.x;
    { auto ap = (const __attribute__((address_space(4))) Args*)__builtin_amdgcn_kernarg_segment_ptr(); F.a = ap; F.ws = ap->ws; F.out = ap->out; }
    volatile LAS unsigned* MISC = (volatile LAS unsigned*)(F.lds + MISC_OFF);
    for (int u = F.tid; u < (LDS_BYTES - LDSCTL_OFF) / 4; u += NWAVES * 64) ((LAS unsigned*)(F.lds + LDSCTL_OFF))[u] = 0u;
    __syncthreads();
    gu32* ctl = (gu32*)(F.ws + WS_CTL);
    XcdBarrier bar; bar.bar = (unsigned*)(ctl + CW_BAR); bar.x = 0; bar.st = nullptr;
    const int lo = args.ph_lo, hi = args.ph_hi;
    if (hi - lo > 1) bar = xcd_barrier_post((unsigned*)(ctl + CW_BAR), MISC + 8);
#pragma unroll 1
    for (int p = lo; p < hi; ++p) {
        { auto ap = (const __attribute__((address_space(4))) Args*)__builtin_amdgcn_kernarg_segment_ptr(); asm volatile("" : "+s"(ap)); F.a = ap; F.ws = ap->ws; F.out = ap->out;
          int t_ = threadIdx.x; asm volatile("" : "+v"(t_)); F.tid = t_; F.lane = t_ & 63; F.wave = __builtin_amdgcn_readfirstlane(t_ >> 6);
          int g_ = gridDim.x, b_ = blockIdx.x; asm volatile("" : "+s"(g_), "+s"(b_)); F.G = g_; F.bid = b_; }
        bf16* xn = (bf16*)(F.ws + WS_XN); bf16* proj = (bf16*)(F.ws + WS_PROJ);
        float* xo = F.out + O_Y;
        if (p == N_PHASES - 1) final_norm_phase(F, NP_DN, dn_slab(F, DEPTH - 1), MP);
        else {
            int l = 0, k = 0;
            if (p == 0) { p0_prologue(F, 0, 0, F.G); __syncthreads(); p0_prologue(F, 1, 0, F.G); __syncthreads(); }
            else { l = (p - 1) / PH_PER_LAYER; k = (p - 1) % PH_PER_LAYER; if (k == 0 && l == 0) continue; }
            bf16* xb1 = (bf16*)(F.ws + WS_XB1);
            if (k == 0 || k == 6) { if (p == 0) norm_phase(F, 0, F.a->in[I_NMIX], xn, 0); else continue; }
            else if (k == 1) {
                unsigned* cnt = (unsigned*)(ctl + CW_SOFT + 64 * l + 16);
                if (l > 0 && F.bid >= 240) { norm_phase(F, 1, F.a->in[I_NMIX] + (size_t)l * DM, xn, NP_DN, dn_slab(F, l - 1), MP, M, F.bid - 240, 16); light_arrive(cnt); }
                typedef pg8::Gemm<DM, DM, DM> GT; typedef pg8::StaticOrder<M, NPAD, DM> SO; GT g{xn, w_ptr(F, l, WO_WIN)}; SO S; S.init(F.G, F.bid); if (l > 0) { S.cnt = cnt; S.need = 16u; }
                pg8::EpiProj E{proj, (float*)(F.ws + WS_GATES), (bf16*)(F.ws + WS_HALO)};
                pg8::gemm_phase<GT, pg8::EpiProj, SO, true, true>(F.lds + RING_OFF, g, S, E, F.tid);
            }
            else if (k == 2) mixer_phase(F, l);
            else if (k == 3) continue;
            else if (k == 4) {
                typedef pg8::Gemm<IN_DIM, DM, DM> GT; typedef pg8::SplitSrcOrder SO; GT g{proj + C_ZG, w_ptr(F, l, WO_WBG)}; SO S; S.init(F.G, F.bid);
                pg8::EpiMerge E{proj + C_GG, proj + C_GM, xn, dn_slab(F, l)};
                pg8::gemm_phase<GT, pg8::EpiMerge, SO, true, true>(F.lds + RING_OFF, g, S, E, F.tid);
            }
            else if (k == 5) {
                unsigned* cnt = (unsigned*)(ctl + CW_SOFT + 64 * l);
                auto pre = [&]() { sample_merge(F, dn_slab(F, l), F.bid, 256); light_arrive(cnt); };
                typedef pg8::Gemm<DM, DM, DM> GT; typedef pg8::SplitOrder<DM, NP_WO> SO; GT g{xn, w_ptr(F, l, WO_WOUT)}; SO S; S.init(F.G, F.bid); S.cnt = cnt; S.need = 256u;
                const bool first = (l == 0);
                pg8::EpiResidN<1> E{first ? F.a->in[I_XP] : xo, first ? F.a->in[I_XS] : xo + (size_t)MP * DM, xo, dn_slab(F, l), xb1, F.a->in[I_NMLP] + (size_t)l * DM,
                                    (unsigned*)(F.ws + WS_XSLOT) + (size_t)(2 * l) * 65536, (unsigned*)(ctl + CW_X + (2 * l) * 4096), F.lds + XLDS_OFF};
                pg8::gemm_phase<GT, pg8::EpiResidN<1>, SO, true, true, decltype(pre)>(F.lds + RING_OFF, g, S, E, F.tid, pre);
            }
            else if (k == 8) {
                typedef pg8::Gemm<FF, FF, FF> GT; typedef pg8::SplitOrder<FF, NP_DN> SO; GT g{proj, w_ptr(F, l, WO_WDN)}; SO S; S.init(F.G, F.bid);
                unsigned* xs = (unsigned*)(F.ws + WS_XSLOT) + (size_t)(2 * l + 1) * 65536; unsigned* xc = (unsigned*)(ctl + CW_X + (2 * l + 1) * 4096);
                if (l + 1 < DEPTH) {
                    pg8::EpiResidN<1> E{xo, xo + (size_t)MP * DM, xo, dn_slab(F, l), xn, F.a->in[I_NMIX] + (size_t)(l + 1) * DM, xs, xc, F.lds + XLDS_OFF};
                    pg8::gemm_phase<GT, pg8::EpiResidN<1>, SO, true, true>(F.lds + RING_OFF, g, S, E, F.tid);
                } else {
                    pg8::EpiResidN<2> E{xo, xo + (size_t)MP * DM, xo, dn_slab(F, l), xn, F.a->in[I_NFIN], xs, xc, F.lds + XLDS_OFF};
                    pg8::gemm_phase<GT, pg8::EpiResidN<2>, SO, true, true>(F.lds + RING_OFF, g, S, E, F.tid);
                }
            }
            else {
                unsigned* cnt = (unsigned*)(ctl + CW_SOFT + 64 * l + 32);
                if (F.bid >= 192) { norm_phase(F, l == 0 ? 2 : 1, F.a->in[I_NMLP] + (size_t)l * DM, xb1, NP_WO, dn_slab(F, l), MP, M, F.bid - 192, 64); light_arrive(cnt); }
                typedef pg8::Gemm<DM, DM, DM> GT; typedef pg8::StaticOrder<M, FF, DM> SO; GT g{xb1, w_ptr(F, l, WO_WUP)}; SO S; S.init(F.G, F.bid); S.cnt = cnt; S.need = 64u;
                pg8::EpiRelu2 E{proj, (float*)(F.ws + WS_SLAB)};
                pg8::gemm_phase<GT, pg8::EpiRelu2, SO, true, true>(F.lds + RING_OFF, g, S, E, F.tid);
            }
        }
        if (p + 1 < hi) xcd_barrier(bar);
    }
}

extern "C" void kernel_launch(void* const* d_in, const int* in_sizes, int n_in, void* d_out, int out_size, void* d_ws, size_t ws_size, hipStream_t stream) {
    static int grid = 0;
    if (grid == 0) {
        if (n_in != 23 || in_sizes[0] != MP * DM || (size_t)out_size != O_END || ws_size < WS_END) { fprintf(stderr, "kernel_launch: unexpected shapes (n_in %d, out %d, ws %zu); nothing launched\n", n_in, out_size, ws_size); grid = -1; return; }
        int dev = 0, cus = 0, per_cu = 0;
        if (hipGetDevice(&dev) != hipSuccess || hipDeviceGetAttribute(&cus, hipDeviceAttributeMultiprocessorCount, dev) != hipSuccess) { grid = -1; return; }
        if (hipFuncSetAttribute((const void*)trunk_fwd, hipFuncAttributeMaxDynamicSharedMemorySize, LDS_BYTES) != hipSuccess) { grid = -1; return; }
        if (hipOccupancyMaxActiveBlocksPerMultiprocessor(&per_cu, (const void*)trunk_fwd, NWAVES * 64, LDS_BYTES) != hipSuccess || per_cu < 1) { fprintf(stderr, "kernel_launch: occupancy query says %d\n", per_cu); grid = -1; (void)hipGetLastError(); return; }
        (void)hipGetLastError();
        if (cus < 128) { fprintf(stderr, "kernel_launch: built for a 256-CU device (%d CUs)\n", cus); grid = -1; return; }
        if (cus != 256) { fprintf(stderr, "kernel_launch: the mixer phase's role split is built for 256 CUs (got %d)\n", cus); grid = -1; return; }
        grid = cus & ~3;
    }
    if (grid < 0) return;
    (void)hipMemsetAsync((char*)d_ws + WS_CTL, 0, CTL_ZERO_BYTES, stream);
    Args a{};
    for (int i = 0; i < 23; ++i) a.in[i] = (const float*)d_in[i];
    a.out = (float*)d_out; a.ws = (unsigned char*)d_ws;
#if MK_ONE_LAUNCH
    a.ph_lo = 0; a.ph_hi = N_PHASES;
    hipLaunchKernelGGL(trunk_fwd, dim3(grid), dim3(NWAVES * 64), LDS_BYTES, stream, a);
#else
    for (int p = 0; p < N_PHASES; ++p) { a.ph_lo = p; a.ph_hi = p + 1; hipLaunchKernelGGL(trunk_fwd, dim3(grid), dim3(NWAVES * 64), LDS_BYTES, stream, a); }
#endif
}
```
